# Optimizing an MI355X kernel written in HIP

```python
import jax, jax.numpy as jnp
from jax import lax
import numpy as np

D_MODEL = 1024
BATCH = 8
SEQ = 2048
DEPTH = 1
DEC_BATCH = 128
DEC_SEQ = 1
PAST_LEN = 16384
PAGE_SIZE = 128

D_MIX = D_MODEL
D_GMLP = D_MIX // 2
GMLP_HEADS = 4
GMLP_HD = D_GMLP // GMLP_HEADS
CHUNK = 128
D_SSD = D_MIX - D_GMLP
SSD_HEAD_DIM = 64
SSD_HEADS = D_SSD // SSD_HEAD_DIM
SSD_GROUPS = 2
HEADS_PER_GROUP = SSD_HEADS // SSD_GROUPS
D_STATE = 128
CONV_W = 4
CONV_DIM = D_SSD + 2 * SSD_GROUPS * D_STATE
SSD_CHUNK = 128
N_MEM = 256
X_HEADS = 4
X_HD = D_MODEL // X_HEADS
D_FF = -(-8 * D_MODEL // (3 * 256)) * 256
D_IN = 2 * D_GMLP + D_SSD + CONV_DIM + SSD_HEADS
SPLITS = [D_GMLP, 2 * D_GMLP, 2 * D_GMLP + D_SSD, 2 * D_GMLP + D_SSD + CONV_DIM]
EPS = 1e-6

kernel_name = "hymba_gmlp_ssd_memxattn_step"

f32 = jnp.float32


def rmsnorm(x, g):
    xf = x.astype(f32)
    y = xf * lax.rsqrt(jnp.mean(xf * xf, -1, keepdims=True) + EPS)
    return (y * g.astype(f32)).astype(x.dtype)


def layernorm(x, g, b):
    xf = x.astype(f32)
    mu = jnp.mean(xf, -1, keepdims=True)
    xc = xf - mu
    y = xc * lax.rsqrt(jnp.mean(xc * xc, -1, keepdims=True) + EPS)
    return (y * g.astype(f32) + b.astype(f32)).astype(x.dtype)


def gated_group_norm(y, z, g):
    yz = y.astype(f32) * jax.nn.silu(z.astype(f32))
    shp = yz.shape
    yz = yz.reshape(*shp[:-1], SSD_GROUPS, D_SSD // SSD_GROUPS)
    yz = yz * lax.rsqrt(jnp.mean(yz * yz, -1, keepdims=True) + EPS)
    return yz.reshape(shp) * g.astype(f32)


def gmlp_mix(u, v, ws, bs):
    b, L, _ = v.shape
    T = min(L, CHUNK)
    nc = L // T
    mask = jnp.tril(jnp.ones((T, T), dtype=bool))
    w = jnp.where(mask, ws[:, :T, :T], jnp.zeros((), ws.dtype))
    vc = v.reshape(b, nc, T, GMLP_HEADS, GMLP_HD)
    mixed = jnp.einsum('hts,bcshd->bcthd', w, vc) + jnp.swapaxes(bs[:, :T], 0, 1)[:, :, None]
    return u * mixed.reshape(b, L, D_GMLP)


def causal_conv(xpad, w, bias, L):
    out = bias
    for k in range(CONV_W):
        out = out + xpad[:, k:k + L] * w[k]
    return jax.nn.silu(out)


def ssd_chunked(x, dt, A, Bm, Cm):
    b, L = x.shape[:2]
    Q = SSD_CHUNK
    nc = L // Q
    G, J, P, N = SSD_GROUPS, HEADS_PER_GROUP, SSD_HEAD_DIM, D_STATE
    xg = x.reshape(b, nc, Q, G, J, P)
    dtg = dt.reshape(b, nc, Q, G, J)
    Bc = Bm.reshape(b, nc, Q, G, N)
    Cc = Cm.reshape(b, nc, Q, G, N)
    a_cum = jnp.cumsum(dtg * A.reshape(G, J), axis=2)
    seg = a_cum[:, :, :, None] - a_cum[:, :, None, :]
    causal = jnp.tril(jnp.ones((Q, Q), dtype=bool))[:, :, None, None]
    decay = jnp.exp(jnp.where(causal, seg, -jnp.inf))
    CB = jnp.einsum('bctgn,bcsgn->bctsg', Cc, Bc)
    y_diag = jnp.einsum('bctsg,bctsgj,bcsgj,bcsgjp->bctgjp', CB, decay, dtg, xg)
    decay_end = jnp.exp(a_cum[:, :, -1:] - a_cum)
    states = jnp.einsum('bcsgn,bcsgj,bcsgjp->bcgjpn', Bc, decay_end * dtg, xg)
    chunk_decay = jnp.exp(a_cum[:, :, -1])

    def step(h, inp):
        dec, st = inp
        return h * dec[..., None, None] + st, h

    h0 = jnp.zeros((b, G, J, P, N), f32)
    h_final, h_prev = lax.scan(step, h0, (jnp.swapaxes(chunk_decay, 0, 1), jnp.swapaxes(states, 0, 1)))
    h_prev = jnp.swapaxes(h_prev, 0, 1)
    y_off = jnp.einsum('bctgn,bctgj,bcgjpn->bctgjp', Cc, jnp.exp(a_cum), h_prev)
    y = (y_diag + y_off).reshape(b, L, SSD_HEADS, P)
    return y, h_final.reshape(b, SSD_HEADS, P, N)


def ssd_recurrent(x, dt, A, Bm, Cm, h0):
    b, L = x.shape[:2]
    G, J, P, N = SSD_GROUPS, HEADS_PER_GROUP, SSD_HEAD_DIM, D_STATE
    Ag = A.reshape(G, J)
    xs = jnp.moveaxis(x.reshape(b, L, G, J, P), 1, 0)
    dts = jnp.moveaxis(dt.reshape(b, L, G, J), 1, 0)
    Bs = jnp.moveaxis(Bm, 1, 0)
    Cs = jnp.moveaxis(Cm, 1, 0)

    def step(h, inp):
        x_t, dt_t, B_t, C_t = inp
        h = h * jnp.exp(dt_t * Ag)[..., None, None] + jnp.einsum('bgj,bgjp,bgn->bgjpn', dt_t, x_t, B_t)
        y = jnp.einsum('bgn,bgjpn->bgjp', C_t, h)
        return h, y

    h, ys = lax.scan(step, h0.reshape(b, G, J, P, N), (xs, dts, Bs, Cs))
    y = jnp.moveaxis(ys, 0, 1).reshape(b, L, SSD_HEADS, P)
    return y, h.reshape(b, SSD_HEADS, P, N)


def mixer_block(hn, conv_prefix, h0, w_in, ln_g, ln_b, ws, bs, cw, cb, dtb, alog, dsk, sn, wo):
    b, L, _ = hn.shape
    proj = hn @ w_in
    u, v, z, xbc, dt_raw = jnp.split(proj, SPLITS, axis=-1)
    u = jax.nn.gelu(u)
    v = layernorm(jax.nn.gelu(v), ln_g, ln_b)
    g_out = gmlp_mix(u, v, ws, bs)
    xpad = jnp.concatenate([conv_prefix.astype(xbc.dtype), xbc], axis=1)
    xbc_c = causal_conv(xpad, cw, cb, L)
    xs, Bm, Cm = jnp.split(xbc_c, [D_SSD, D_SSD + SSD_GROUPS * D_STATE], axis=-1)
    xs = xs.reshape(b, L, SSD_HEADS, SSD_HEAD_DIM).astype(f32)
    Bm = Bm.reshape(b, L, SSD_GROUPS, D_STATE).astype(f32)
    Cm = Cm.reshape(b, L, SSD_GROUPS, D_STATE).astype(f32)
    dt = jax.nn.softplus(dt_raw.astype(f32) + dtb.astype(f32))
    A = -jnp.exp(alog.astype(f32))
    if h0 is None:
        y, h = ssd_chunked(xs, dt, A, Bm, Cm)
    else:
        y, h = ssd_recurrent(xs, dt, A, Bm, Cm, h0.astype(f32))
    y = y + dsk.astype(f32)[:, None] * xs
    s_out = gated_group_norm(y.reshape(b, L, D_SSD), z, sn).astype(hn.dtype)
    out = jnp.concatenate([g_out, s_out], axis=-1) @ wo
    return out, xpad[:, -(CONV_W - 1):], h.astype(hn.dtype), v


def mem_kv(mem, g, w_k, w_v):
    mn = rmsnorm(mem, g)
    b, M, _ = mem.shape
    return (mn @ w_k).reshape(b, M, X_HEADS, X_HD), (mn @ w_v).reshape(b, M, X_HEADS, X_HD)


def cross_attn(hn, k, v, w_q, w_xo):
    b, L, _ = hn.shape
    q = (hn @ w_q).reshape(b, L, X_HEADS, X_HD)
    s = jnp.einsum('bthd,bmhd->bhtm', q.astype(f32), k.astype(f32)) * (X_HD ** -0.5)
    p = jax.nn.softmax(s, axis=-1)
    o = jnp.einsum('bhtm,bmhd->bthd', p, v.astype(f32)).astype(hn.dtype)
    return o.reshape(b, L, D_MODEL) @ w_xo


def swiglu(hn, w_gate, w_up, w_down):
    return (jax.nn.silu(hn @ w_gate) * (hn @ w_up)) @ w_down


def setup_inputs(seed: int = 0) -> dict:
    key = jax.random.key(seed)
    ks = iter(jax.random.split(key, 48))

    def nrm(shape, scale):
        return jax.random.normal(next(ks), shape, f32) * scale

    def gain(n):
        return 1.0 + nrm((DEPTH, n), 0.02)

    dt0 = jnp.exp(jax.random.uniform(next(ks), (DEPTH, SSD_HEADS), f32, np.log(1e-3), np.log(1e-1)))
    dt_bias = dt0 + jnp.log(-jnp.expm1(-dt0))
    a_log = jnp.log(jax.random.uniform(next(ks), (DEPTH, SSD_HEADS), f32, 1.0, 16.0))
    return {
        "x_prompt": nrm((BATCH, SEQ, D_MODEL), 1.0),
        "x_sample": nrm((DEC_BATCH, DEC_SEQ, D_MODEL), 1.0),
        "state_ssm": nrm((DEPTH, DEC_BATCH, SSD_HEADS, SSD_HEAD_DIM, D_STATE), 0.1),
        "state_conv": nrm((DEPTH, DEC_BATCH, CONV_W - 1, CONV_DIM), 1.0),
        "cache_mem_k": nrm((DEPTH, DEC_BATCH, N_MEM, X_HEADS, X_HD), 1.0),
        "cache_mem_v": nrm((DEPTH, DEC_BATCH, N_MEM, X_HEADS, X_HD), 1.0),
        "mem_prompt": nrm((BATCH, N_MEM, D_MODEL), 1.0),
        "norm_mix": gain(D_MODEL),
        "w_in": nrm((DEPTH, D_MODEL, D_IN), D_MODEL ** -0.5),
        "gmlp_ln_g": gain(D_GMLP),
        "gmlp_ln_b": nrm((DEPTH, D_GMLP), 0.02),
        "gmlp_ws": nrm((DEPTH, GMLP_HEADS, CHUNK, CHUNK), CHUNK ** -0.5),
        "gmlp_bs": 1.0 + nrm((DEPTH, GMLP_HEADS, CHUNK), 0.02),
        "conv_w": nrm((DEPTH, CONV_W, CONV_DIM), CONV_W ** -0.5),
        "conv_b": nrm((DEPTH, CONV_DIM), 0.02),
        "dt_bias": dt_bias,
        "a_log": a_log,
        "d_skip": 1.0 + nrm((DEPTH, SSD_HEADS), 0.02),
        "ssd_norm": gain(D_SSD),
        "w_out": nrm((DEPTH, D_MIX, D_MODEL), D_MIX ** -0.5),
        "norm_xattn": gain(D_MODEL),
        "norm_mem": gain(D_MODEL),
        "w_q": nrm((DEPTH, D_MODEL, D_MODEL), D_MODEL ** -0.5),
        "w_k": nrm((DEPTH, D_MODEL, D_MODEL), D_MODEL ** -0.5),
        "w_v": nrm((DEPTH, D_MODEL, D_MODEL), D_MODEL ** -0.5),
        "w_xo": nrm((DEPTH, D_MODEL, D_MODEL), D_MODEL ** -0.5),
        "norm_ffn": gain(D_MODEL),
        "w_gate": nrm((DEPTH, D_MODEL, D_FF), D_MODEL ** -0.5),
        "w_up": nrm((DEPTH, D_MODEL, D_FF), D_MODEL ** -0.5),
        "w_down": nrm((DEPTH, D_FF, D_MODEL), D_FF ** -0.5),
        "norm_final": 1.0 + nrm((D_MODEL,), 0.02),
    }


def reference(x_prompt, x_sample, state_ssm, state_conv, cache_mem_k, cache_mem_v, mem_prompt,
              norm_mix, w_in, gmlp_ln_g, gmlp_ln_b, gmlp_ws, gmlp_bs, conv_w, conv_b, dt_bias,
              a_log, d_skip, ssd_norm, w_out, norm_xattn, norm_mem, w_q, w_k, w_v, w_xo,
              norm_ffn, w_gate, w_up, w_down, norm_final):
    hp, hs = x_prompt, x_sample
    ssm_p, conv_p, gv_p, mk_p, mv_p = [], [], [], [], []
    ssm_s, conv_s, gv_s = [], [], []
    for l in range(DEPTH):
        mix_w = (w_in[l], gmlp_ln_g[l], gmlp_ln_b[l], gmlp_ws[l], gmlp_bs[l], conv_w[l], conv_b[l],
                 dt_bias[l], a_log[l], d_skip[l], ssd_norm[l], w_out[l])
        zero_prefix = jnp.zeros((hp.shape[0], CONV_W - 1, CONV_DIM), hp.dtype)
        out, cst, hst, v = mixer_block(rmsnorm(hp, norm_mix[l]), zero_prefix, None, *mix_w)
        hp = hp + out
        mk, mv = mem_kv(mem_prompt, norm_mem[l], w_k[l], w_v[l])
        hp = hp + cross_attn(rmsnorm(hp, norm_xattn[l]), mk, mv, w_q[l], w_xo[l])
        hp = hp + swiglu(rmsnorm(hp, norm_ffn[l]), w_gate[l], w_up[l], w_down[l])
        ssm_p.append(hst); conv_p.append(cst); gv_p.append(v[:, -CHUNK:]); mk_p.append(mk); mv_p.append(mv)
        out, cst, hst, v = mixer_block(rmsnorm(hs, norm_mix[l]), state_conv[l], state_ssm[l], *mix_w)
        hs = hs + out
        hs = hs + cross_attn(rmsnorm(hs, norm_xattn[l]), cache_mem_k[l], cache_mem_v[l], w_q[l], w_xo[l])
        hs = hs + swiglu(rmsnorm(hs, norm_ffn[l]), w_gate[l], w_up[l], w_down[l])
        ssm_s.append(hst); conv_s.append(cst); gv_s.append(v)
    y_prompt = rmsnorm(hp, norm_final)
    y_sample = rmsnorm(hs, norm_final)
    return (y_prompt, y_sample, jnp.stack(ssm_p), jnp.stack(conv_p), jnp.stack(gv_p),
            jnp.stack(mk_p), jnp.stack(mv_p), jnp.stack(ssm_s), jnp.stack(conv_s), jnp.stack(gv_s))
```

```cpp
#include <hip/hip_runtime.h>
#include <hip/hip_cooperative_groups.h>
#include <stdint.h>
#include <cstdio>
namespace cg = cooperative_groups;

#ifndef FUSED
#define FUSED 1
#endif
#define DUP_MASK 0
#define PRE_MASK 0
#ifndef RUN_PHASES
#define RUN_PHASES 13
#define DUMP_SEL 0
#endif

#define LAS __attribute__((address_space(3)))
typedef unsigned short bf16_t;
typedef short bf16x8 __attribute__((ext_vector_type(8)));
typedef float f32x4 __attribute__((ext_vector_type(4)));
typedef unsigned u32x4 __attribute__((ext_vector_type(4)));
typedef unsigned u32x2 __attribute__((ext_vector_type(2)));

constexpr int MP = 16384, MS = 128, MT = MP + MS;
constexpr int NCH = 128;
constexpr float EPS = 1e-6f;
constexpr int NPH = 13;

constexpr size_t O_YP = 0, O_YS = 16777216, O_SSMP = 16908288, O_CONVP = 17432576, O_GVP = 17457152,
                 O_MK = 17981440, O_MV = 20078592, O_SSMS = 22175744, O_CONVS = 30564352, O_GVS = 30957568;

constexpr size_t al(size_t x) { return (x + 255) & ~(size_t)255; }
constexpr size_t W_BAR = 0;
constexpr size_t W_ZERO = al(W_BAR + 3456 * 4);
constexpr size_t ZERO_FLOATS = (size_t)MT * 7;
constexpr size_t W_WIN = al(W_ZERO + ZERO_FLOATS * 4);
constexpr size_t W_WKV = al(W_WIN + (size_t)2688 * 1024 * 2);
constexpr size_t W_WOUT = al(W_WKV + (size_t)2048 * 1024 * 2);
constexpr size_t W_WQ = al(W_WOUT + (size_t)1024 * 1024 * 2);
constexpr size_t W_WXO = al(W_WQ + (size_t)1024 * 1024 * 2);
constexpr size_t W_WGU = al(W_WXO + (size_t)1024 * 1024 * 2);
constexpr size_t W_WD = al(W_WGU + (size_t)5632 * 1024 * 2);
constexpr size_t W_WSB = al(W_WD + (size_t)1024 * 2816 * 2);
constexpr size_t W_MEMB = al(W_WSB + (size_t)4 * 128 * 128 * 2);
constexpr size_t W_DTRAW = al(W_MEMB + (size_t)2048 * 1024 * 2);
constexpr size_t W_KB = al(W_DTRAW + (size_t)MT * 8 * 4);
constexpr size_t W_VT = al(W_KB + (size_t)2048 * 1024 * 2);
constexpr size_t W_VLNT = al(W_VT + (size_t)2048 * 1024 * 2);
constexpr size_t W_ACUM = al(W_VLNT + (size_t)MP * 512 * 2);
constexpr size_t W_DTV = al(W_ACUM + (size_t)NCH * 8 * 128 * 4);
constexpr size_t W_CONCAT = al(W_DTV + (size_t)NCH * 8 * 128 * 4);
constexpr size_t W_HP = al(W_CONCAT + (size_t)MT * 1024 * 2);
constexpr size_t W_HPB = al(W_HP + (size_t)MT * 1024 * 4);
constexpr size_t W_XB = al(W_HPB + (size_t)MT * 1024 * 2);
constexpr size_t W_UB = al(W_XB + (size_t)MT * 1024 * 2);
constexpr size_t W_VG = al(W_UB + (size_t)MT * 512 * 2);
constexpr size_t W_ZB = al(W_VG + (size_t)MT * 512 * 2);
constexpr size_t W_XBCB = al(W_ZB + (size_t)MT * 512 * 2);
constexpr size_t W_R1END = al(W_XBCB + (size_t)MT * 1024 * 2);
constexpr size_t W_ACT = W_XB;
static_assert((size_t)MT * 2816 * 2 <= W_R1END - W_XB, "act alias");
constexpr size_t W_XN = W_R1END;
constexpr size_t W_XWT = al(W_XN + (size_t)MP * 512 * 2);
constexpr size_t W_XT = al(W_XWT + (size_t)MP * 512 * 2);
constexpr size_t W_BN = al(W_XT + (size_t)MP * 512 * 2);
constexpr size_t W_BT = al(W_BN + (size_t)MP * 256 * 2);
constexpr size_t W_CN = al(W_BT + (size_t)MP * 256 * 2);
constexpr size_t W_R2END = al(W_CN + (size_t)MP * 256 * 2);
constexpr size_t W_QB = W_XN;
static_assert((size_t)MT * 1024 * 2 <= W_BN - W_XN, "qb alias");
constexpr size_t W_SC = W_R2END;
constexpr size_t W_HPREV = al(W_SC + (size_t)NCH * 8 * 64 * 128 * 4);
constexpr size_t W_MT = al(W_HPREV + (size_t)NCH * 8 * 64 * 128 * 2);
constexpr size_t W_END = al(W_MT + (size_t)NCH * 8 * 128 * 128 * 2);
constexpr size_t W_PBUF = W_SC;
constexpr size_t W_OB = W_HPREV;
static_assert((size_t)MT * 1024 * 2 <= W_END - W_HPREV, "ob alias");
static_assert(W_END < (size_t)530 * 1000 * 1000, "workspace too large");

constexpr int LDS_MISC = 65536;
constexpr int LDS_BYTES = 65536 + 4096;

struct Params {
    const float* in[31];
    float* out;
    char* ws;
    int ph_lo, ph_hi, fused, never;
};

__device__ __forceinline__ float bf2f(unsigned h) { return __uint_as_float(h << 16); }
__device__ __forceinline__ unsigned pk2(float lo, float hi) { unsigned r; asm("v_cvt_pk_bf16_f32 %0, %1, %2" : "=v"(r) : "v"(lo), "v"(hi)); return r; }
__device__ __forceinline__ float bflo(unsigned u) { return __uint_as_float(u << 16); }
__device__ __forceinline__ float bfhi(unsigned u) { return __uint_as_float(u & 0xffff0000u); }
__device__ __forceinline__ float rbf(float x) { return bflo(pk2(x, 0.f) & 0xffffu); }
__device__ __forceinline__ float gelu_t(float x) { const float u = 1.5957691216f * (x + 0.044715f * x * x * x); return x / (1.f + __expf(-u)); }
__device__ __forceinline__ float silu_f(float x) { return x / (1.f + __expf(-x)); }
__device__ __forceinline__ float softplus_f(float x) { return x > 20.f ? x : log1pf(expf(x)); }
__device__ __forceinline__ float wave_sum(float v) {
#pragma unroll
    for (int o = 1; o < 64; o <<= 1) v += __shfl_xor(v, o);
    return v;
}
__device__ __forceinline__ float wave_max(float v) {
#pragma unroll
    for (int o = 1; o < 64; o <<= 1) v = fmaxf(v, __shfl_xor(v, o));
    return v;
}
__device__ __forceinline__ u32x4 scale8(u32x4 v, float s) {
    u32x4 o;
    o.x = pk2(bflo(v.x) * s, bfhi(v.x) * s); o.y = pk2(bflo(v.y) * s, bfhi(v.y) * s);
    o.z = pk2(bflo(v.z) * s, bfhi(v.z) * s); o.w = pk2(bflo(v.w) * s, bfhi(v.w) * s);
    return o;
}

#define XB_TMO      128
#define XB_XCNT(j)  (256  + 64 * (j))
#define XB_XSUB(j)  (1280 + 64 * (j))
#define XB_XGEN(j)  (2304 + 64 * (j))
#define XB_TOP      3328
#define XB_TOPGEN   3392
#define XCD_BAR_WORDS 3456
#define XB_SPIN_CAP (1u << 22)
__device__ __forceinline__ unsigned xb_ld(unsigned* p)              { return __hip_atomic_load(p, __ATOMIC_RELAXED, __HIP_MEMORY_SCOPE_AGENT); }
__device__ __forceinline__ unsigned xb_add(unsigned* p, unsigned v) { return __hip_atomic_fetch_add(p, v, __ATOMIC_RELAXED, __HIP_MEMORY_SCOPE_AGENT); }
__device__ __forceinline__ unsigned xb_xcc_id() { return (unsigned)__builtin_amdgcn_s_getreg((3 << 11) | 20) & 0xFu; }
#define XB_SPIN(cond, bar) do { unsigned _sp = 0; while (cond) { __builtin_amdgcn_s_sleep(1); \
    if ((++_sp & 255u) == 0u) { if (xb_ld(&(bar)[XB_TMO])) break; if (_sp > XB_SPIN_CAP) { atomicAdd(&(bar)[XB_TMO], 1u); break; } } } } while (0)
struct XcdBarrier { unsigned* bar; unsigned x; volatile LAS unsigned* st; };
__device__ __forceinline__ XcdBarrier xcd_barrier_post(unsigned* bar, volatile LAS unsigned* st) {
    XcdBarrier b; b.bar = bar; b.x = xb_xcc_id(); b.st = st;
    if (threadIdx.x == 0) (void)xb_add(&bar[XB_XCNT(b.x)], 1u);
    return b;
}
__device__ __forceinline__ void xcd_barrier_complete(unsigned* bar, unsigned x, unsigned& nloc, unsigned& nx) {
    const unsigned G = gridDim.x * gridDim.y * gridDim.z;
    unsigned sum, cnt, mine, sp = 0u;
    for (;;) {
        sum = 0u; cnt = 0u; mine = 0u;
#pragma unroll
        for (unsigned j = 0; j < 16; ++j) { const unsigned c = xb_ld(&bar[XB_XCNT(j)]); sum += c; cnt += (c > 0u) ? 1u : 0u; mine = (j == x) ? c : mine; }
        if (sum == G) break;
        __builtin_amdgcn_s_sleep(1);
        if ((++sp & 255u) == 0u) { if (xb_ld(&bar[XB_TMO])) break; if (sp > XB_SPIN_CAP) { atomicAdd(&bar[XB_TMO], 1u); break; } }
    }
    nloc = mine > 0u ? mine : 1u; nx = cnt > 0u ? cnt : 1u;
}
__device__ __forceinline__ void xcd_barrier(const XcdBarrier& b) {
    asm volatile("s_waitcnt vmcnt(0)" ::: "memory");
    __syncthreads();
    if (threadIdx.x == 0) {
        unsigned* bar = b.bar;
        __builtin_amdgcn_s_waitcnt(0);
        unsigned nloc = b.st[0], nx = b.st[1];
        if (nloc == 0u) { xcd_barrier_complete(bar, b.x, nloc, nx); b.st[0] = nloc; b.st[1] = nx; }
        const unsigned old = xb_add(&bar[XB_XSUB(b.x)], 1u);
        const unsigned gen = old / nloc;
        if (old + 1u == (gen + 1u) * nloc) {
            __builtin_amdgcn_fence(__ATOMIC_RELEASE, "agent");
            asm volatile("s_waitcnt vmcnt(0)" ::: "memory");
            const unsigned og = xb_add(&bar[XB_TOP], 1u);
            const unsigned tg = og / nx;
            if (og + 1u == (tg + 1u) * nx) xb_add(&bar[XB_TOPGEN], 1u);
            else XB_SPIN(xb_ld(&bar[XB_TOPGEN]) == tg, bar);
            __builtin_amdgcn_fence(__ATOMIC_ACQUIRE, "agent");
            xb_add(&bar[XB_XGEN(b.x)], 1u);
            asm volatile("s_waitcnt vmcnt(0)" ::: "memory");
        } else {
            XB_SPIN(xb_ld(&bar[XB_XGEN(b.x)]) == gen, bar);
            __builtin_amdgcn_fence(__ATOMIC_ACQUIRE, "agent");
            asm volatile("s_waitcnt vmcnt(0)" ::: "memory");
        }
    }
    __syncthreads();
}

__device__ __forceinline__ int sched(int i, int T) {
    const int x = blockIdx.x & 7, lb = blockIdx.x >> 3, nlb = gridDim.x >> 3;
    const int chunk = (T + 7) >> 3, local = lb + i * nlb;
    if (local >= chunk) return -1;
    const int t = x * chunk + local;
    return t < T ? t : -1;
}
__device__ __forceinline__ void tile_mn(int t, int NMt, int NNt, int& mt, int& nt) {
    const int per = 8 * NNt, gi = t / per, r = t - gi * per, fm = gi * 8;
    const int gsz = (NMt - fm) < 8 ? (NMt - fm) : 8;
    mt = fm + r % gsz; nt = r / gsz;
}

template <int BN, int AMODE>
__device__ __forceinline__ void mma_seg(f32x4 (&acc)[4][BN / 32], const bf16_t* __restrict__ A, const int lda,
                                        const bf16_t* __restrict__ Bt, const int ldb, const int K, LAS char* lds,
                                        const float* __restrict__ gssrow) {
    constexpr int NI = BN / 32;
    const int tid = threadIdx.x, lane = tid & 63, wid = __builtin_amdgcn_readfirstlane(tid >> 6), wm = wid >> 1, wn = wid & 1, fr = lane & 15, fq = lane >> 4;
    const int srow = tid >> 3, sc = tid & 7;
    const int csw = (sc ^ ((srow >> 1) & 7)) * 8;
    const bf16_t* ap = A + (size_t)srow * lda + (AMODE == 1 ? sc * 8 : csw);
    const bf16_t* bp = Bt + (size_t)srow * ldb + csw;
    const int woff = srow * 128 + ((sc ^ ((srow >> 1) & 7)) << 4);
    const int gl = wid * 1024;
    const int sw = (fr >> 1) & 7;
    const int aoff = (wm * 64 + fr) * 128, boff = 32768 + (wn * (BN / 2) + fr) * 128;
    u32x4 ra[4];
    float asc[4];
    const int nk = K >> 6;
#define MS_ISSUE(kt, buf) do { \
    if (AMODE == 1) { \
        _Pragma("unroll") for (int i = 0; i < 4; ++i) ra[i] = *(const u32x4*)(ap + (size_t)(i * 32) * lda + (kt) * 64); \
        const int k_ = (kt) * 64 + sc * 8; \
        _Pragma("unroll") for (int i = 0; i < 4; ++i) asc[i] = (k_ >= 512) ? rsqrtf(gssrow[(srow + 32 * i) * 2 + ((k_ - 512) >> 8)] * (1.f / 256.f) + EPS) : 1.f; \
    } else { \
        _Pragma("unroll") for (int i = 0; i < 4; ++i) __builtin_amdgcn_global_load_lds((const unsigned*)(ap + (size_t)(i * 32) * lda + (kt) * 64), (LAS unsigned*)(lds + (buf) * 16384 + i * 4096 + gl), 16, 0, 0); \
    } \
    _Pragma("unroll") for (int i = 0; i < NI; ++i) __builtin_amdgcn_global_load_lds((const unsigned*)(bp + (size_t)(i * 32) * ldb + (kt) * 64), (LAS unsigned*)(lds + 32768 + (buf) * 16384 + i * 4096 + gl), 16, 0, 0); \
  } while (0)
#define MS_STORE(buf) do { if (AMODE == 1) { \
    _Pragma("unroll") for (int i = 0; i < 4; ++i) { *(LAS u32x4*)(lds + (buf) * 16384 + woff + i * 4096) = scale8(ra[i], asc[i]); } } \
  } while (0)
    __syncthreads();
    MS_ISSUE(0, 0);
    MS_STORE(0);
    asm volatile("s_waitcnt vmcnt(0)" ::: "memory");
    __syncthreads();
    for (int kt = 0; kt < nk; ++kt) {
        const int cur = kt & 1;
        if (kt + 1 < nk) MS_ISSUE(kt + 1, cur ^ 1);
#pragma unroll
        for (int kk = 0; kk < 2; ++kk) {
            const int co = (((kk * 4 + fq) ^ sw) << 4) + cur * 16384;
            bf16x8 af[4], bfv[NI];
#pragma unroll
            for (int mi = 0; mi < 4; ++mi) af[mi] = *(LAS bf16x8*)(lds + aoff + mi * 2048 + co);
#pragma unroll
            for (int ni = 0; ni < NI; ++ni) bfv[ni] = *(LAS bf16x8*)(lds + boff + ni * 2048 + co);
#pragma unroll
            for (int mi = 0; mi < 4; ++mi)
#pragma unroll
                for (int ni = 0; ni < NI; ++ni) acc[mi][ni] = __builtin_amdgcn_mfma_f32_16x16x32_bf16(bfv[ni], af[mi], acc[mi][ni], 0, 0, 0);
        }
        if (kt + 1 < nk) MS_STORE(cur ^ 1);
        asm volatile("s_waitcnt vmcnt(0)" ::: "memory");
        __syncthreads();
    }
#undef MS_ISSUE
#undef MS_STORE
}
template <int NI> __device__ __forceinline__ void zero_acc(f32x4 (&acc)[4][NI]) {
#pragma unroll
    for (int mi = 0; mi < 4; ++mi)
#pragma unroll
        for (int ni = 0; ni < NI; ++ni) acc[mi][ni] = (f32x4){0.f, 0.f, 0.f, 0.f};
}
__device__ __forceinline__ float fq_sum(float v) { v += __shfl_xor(v, 16); v += __shfl_xor(v, 32); return v; }
__device__ __forceinline__ float fq_max(float v) { v = fmaxf(v, __shfl_xor(v, 16)); v = fmaxf(v, __shfl_xor(v, 32)); return v; }

#define WSP(T, off) ((T*)(p.ws + (off)))
#define TIDV const int tid = threadIdx.x, lane = tid & 63, wid = tid >> 6, wm = wid >> 1, wn = wid & 1, fr = lane & 15, fq = lane >> 4; (void)wm; (void)wn; (void)fr; (void)fq; (void)lane; (void)wid

__device__ __forceinline__ void p0_transpose(const Params& p, int item, LAS char* lds) {
    TIDV;
    LAS float* tile = (LAS float*)lds;
    int r = item; const float* s0; const float* s1 = nullptr; const float* ksc = nullptr; bf16_t* dst; int K = 1024, NT, ld, mode = 0, kso = 0, nvalid; float mul = 1.f;
    if (r < 672) { s0 = p.in[8]; dst = WSP(bf16_t, W_WIN); NT = 42; ld = 2568; nvalid = 2568; }
    else if ((r -= 672) < 512) { s0 = p.in[23]; s1 = p.in[24]; dst = WSP(bf16_t, W_WKV); mode = 1; NT = 32; ld = 1024; nvalid = 2048; }
    else if ((r -= 512) < 256) { s0 = p.in[19]; dst = WSP(bf16_t, W_WOUT); ksc = p.in[18]; kso = 512; NT = 16; ld = 1024; nvalid = 1024; }
    else if ((r -= 256) < 256) { s0 = p.in[22]; dst = WSP(bf16_t, W_WQ); ksc = p.in[20]; mul = 0.0625f; NT = 16; ld = 1024; nvalid = 1024; }
    else if ((r -= 256) < 256) { s0 = p.in[25]; dst = WSP(bf16_t, W_WXO); NT = 16; ld = 1024; nvalid = 1024; }
    else if ((r -= 256) < 1408) { s0 = p.in[27]; s1 = p.in[28]; dst = WSP(bf16_t, W_WGU); mode = 2; ksc = p.in[26]; NT = 88; ld = 2816; nvalid = 5632; }
    else { r -= 1408; s0 = p.in[29]; dst = WSP(bf16_t, W_WD); K = 2816; NT = 16; ld = 1024; nvalid = 1024; }
    const int kt = r / NT, nt = r - kt * NT, k0 = kt * 64, n0 = nt * 64;
    {
        const int tn = (tid & 15) * 4, tk = tid >> 4, n = n0 + tn;
        const float* src = s0; size_t coff = 0; const bool valid = n < nvalid;
        if (mode == 0) coff = n;
        else if (mode == 1) { if (n >= 1024) { src = s1; coff = n - 1024; } else coff = n; }
        else { const int grp = n >> 5, w = n & 31; coff = grp * 16 + (w & 15); if (w >> 4) src = s1; }
        f32x4 v[4];
#pragma unroll
        for (int i = 0; i < 4; ++i) { const int k = k0 + tk + 16 * i; v[i] = valid ? *(const f32x4*)(src + (size_t)k * ld + coff) : (f32x4){0.f, 0.f, 0.f, 0.f}; }
#pragma unroll
        for (int i = 0; i < 4; ++i) {
            const int k = k0 + tk + 16 * i;
            float sc_ = mul; if (ksc && k >= kso) sc_ *= ksc[k - kso];
            LAS float* t_ = tile + (tk + 16 * i) * 65 + tn;
            t_[0] = v[i][0] * sc_; t_[1] = v[i][1] * sc_; t_[2] = v[i][2] * sc_; t_[3] = v[i][3] * sc_;
        }
    }
    __syncthreads();
    {
        const int c = tid & 7, nl = tid >> 3;
#pragma unroll
        for (int j = 0; j < 2; ++j) {
            const int n = nl + 32 * j;
            const LAS float* s = tile + (c * 8) * 65 + n;
            u32x4 o; o.x = pk2(s[0], s[65]); o.y = pk2(s[2 * 65], s[3 * 65]); o.z = pk2(s[4 * 65], s[5 * 65]); o.w = pk2(s[6 * 65], s[7 * 65]);
            *(u32x4*)(dst + (size_t)(n0 + n) * K + k0 + c * 8) = o;
        }
    }
    __syncthreads();
}
__device__ __forceinline__ void p0_rownorm(const Params& p, int ri) {
    TIDV;
    const int row = ri * 4 + wid;
    const float* src; const float* g; bf16_t* dst;
    if (row < MT) { src = row < MP ? p.in[0] + (size_t)row * 1024 : p.in[1] + (size_t)(row - MP) * 1024; g = p.in[7]; dst = WSP(bf16_t, W_XB) + (size_t)row * 1024; }
    else { const int r2 = row - MT; src = p.in[6] + (size_t)r2 * 1024; g = p.in[21]; dst = WSP(bf16_t, W_MEMB) + (size_t)r2 * 1024; }
    float4 v[4]; float ss = 0.f;
#pragma unroll
    for (int j = 0; j < 4; ++j) { v[j] = *(const float4*)(src + (j * 64 + lane) * 4); ss += v[j].x * v[j].x + v[j].y * v[j].y + v[j].z * v[j].z + v[j].w * v[j].w; }
    const float rstd = rsqrtf(wave_sum(ss) * (1.f / 1024.f) + EPS);
#pragma unroll
    for (int j = 0; j < 4; ++j) {
        const float4 gv = *(const float4*)(g + (j * 64 + lane) * 4);
        u32x2 o; o.x = pk2(v[j].x * rstd * gv.x, v[j].y * rstd * gv.y); o.y = pk2(v[j].z * rstd * gv.z, v[j].w * rstd * gv.w);
        *(u32x2*)(dst + (j * 64 + lane) * 4) = o;
    }
}
__device__ __forceinline__ void phase0(const Params& p, LAS char* lds) {
    const int gtid = blockIdx.x * 256 + threadIdx.x, gn = gridDim.x * 256;
    float* z = WSP(float, W_ZERO);
    for (int i = gtid; i < (int)ZERO_FLOATS; i += gn) z[i] = 0.f;
    bf16_t* wsb = WSP(bf16_t, W_WSB); const float* ws = p.in[11];
    for (int i = gtid; i < 4 * 128 * 128; i += gn) { const int s = i & 127, t = (i >> 7) & 127; wsb[i] = (s <= t) ? (bf16_t)(pk2(ws[i], 0.f) & 0xffffu) : (bf16_t)0; }
    for (int it = blockIdx.x; it < 4064 + 4640; it += gridDim.x) {
        if (it < 4064) p0_transpose(p, it, lds); else p0_rownorm(p, it - 4064);
    }
}

__device__ __forceinline__ void p1_inproj_tile(const Params& p, int mt, int nt, LAS char* lds) {
    TIDV;
    f32x4 acc[4][4]; zero_acc<4>(acc);
    const int m0 = mt * 128, n0 = nt * 128;
    mma_seg<128, 0>(acc, WSP(bf16_t, W_XB) + (size_t)m0 * 1024, 1024, WSP(bf16_t, W_WIN) + (size_t)n0 * 1024, 1024, 1024, lds, nullptr);
    const int rb = m0 + wm * 64 + fr, cb = n0 + wn * 64 + fq * 4;
    if (n0 < 512) {
        bf16_t* ub = WSP(bf16_t, W_UB);
#pragma unroll
        for (int mi = 0; mi < 4; ++mi)
#pragma unroll
            for (int ni = 0; ni < 4; ++ni) { const f32x4 a = acc[mi][ni]; u32x2 o; o.x = pk2(gelu_t(a[0]), gelu_t(a[1])); o.y = pk2(gelu_t(a[2]), gelu_t(a[3]));
                *(u32x2*)(ub + (size_t)(rb + mi * 16) * 512 + cb + ni * 16) = o; }
    } else if (n0 < 1024) {
        bf16_t* vg = WSP(bf16_t, W_VG); float* vstat = WSP(float, W_ZERO);
#pragma unroll
        for (int mi = 0; mi < 4; ++mi) {
            float s1 = 0.f, s2 = 0.f;
#pragma unroll
            for (int ni = 0; ni < 4; ++ni) { const f32x4 a = acc[mi][ni]; const float g0 = gelu_t(a[0]), g1 = gelu_t(a[1]), g2 = gelu_t(a[2]), g3 = gelu_t(a[3]);
                u32x2 o; o.x = pk2(g0, g1); o.y = pk2(g2, g3);
                const float r0 = bflo(o.x), r1 = bfhi(o.x), r2 = bflo(o.y), r3 = bfhi(o.y);
                s1 += (r0 + r1) + (r2 + r3); s2 += (r0 * r0 + r1 * r1) + (r2 * r2 + r3 * r3);
                *(u32x2*)(vg + (size_t)(rb + mi * 16) * 512 + (cb - 512) + ni * 16) = o; }
            s1 = fq_sum(s1); s2 = fq_sum(s2);
            if (fq == 0) { atomicAdd(vstat + (size_t)(rb + mi * 16) * 2, s1); atomicAdd(vstat + (size_t)(rb + mi * 16) * 2 + 1, s2); }
        }
    } else if (n0 < 1536) {
        bf16_t* zb = WSP(bf16_t, W_ZB);
#pragma unroll
        for (int mi = 0; mi < 4; ++mi)
#pragma unroll
            for (int ni = 0; ni < 4; ++ni) { const f32x4 a = acc[mi][ni]; u32x2 o; o.x = pk2(a[0], a[1]); o.y = pk2(a[2], a[3]);
                *(u32x2*)(zb + (size_t)(rb + mi * 16) * 512 + (cb - 1024) + ni * 16) = o; }
    } else if (n0 < 2560) {
        bf16_t* xb = WSP(bf16_t, W_XBCB);
#pragma unroll
        for (int mi = 0; mi < 4; ++mi) {
            const int row = rb + mi * 16;
            float* fo = nullptr;
            if (row < MP) { const int t = row & 2047; if (t >= 2045) fo = p.out + O_CONVP + ((size_t)(row >> 11) * 3 + (t - 2045)) * 1024; }
            else fo = p.out + O_CONVS + ((size_t)(row - MP) * 3 + 2) * 1024;
#pragma unroll
            for (int ni = 0; ni < 4; ++ni) { const f32x4 a = acc[mi][ni]; const int ch = cb - 1536 + ni * 16; u32x2 o; o.x = pk2(a[0], a[1]); o.y = pk2(a[2], a[3]);
                *(u32x2*)(xb + (size_t)row * 1024 + ch) = o;
                if (fo) *(f32x4*)(fo + ch) = a; }
        }
    } else {
        float* dtr = WSP(float, W_DTRAW);
        if (wn == 0 && fq < 2) {
#pragma unroll
            for (int mi = 0; mi < 4; ++mi) *(f32x4*)(dtr + (size_t)(rb + mi * 16) * 8 + fq * 4) = acc[mi][0];
        }
    }
}
__device__ __forceinline__ void p1_memkv_tile(const Params& p, int mt, int nt, LAS char* lds) {
    TIDV;
    f32x4 acc[4][4]; zero_acc<4>(acc);
    const int m0 = mt * 128, n0 = nt * 128;
    mma_seg<128, 0>(acc, WSP(bf16_t, W_MEMB) + (size_t)m0 * 1024, 1024, WSP(bf16_t, W_WKV) + (size_t)n0 * 1024, 1024, 1024, lds, nullptr);
    const int rb = m0 + wm * 64 + fr, cb = n0 + wn * 64 + fq * 4;
    if (n0 < 1024) {
        bf16_t* kb = WSP(bf16_t, W_KB);
#pragma unroll
        for (int mi = 0; mi < 4; ++mi)
#pragma unroll
            for (int ni = 0; ni < 4; ++ni) { const f32x4 a = acc[mi][ni]; const size_t o_ = (size_t)(rb + mi * 16) * 1024 + cb + ni * 16;
                *(f32x4*)(p.out + O_MK + o_) = a; u32x2 o; o.x = pk2(a[0], a[1]); o.y = pk2(a[2], a[3]); *(u32x2*)(kb + o_) = o; }
    } else {
        bf16_t* vT = WSP(bf16_t, W_VT);
#pragma unroll
        for (int mi = 0; mi < 4; ++mi)
#pragma unroll
            for (int ni = 0; ni < 4; ++ni) { const f32x4 a = acc[mi][ni]; const int row = rb + mi * 16, c = cb - 1024 + ni * 16;
                *(f32x4*)(p.out + O_MV + (size_t)row * 1024 + c) = a;
                const int b = row >> 8, m = row & 255, head = c >> 8, d = c & 255;
                bf16_t* vp = vT + ((size_t)(b * 4 + head) * 256 + d) * 256 + m;
                const unsigned q0 = pk2(a[0], a[1]), q1 = pk2(a[2], a[3]);
                vp[0] = (bf16_t)(q0 & 0xffffu); vp[256] = (bf16_t)(q0 >> 16); vp[512] = (bf16_t)(q1 & 0xffffu); vp[768] = (bf16_t)(q1 >> 16); }
    }
}
__device__ __forceinline__ void phase1(const Params& p, LAS char* lds) {
    constexpr int T1 = 129 * 21, T2 = 16 * 16;
    int t;
    for (int i = 0; (t = sched(i, T1 + T2)) >= 0; ++i) {
        int mt, nt;
        if (t < T1) { tile_mn(t, 129, 21, mt, nt); p1_inproj_tile(p, mt, nt, lds); }
        else { tile_mn(t - T1, 16, 16, mt, nt); p1_memkv_tile(p, mt, nt, lds); }
    }
}

__device__ __forceinline__ void p2_conv(const Params& p, int item, LAS char* lds) {
    TIDV;
    const int cc = item >> 4, slab = item & 15, c = cc & 15, tok0 = cc * 128, ch0 = slab * 64;
    const int cgp = tid & 7, r0 = tid >> 3;
    LAS float* s_acum = (LAS float*)(lds + 40960); LAS float* s_dt = s_acum + 128; LAS float* s_tot = s_acum + 256;
    if (slab < 8) {
        const int h = slab;
        float v = 0.f, dtv = 0.f;
        if (tid < 128) {
            dtv = softplus_f(WSP(float, W_DTRAW)[(size_t)(tok0 + tid) * 8 + h] + p.in[15][h]);
            v = dtv * (-expf(p.in[16][h]));
#pragma unroll
            for (int d = 1; d < 64; d <<= 1) { const float t = __shfl_up(v, d); if (lane >= d) v += t; }
            if (lane == 63) s_tot[wid] = v;
        }
        __syncthreads();
        if (tid < 128) {
            if (wid == 1) v += s_tot[0];
            s_acum[tid] = v; s_dt[tid] = dtv;
            WSP(float, W_ACUM)[(size_t)(cc * 8 + h) * 128 + tid] = v;
            WSP(float, W_DTV)[(size_t)(cc * 8 + h) * 128 + tid] = dtv;
        }
        __syncthreads();
    }
    const bf16_t* xin = WSP(bf16_t, W_XBCB);
    const int chb = ch0 + cgp * 8;
    u32x4 rin[7];
#pragma unroll
    for (int i = 0; i < 7; ++i) {
        const int rr = r0 * 4 - 3 + i;
        if (rr < 0 && c == 0) rin[i] = (u32x4){0u, 0u, 0u, 0u};
        else rin[i] = *(const u32x4*)(xin + (size_t)(tok0 + rr) * 1024 + chb);
    }
    const float* cw = p.in[13]; const float* cbp = p.in[14];
    float o[4][8];
#pragma unroll
    for (int e = 0; e < 8; ++e) {
        const float w0 = cw[chb + e], w1 = cw[1024 + chb + e], w2 = cw[2048 + chb + e], w3 = cw[3072 + chb + e], bb = cbp[chb + e];
        float xin_[7];
#pragma unroll
        for (int i = 0; i < 7; ++i) { const unsigned u = (e >> 1) == 0 ? rin[i].x : (e >> 1) == 1 ? rin[i].y : (e >> 1) == 2 ? rin[i].z : rin[i].w; xin_[i] = (e & 1) ? bfhi(u) : bflo(u); }
#pragma unroll
        for (int r = 0; r < 4; ++r) o[r][e] = silu_f(bb + xin_[r] * w0 + xin_[r + 1] * w1 + xin_[r + 2] * w2 + xin_[r + 3] * w3);
    }
    {
        bf16_t* dstn; int ldn, cofs;
        if (slab < 8) { dstn = WSP(bf16_t, W_XN); ldn = 512; cofs = chb; }
        else if (slab < 12) { dstn = WSP(bf16_t, W_BN); ldn = 256; cofs = chb - 512; }
        else { dstn = WSP(bf16_t, W_CN); ldn = 256; cofs = chb - 768; }
#pragma unroll
        for (int r = 0; r < 4; ++r) { u32x4 q; q.x = pk2(o[r][0], o[r][1]); q.y = pk2(o[r][2], o[r][3]); q.z = pk2(o[r][4], o[r][5]); q.w = pk2(o[r][6], o[r][7]);
            *(u32x4*)(dstn + (size_t)(tok0 + r0 * 4 + r) * ldn + cofs) = q; }
    }
    if (slab < 12) {
        float wv[4] = {1.f, 1.f, 1.f, 1.f};
        if (slab < 8) { const float al_ = s_acum[127];
#pragma unroll
            for (int r = 0; r < 4; ++r) wv[r] = __expf(al_ - s_acum[r0 * 4 + r]) * s_dt[r0 * 4 + r]; }
#pragma unroll
        for (int e = 0; e < 8; ++e) {
            u32x2 q; q.x = pk2(o[0][e], o[1][e]); q.y = pk2(o[2][e], o[3][e]);
            *(LAS u32x2*)(lds + (cgp * 8 + e) * 256 + r0 * 8) = q;
            if (slab < 8) { u32x2 q2; q2.x = pk2(o[0][e] * wv[0], o[1][e] * wv[1]); q2.y = pk2(o[2][e] * wv[2], o[3][e] * wv[3]);
                *(LAS u32x2*)(lds + 16384 + (cgp * 8 + e) * 256 + r0 * 8) = q2; }
        }
        __syncthreads();
        bf16_t* d1; bf16_t* d2 = nullptr; size_t rowbase;
        if (slab < 8) { d1 = WSP(bf16_t, W_XT); d2 = WSP(bf16_t, W_XWT); rowbase = (size_t)(cc * 8 + slab) * 64; }
        else { const int g = (slab - 8) >> 1, half = (slab - 8) & 1; d1 = WSP(bf16_t, W_BT); rowbase = (size_t)(cc * 2 + g) * 128 + half * 64; }
#pragma unroll
        for (int i = 0; i < 4; ++i) {
            const int id = tid + 256 * i, pr = id >> 4, scn = id & 15;
            *(u32x4*)(d1 + (rowbase + pr) * 128 + scn * 8) = *(LAS u32x4*)(lds + pr * 256 + scn * 16);
            if (slab < 8) *(u32x4*)(d2 + (rowbase + pr) * 128 + scn * 8) = *(LAS u32x4*)(lds + 16384 + pr * 256 + scn * 16);
        }
    }
    __syncthreads();
}
__device__ __forceinline__ void p2_vln(const Params& p, int item, LAS char* lds) {
    TIDV;
    const int cc = item >> 2, head = item & 3, c = cc & 15, b = cc >> 4, tok0 = cc * 128;
    const int cgp = tid & 15, r0 = tid >> 4;
    const int chb = head * 128 + cgp * 8;
    const bf16_t* vg = WSP(bf16_t, W_VG); const float* vstat = WSP(float, W_ZERO);
    float lg[8], lb[8];
#pragma unroll
    for (int e = 0; e < 8; ++e) { lg[e] = p.in[9][chb + e]; lb[e] = p.in[10][chb + e]; }
    float o[8][8];
#pragma unroll
    for (int r = 0; r < 8; ++r) {
        const int tok = tok0 + r0 * 8 + r;
        const u32x4 q = *(const u32x4*)(vg + (size_t)tok * 512 + chb);
        const float mean = vstat[(size_t)tok * 2] * (1.f / 512.f);
        const float var = vstat[(size_t)tok * 2 + 1] * (1.f / 512.f) - mean * mean;
        const float rstd = rsqrtf(fmaxf(var, 0.f) + EPS);
        const float xv[8] = {bflo(q.x), bfhi(q.x), bflo(q.y), bfhi(q.y), bflo(q.z), bfhi(q.z), bflo(q.w), bfhi(q.w)};
#pragma unroll
        for (int e = 0; e < 8; ++e) o[r][e] = (xv[e] - mean) * rstd * lg[e] + lb[e];
        if (c == 15) {
            float* go = p.out + O_GVP + ((size_t)(b * 128 + r0 * 8 + r)) * 512 + chb;
            *(f32x4*)go = (f32x4){o[r][0], o[r][1], o[r][2], o[r][3]}; *(f32x4*)(go + 4) = (f32x4){o[r][4], o[r][5], o[r][6], o[r][7]};
        }
    }
#pragma unroll
    for (int e = 0; e < 8; ++e) {
        u32x4 q; q.x = pk2(o[0][e], o[1][e]); q.y = pk2(o[2][e], o[3][e]); q.z = pk2(o[4][e], o[5][e]); q.w = pk2(o[6][e], o[7][e]);
        *(LAS u32x4*)(lds + (cgp * 8 + e) * 256 + r0 * 16) = q;
    }
    __syncthreads();
    bf16_t* dst = WSP(bf16_t, W_VLNT) + (size_t)(cc * 4 + head) * 128 * 128;
#pragma unroll
    for (int i = 0; i < 8; ++i) { const int id = tid + 256 * i, pr = id >> 4, scn = id & 15;
        *(u32x4*)(dst + (size_t)pr * 128 + scn * 8) = *(LAS u32x4*)(lds + pr * 256 + scn * 16); }
    __syncthreads();
}
__device__ __forceinline__ void p2_sample_ssd(const Params& p, int item, LAS char* lds) {
    TIDV;
    const int bs = item >> 3, h = item & 7, g = h >> 2;
    LAS float* s_x = (LAS float*)lds; LAS float* s_B = s_x + 64; LAS float* s_C = s_B + 128; LAS float* s_y = s_C + 128;
    const float* scv = p.in[3] + (size_t)bs * 3 * 1024;
    const float* xrow = p.out + O_CONVS + ((size_t)bs * 3 + 2) * 1024;
    const float* cw = p.in[13]; const float* cbp = p.in[14];
    for (int idx = tid; idx < 320; idx += 256) {
        int ch; if (idx < 64) ch = h * 64 + idx; else if (idx < 192) ch = 512 + g * 128 + (idx - 64); else ch = 768 + g * 128 + (idx - 192);
        const float v = cbp[ch] + scv[ch] * cw[ch] + scv[1024 + ch] * cw[1024 + ch] + scv[2048 + ch] * cw[2048 + ch] + xrow[ch] * cw[3072 + ch];
        s_x[idx] = silu_f(v);
    }
    __syncthreads();
    const float dt = softplus_f(WSP(float, W_DTRAW)[(size_t)(MP + bs) * 8 + h] + p.in[15][h]);
    const float dA = expf(dt * (-expf(p.in[16][h])));
    const int l = tid & 31, rg = tid >> 5;
    const f32x4 Bv = *(LAS f32x4*)(s_B + l * 4), Cv = *(LAS f32x4*)(s_C + l * 4);
    const float* h0 = p.in[2] + ((size_t)(bs * 8 + h) * 64) * 128;
    float* ho = p.out + O_SSMS + ((size_t)(bs * 8 + h) * 64) * 128;
    f32x4 hv[8];
#pragma unroll
    for (int i = 0; i < 8; ++i) hv[i] = *(const f32x4*)(h0 + (size_t)(rg + 8 * i) * 128 + l * 4);
#pragma unroll
    for (int i = 0; i < 8; ++i) {
        const int pp = rg + 8 * i;
        const float dx = dt * s_x[pp];
        f32x4 hn = hv[i] * dA + Bv * dx;
        *(f32x4*)(ho + (size_t)pp * 128 + l * 4) = hn;
        float y = hn[0] * Cv[0] + hn[1] * Cv[1] + hn[2] * Cv[2] + hn[3] * Cv[3];
        y += __shfl_xor(y, 16); y += __shfl_xor(y, 8); y += __shfl_xor(y, 4); y += __shfl_xor(y, 2); y += __shfl_xor(y, 1);
        if (l == 0) s_y[pp] = y;
    }
    __syncthreads();
    if (tid < 64) {
        const float xv = s_x[tid];
        const float y = s_y[tid] + p.in[17][h] * xv;
        const float z = bf2f(WSP(bf16_t, W_ZB)[(size_t)(MP + bs) * 512 + h * 64 + tid]);
        const float yz = y * silu_f(z);
        const unsigned q = pk2(yz, 0.f) & 0xffffu;
        WSP(bf16_t, W_CONCAT)[(size_t)(MP + bs) * 1024 + 512 + h * 64 + tid] = (bf16_t)q;
        const float yr = bflo(q);
        const float ssq = wave_sum(yr * yr);
        if (tid == 0) atomicAdd(WSP(float, W_ZERO) + (size_t)MT * 2 + (size_t)(MP + bs) * 2 + g, ssq);
    }
    __syncthreads();
}
__device__ __forceinline__ void p2_sample_misc(const Params& p, int bs) {
    TIDV;
    const float* vstat = WSP(float, W_ZERO);
    const int tok = MP + bs;
    const float mean = vstat[(size_t)tok * 2] * (1.f / 512.f);
    const float var = vstat[(size_t)tok * 2 + 1] * (1.f / 512.f) - mean * mean;
    const float rstd = rsqrtf(fmaxf(var, 0.f) + EPS);
    for (int ch = tid; ch < 512; ch += 256) {
        const int hd = ch >> 7;
        const float v = bf2f(WSP(bf16_t, W_VG)[(size_t)tok * 512 + ch]);
        const float vl = (v - mean) * rstd * p.in[9][ch] + p.in[10][ch];
        p.out[O_GVS + (size_t)bs * 512 + ch] = vl;
        const float u = bf2f(WSP(bf16_t, W_UB)[(size_t)tok * 512 + ch]);
        const float gout = u * (p.in[11][hd * 128 * 128] * vl + p.in[12][hd * 128]);
        WSP(bf16_t, W_CONCAT)[(size_t)tok * 1024 + ch] = (bf16_t)(pk2(gout, 0.f) & 0xffffu);
    }
    const float* scv = p.in[3] + (size_t)bs * 3 * 1024;
    float* co = p.out + O_CONVS + (size_t)bs * 3 * 1024;
    for (int i = tid; i < 2048; i += 256) co[i] = scv[1024 + i];
}
__device__ __forceinline__ void phase2(const Params& p, LAS char* lds) {
    constexpr int N1 = 1024, N2 = 2048, N3 = 512, N4 = 128;
    for (int it = blockIdx.x; it < N1 + N2 + N3 + N4; it += gridDim.x) {
        if (it < N1) p2_sample_ssd(p, it, lds);
        else if (it < N1 + N2) p2_conv(p, it - N1, lds);
        else if (it < N1 + N2 + N3) p2_vln(p, it - N1 - N2, lds);
        else p2_sample_misc(p, it - N1 - N2 - N3);
    }
}

__device__ __forceinline__ void p3_cb(const Params& p, int item, LAS char* lds) {
    TIDV;
    const int cc = item >> 1, g = item & 1, tok0 = cc * 128;
    f32x4 acc[4][4]; zero_acc<4>(acc);
    mma_seg<128, 0>(acc, WSP(bf16_t, W_CN) + (size_t)tok0 * 256 + g * 128, 256, WSP(bf16_t, W_BN) + (size_t)tok0 * 256 + g * 128, 256, 128, lds, nullptr);
    const int tb = wm * 64 + fr, sb = wn * 64 + fq * 4;
#pragma unroll 1
    for (int jh = 0; jh < 4; ++jh) {
        const int h = g * 4 + jh;
        const float* ac = WSP(float, W_ACUM) + (size_t)(cc * 8 + h) * 128;
        const float* dv = WSP(float, W_DTV) + (size_t)(cc * 8 + h) * 128;
        bf16_t* mt_ = WSP(bf16_t, W_MT) + (size_t)(cc * 8 + h) * 128 * 128;
        float at[4];
#pragma unroll
        for (int mi = 0; mi < 4; ++mi) at[mi] = ac[tb + mi * 16];
#pragma unroll
        for (int ni = 0; ni < 4; ++ni) {
            const f32x4 as = *(const f32x4*)(ac + sb + ni * 16), ds = *(const f32x4*)(dv + sb + ni * 16);
#pragma unroll
            for (int mi = 0; mi < 4; ++mi) {
                const int t = tb + mi * 16, s0 = sb + ni * 16;
                float v[4];
#pragma unroll
                for (int j = 0; j < 4; ++j) v[j] = (s0 + j <= t) ? acc[mi][ni][j] * __expf(at[mi] - as[j]) * ds[j] : 0.f;
                u32x2 o; o.x = pk2(v[0], v[1]); o.y = pk2(v[2], v[3]);
                *(u32x2*)(mt_ + (size_t)t * 128 + s0) = o;
            }
        }
    }
}
__device__ __forceinline__ void p3_gmlp(const Params& p, int item, LAS char* lds) {
    TIDV;
    const int cc = item >> 2, head = item & 3, tok0 = cc * 128;
    f32x4 acc[4][4]; zero_acc<4>(acc);
    mma_seg<128, 0>(acc, WSP(bf16_t, W_WSB) + (size_t)head * 128 * 128, 128, WSP(bf16_t, W_VLNT) + (size_t)(cc * 4 + head) * 128 * 128, 128, 128, lds, nullptr);
    const int tb = wm * 64 + fr, db = wn * 64 + fq * 4;
    const bf16_t* ub = WSP(bf16_t, W_UB); bf16_t* cat = WSP(bf16_t, W_CONCAT);
#pragma unroll
    for (int mi = 0; mi < 4; ++mi) {
        const int t = tb + mi * 16;
        const float bias = p.in[12][head * 128 + t];
#pragma unroll
        for (int ni = 0; ni < 4; ++ni) {
            const int d = db + ni * 16;
            const u32x2 uq = *(const u32x2*)(ub + (size_t)(tok0 + t) * 512 + head * 128 + d);
            const f32x4 a = acc[mi][ni];
            u32x2 o; o.x = pk2((a[0] + bias) * bflo(uq.x), (a[1] + bias) * bfhi(uq.x)); o.y = pk2((a[2] + bias) * bflo(uq.y), (a[3] + bias) * bfhi(uq.y));
            *(u32x2*)(cat + (size_t)(tok0 + t) * 1024 + head * 128 + d) = o;
        }
    }
}
__device__ __forceinline__ void p3_states(const Params& p, int item, LAS char* lds) {
    TIDV;
    const int cc = item >> 3, h = item & 7, g = h >> 2;
    f32x4 acc[4][2]; zero_acc<2>(acc);
    mma_seg<64, 0>(acc, WSP(bf16_t, W_BT) + (size_t)(cc * 2 + g) * 128 * 128, 128, WSP(bf16_t, W_XWT) + (size_t)(cc * 8 + h) * 64 * 128, 128, 128, lds, nullptr);
    float* sc = WSP(float, W_SC) + (size_t)(cc * 8 + h) * 64 * 128;
    const int nb = wm * 64 + fr, pb = wn * 32 + fq * 4;
#pragma unroll
    for (int mi = 0; mi < 4; ++mi)
#pragma unroll
        for (int ni = 0; ni < 2; ++ni)
#pragma unroll
            for (int j = 0; j < 4; ++j) sc[(size_t)(pb + ni * 16 + j) * 128 + nb + mi * 16] = acc[mi][ni][j];
}
__device__ __forceinline__ void phase3(const Params& p, LAS char* lds) {
    constexpr int N1 = 256, N2 = 512, N3 = 1024;
    for (int it = blockIdx.x; it < N1 + N2 + N3; it += gridDim.x) {
        if (it < N1) p3_cb(p, it, lds);
        else if (it < N1 + N2) p3_gmlp(p, it - N1, lds);
        else p3_states(p, it - N1 - N2, lds);
    }
}

__device__ __forceinline__ void phase4(const Params& p) {
    for (int it = blockIdx.x; it < 512; it += gridDim.x) {
        const int idx4 = it * 256 + threadIdx.x;
        const int bh = idx4 >> 11, rem = (idx4 & 2047) * 4, b = bh >> 3, h = bh & 7;
        f32x4 st = {0.f, 0.f, 0.f, 0.f};
        const float* sc = WSP(float, W_SC); bf16_t* hp_ = WSP(bf16_t, W_HPREV); const float* ac = WSP(float, W_ACUM);
        f32x4 nxt = *(const f32x4*)(sc + ((size_t)((b * 16) * 8 + h)) * 8192 + rem);
#pragma unroll 1
        for (int c = 0; c < 16; ++c) {
            const size_t base = ((size_t)((b * 16 + c) * 8 + h)) * 8192 + rem;
            const f32x4 cur = nxt;
            if (c + 1 < 16) nxt = *(const f32x4*)(sc + base + 8 * 8192);
            u32x2 o; o.x = pk2(st[0], st[1]); o.y = pk2(st[2], st[3]);
            *(u32x2*)(hp_ + base) = o;
            const float dec = __expf(ac[(size_t)((b * 16 + c) * 8 + h) * 128 + 127]);
            st = st * dec + cur;
        }
        *(f32x4*)(p.out + O_SSMP + (size_t)idx4 * 4) = st;
    }
}

__device__ __forceinline__ void p5_y(const Params& p, int item, LAS char* lds) {
    TIDV;
    const int cc = item >> 3, h = item & 7, g = h >> 2, tok0 = cc * 128;
    f32x4 acc[4][2]; zero_acc<2>(acc);
    mma_seg<64, 0>(acc, WSP(bf16_t, W_CN) + (size_t)tok0 * 256 + g * 128, 256, WSP(bf16_t, W_HPREV) + (size_t)(cc * 8 + h) * 64 * 128, 128, 128, lds, nullptr);
    const float* ac = WSP(float, W_ACUM) + (size_t)(cc * 8 + h) * 128;
    const int tb = wm * 64 + fr, pb = wn * 32 + fq * 4;
#pragma unroll
    for (int mi = 0; mi < 4; ++mi) { const float e = __expf(ac[tb + mi * 16]);
#pragma unroll
        for (int ni = 0; ni < 2; ++ni) acc[mi][ni] = acc[mi][ni] * e; }
    mma_seg<64, 0>(acc, WSP(bf16_t, W_MT) + (size_t)(cc * 8 + h) * 128 * 128, 128, WSP(bf16_t, W_XT) + (size_t)(cc * 8 + h) * 64 * 128, 128, 128, lds, nullptr);
    const float dsk = p.in[17][h];
    const bf16_t* xn = WSP(bf16_t, W_XN); const bf16_t* zb = WSP(bf16_t, W_ZB); bf16_t* cat = WSP(bf16_t, W_CONCAT);
    float* gss = WSP(float, W_ZERO) + (size_t)MT * 2;
#pragma unroll
    for (int mi = 0; mi < 4; ++mi) {
        const int tok = tok0 + tb + mi * 16;
        float ssq = 0.f;
#pragma unroll
        for (int ni = 0; ni < 2; ++ni) {
            const int pc = h * 64 + pb + ni * 16;
            const u32x2 xq = *(const u32x2*)(xn + (size_t)tok * 512 + pc), zq = *(const u32x2*)(zb + (size_t)tok * 512 + pc);
            const f32x4 a = acc[mi][ni];
            const float y0 = (a[0] + dsk * bflo(xq.x)) * silu_f(bflo(zq.x)), y1 = (a[1] + dsk * bfhi(xq.x)) * silu_f(bfhi(zq.x));
            const float y2 = (a[2] + dsk * bflo(xq.y)) * silu_f(bflo(zq.y)), y3 = (a[3] + dsk * bfhi(xq.y)) * silu_f(bfhi(zq.y));
            u32x2 o; o.x = pk2(y0, y1); o.y = pk2(y2, y3);
            const float r0 = bflo(o.x), r1 = bfhi(o.x), r2 = bflo(o.y), r3 = bfhi(o.y);
            ssq += (r0 * r0 + r1 * r1) + (r2 * r2 + r3 * r3);
            *(u32x2*)(cat + (size_t)tok * 1024 + 512 + pc) = o;
        }
        ssq = fq_sum(ssq);
        if (fq == 0) atomicAdd(gss + (size_t)tok * 2 + g, ssq);
    }
}
__device__ __forceinline__ void phase5(const Params& p, LAS char* lds) {
    for (int it = blockIdx.x; it < 1024; it += gridDim.x) p5_y(p, it, lds);
}

template <int MODE>
__device__ __forceinline__ void res_gemm_tile(const Params& p, int mt, int nt, LAS char* lds) {
    TIDV;
    f32x4 acc[4][4]; zero_acc<4>(acc);
    const int m0 = mt * 128, n0 = nt * 128;
    if (MODE == 0) {
        const bf16_t* Ab = WSP(bf16_t, W_CONCAT) + (size_t)m0 * 1024; const bf16_t* Wb = WSP(bf16_t, W_WOUT) + (size_t)n0 * 1024;
        const float* gss = WSP(float, W_ZERO) + (size_t)MT * 2;
        float r0[4], r1[4];
#pragma unroll
        for (int mi = 0; mi < 4; ++mi) { const int row = m0 + wm * 64 + mi * 16 + fr;
            r0[mi] = rsqrtf(gss[(size_t)row * 2] * (1.f / 256.f) + EPS); r1[mi] = rsqrtf(gss[(size_t)row * 2 + 1] * (1.f / 256.f) + EPS); }
        mma_seg<128, 0>(acc, Ab + 512, 1024, Wb + 512, 1024, 256, lds, nullptr);
#pragma unroll
        for (int mi = 0; mi < 4; ++mi) { const float f = r0[mi] / r1[mi];
#pragma unroll
            for (int ni = 0; ni < 4; ++ni) acc[mi][ni] = acc[mi][ni] * f; }
        mma_seg<128, 0>(acc, Ab + 768, 1024, Wb + 768, 1024, 256, lds, nullptr);
#pragma unroll
        for (int mi = 0; mi < 4; ++mi)
#pragma unroll
            for (int ni = 0; ni < 4; ++ni) acc[mi][ni] = acc[mi][ni] * r1[mi];
        mma_seg<128, 0>(acc, Ab, 1024, Wb, 1024, 512, lds, nullptr);
    }
    else if (MODE == 1) mma_seg<128, 0>(acc, WSP(bf16_t, W_OB) + (size_t)m0 * 1024, 1024, WSP(bf16_t, W_WXO) + (size_t)n0 * 1024, 1024, 1024, lds, nullptr);
    else mma_seg<128, 0>(acc, WSP(bf16_t, W_ACT) + (size_t)m0 * 2816, 2816, WSP(bf16_t, W_WD) + (size_t)n0 * 2816, 2816, 2816, lds, nullptr);
    const int rb = m0 + wm * 64 + fr, cb = n0 + wn * 64 + fq * 4;
    float* hp = WSP(float, W_HP); bf16_t* hpb = WSP(bf16_t, W_HPB);
    float* ssq_ = WSP(float, W_ZERO) + (size_t)MT * 4 + (size_t)MT * MODE;
#pragma unroll
    for (int mi = 0; mi < 4; ++mi) {
        const int row = rb + mi * 16;
        const float* rsrc;
        if (MODE == 0) rsrc = row < MP ? p.in[0] + (size_t)row * 1024 : p.in[1] + (size_t)(row - MP) * 1024;
        else rsrc = hp + (size_t)row * 1024;
        float ssq = 0.f;
#pragma unroll
        for (int ni = 0; ni < 4; ++ni) {
            const int col = cb + ni * 16;
            const f32x4 r = *(const f32x4*)(rsrc + col);
            const f32x4 v = acc[mi][ni] + r;
            *(f32x4*)(hp + (size_t)row * 1024 + col) = v;
            ssq += (v[0] * v[0] + v[1] * v[1]) + (v[2] * v[2] + v[3] * v[3]);
            if (MODE != 2) { u32x2 o; o.x = pk2(v[0], v[1]); o.y = pk2(v[2], v[3]); *(u32x2*)(hpb + (size_t)row * 1024 + col) = o; }
        }
        if (MODE != 2) { ssq = fq_sum(ssq); if (fq == 0) atomicAdd(ssq_ + row, ssq); }
    }
}
template <int MODE>
__device__ __forceinline__ void phase_res(const Params& p, LAS char* lds) {
    int t;
    for (int i = 0; (t = sched(i, 129 * 8)) >= 0; ++i) { int mt, nt; tile_mn(t, 129, 8, mt, nt); res_gemm_tile<MODE>(p, mt, nt, lds); }
}
__device__ __forceinline__ void p11_sample_item(const Params& p, int j, LAS char* lds) {
    TIDV;
    const int nt = j & 7, ks = j >> 3, n0 = nt * 128;
    f32x4 acc[4][4]; zero_acc<4>(acc);
    mma_seg<128, 0>(acc, WSP(bf16_t, W_ACT) + (size_t)MP * 2816 + ks * 704, 2816, WSP(bf16_t, W_WD) + (size_t)n0 * 2816 + ks * 704, 2816, 704, lds, nullptr);
    float* hp = WSP(float, W_HP);
    const int rb = MP + wm * 64 + fr, cb = n0 + wn * 64 + fq * 4;
#pragma unroll
    for (int mi = 0; mi < 4; ++mi)
#pragma unroll
        for (int ni = 0; ni < 4; ++ni)
#pragma unroll
            for (int jj = 0; jj < 4; ++jj) atomicAdd(hp + (size_t)(rb + mi * 16) * 1024 + cb + ni * 16 + jj, acc[mi][ni][jj]);
}
__device__ __forceinline__ void phase11(const Params& p, LAS char* lds) {
    if ((blockIdx.x & 15) == 0 && (blockIdx.x >> 4) < 32) p11_sample_item(p, blockIdx.x >> 4, lds);
    int t;
    for (int i = 0; (t = sched(i, 128 * 8)) >= 0; ++i) { int mt, nt; tile_mn(t, 128, 8, mt, nt); res_gemm_tile<2>(p, mt, nt, lds); }
}

__device__ __forceinline__ void phase7(const Params& p, LAS char* lds) {
    TIDV;
    int t;
    for (int i = 0; (t = sched(i, 129 * 8)) >= 0; ++i) {
        int mt, nt; tile_mn(t, 129, 8, mt, nt);
        f32x4 acc[4][4]; zero_acc<4>(acc);
        const int m0 = mt * 128, n0 = nt * 128;
        mma_seg<128, 0>(acc, WSP(bf16_t, W_HPB) + (size_t)m0 * 1024, 1024, WSP(bf16_t, W_WQ) + (size_t)n0 * 1024, 1024, 1024, lds, nullptr);
        const int rb = m0 + wm * 64 + fr, cb = n0 + wn * 64 + fq * 4;
        const float* ss1 = WSP(float, W_ZERO) + (size_t)MT * 4;
        bf16_t* qb = WSP(bf16_t, W_QB);
#pragma unroll
        for (int mi = 0; mi < 4; ++mi) {
            const int row = rb + mi * 16;
            const float rs = rsqrtf(ss1[row] * (1.f / 1024.f) + EPS);
#pragma unroll
            for (int ni = 0; ni < 4; ++ni) { const f32x4 a = acc[mi][ni] * rs; u32x2 o; o.x = pk2(a[0], a[1]); o.y = pk2(a[2], a[3]);
                *(u32x2*)(qb + (size_t)row * 1024 + cb + ni * 16) = o; }
        }
    }
}

__device__ __forceinline__ void p8_prompt(const Params& p, int item, LAS char* lds) {
    TIDV;
    const int qt = item & 15, head = (item >> 4) & 3, b = item >> 6;
    const int tokq = b * 2048 + qt * 128;
    const bf16_t* qa = WSP(bf16_t, W_QB) + (size_t)tokq * 1024 + head * 256;
    const bf16_t* kbp = WSP(bf16_t, W_KB) + (size_t)(b * 256) * 1024 + head * 256;
    f32x4 s0[4][4], s1[4][4]; zero_acc<4>(s0); zero_acc<4>(s1);
    mma_seg<128, 0>(s0, qa, 1024, kbp, 1024, 256, lds, nullptr);
    mma_seg<128, 0>(s1, qa, 1024, kbp + (size_t)128 * 1024, 1024, 256, lds, nullptr);
    LAS float* red = (LAS float*)(lds + LDS_MISC + 64);
    float rinv[4];
    float mx[4];
#pragma unroll
    for (int mi = 0; mi < 4; ++mi) {
        float m = -3.0e38f;
#pragma unroll
        for (int ni = 0; ni < 4; ++ni)
#pragma unroll
            for (int j = 0; j < 4; ++j) m = fmaxf(m, fmaxf(s0[mi][ni][j], s1[mi][ni][j]));
        m = fq_max(m);
        if (fq == 0) red[wn * 128 + wm * 64 + mi * 16 + fr] = m;
        mx[mi] = m;
    }
    __syncthreads();
#pragma unroll
    for (int mi = 0; mi < 4; ++mi) mx[mi] = fmaxf(mx[mi], red[(wn ^ 1) * 128 + wm * 64 + mi * 16 + fr]);
#pragma unroll
    for (int mi = 0; mi < 4; ++mi) {
        float sum = 0.f;
        const int t = wm * 64 + mi * 16 + fr;
#pragma unroll
        for (int ni = 0; ni < 4; ++ni) {
            const int mcol = wn * 64 + ni * 16 + fq * 4;
            u32x2 o0, o1;
            o0.x = pk2(__expf(s0[mi][ni][0] - mx[mi]), __expf(s0[mi][ni][1] - mx[mi])); o0.y = pk2(__expf(s0[mi][ni][2] - mx[mi]), __expf(s0[mi][ni][3] - mx[mi]));
            o1.x = pk2(__expf(s1[mi][ni][0] - mx[mi]), __expf(s1[mi][ni][1] - mx[mi])); o1.y = pk2(__expf(s1[mi][ni][2] - mx[mi]), __expf(s1[mi][ni][3] - mx[mi]));
            sum += (bflo(o0.x) + bfhi(o0.x)) + (bflo(o0.y) + bfhi(o0.y)) + (bflo(o1.x) + bfhi(o1.x)) + (bflo(o1.y) + bfhi(o1.y));
            const int c0 = mcol >> 3, c1 = (mcol + 128) >> 3, sub = (mcol & 7) * 2;
            *(LAS u32x2*)(lds + t * 512 + ((c0 ^ (t & 15)) << 4) + sub) = o0;
            *(LAS u32x2*)(lds + t * 512 + ((c1 ^ (t & 15)) << 4) + sub) = o1;
        }
        sum = fq_sum(sum);
        if (fq == 0) red[256 + wn * 128 + t] = sum;
        rinv[mi] = sum;
        __builtin_amdgcn_sched_barrier(0);
    }
    __syncthreads();
#pragma unroll
    for (int mi = 0; mi < 4; ++mi) rinv[mi] = 1.f / (rinv[mi] + red[256 + (wn ^ 1) * 128 + wm * 64 + mi * 16 + fr]);
    const bf16_t* vtp = WSP(bf16_t, W_VT) + (size_t)(b * 4 + head) * 256 * 256;
    bf16_t* ob = WSP(bf16_t, W_OB);
#pragma unroll 1
    for (int nn = 0; nn < 2; ++nn) {
        f32x4 acc[4][4]; zero_acc<4>(acc);
        const bf16_t* vb = vtp + (size_t)(nn * 128 + wn * 64 + fr) * 256 + fq * 8;
        bf16x8 bcur[4], bnxt[4];
#pragma unroll
        for (int ni = 0; ni < 4; ++ni) bcur[ni] = *(const bf16x8*)(vb + (size_t)(ni * 16) * 256);
#pragma unroll 1
        for (int kk = 0; kk < 8; ++kk) {
            if (kk + 1 < 8) {
#pragma unroll
                for (int ni = 0; ni < 4; ++ni) bnxt[ni] = *(const bf16x8*)(vb + (size_t)(ni * 16) * 256 + (kk + 1) * 32);
            }
            bf16x8 af[4];
#pragma unroll
            for (int mi = 0; mi < 4; ++mi) { const int t = wm * 64 + mi * 16 + fr; af[mi] = *(LAS bf16x8*)(lds + t * 512 + (((kk * 4 + fq) ^ (t & 15)) << 4)); }
#pragma unroll
            for (int mi = 0; mi < 4; ++mi)
#pragma unroll
                for (int ni = 0; ni < 4; ++ni) acc[mi][ni] = __builtin_amdgcn_mfma_f32_16x16x32_bf16(bcur[ni], af[mi], acc[mi][ni], 0, 0, 0);
            if (kk + 1 < 8) {
#pragma unroll
                for (int ni = 0; ni < 4; ++ni) bcur[ni] = bnxt[ni];
            }
        }
#pragma unroll
        for (int mi = 0; mi < 4; ++mi)
#pragma unroll
            for (int ni = 0; ni < 4; ++ni) { const f32x4 a = acc[mi][ni] * rinv[mi]; u32x2 o; o.x = pk2(a[0], a[1]); o.y = pk2(a[2], a[3]);
                *(u32x2*)(ob + (size_t)(tokq + wm * 64 + mi * 16 + fr) * 1024 + head * 256 + nn * 128 + wn * 64 + ni * 16 + fq * 4) = o; }
    }
    __syncthreads();
}
__device__ __forceinline__ void p8_sample(const Params& p, int item, LAS char* lds) {
    TIDV;
    const int bs = item >> 2, head = item & 3;
    LAS float* s_q = (LAS float*)lds; LAS float* s_sc = s_q + 256; LAS float* s_red = s_sc + 256; LAS float* s_part = s_red + 16;
    s_q[tid] = bf2f(WSP(bf16_t, W_QB)[(size_t)(MP + bs) * 1024 + head * 256 + tid]);
    __syncthreads();
    const f32x4 qv = *(LAS f32x4*)(s_q + lane * 4);
    const float* kc = p.in[4] + ((size_t)(bs * 256) * 4 + head) * 256 + lane * 4;
    const float* vc = p.in[5] + ((size_t)(bs * 256) * 4 + head) * 256 + lane * 4;
#pragma unroll 1
    for (int i = 0; i < 64; i += 8) {
        f32x4 kv[8];
#pragma unroll
        for (int u = 0; u < 8; ++u) kv[u] = *(const f32x4*)(kc + (size_t)(wid * 64 + i + u) * 1024);
#pragma unroll
        for (int u = 0; u < 8; ++u) { float d = kv[u][0] * qv[0] + kv[u][1] * qv[1] + kv[u][2] * qv[2] + kv[u][3] * qv[3]; d = wave_sum(d); if (lane == 0) s_sc[wid * 64 + i + u] = d; }
    }
    __syncthreads();
    const float sv = s_sc[tid];
    float m = wave_max(sv);
    if (lane == 0) s_red[wid] = m;
    __syncthreads();
    m = fmaxf(fmaxf(s_red[0], s_red[1]), fmaxf(s_red[2], s_red[3]));
    const float e = __expf(sv - m);
    float sm = wave_sum(e);
    if (lane == 0) s_red[4 + wid] = sm;
    s_sc[tid] = e;
    __syncthreads();
    const float inv = 1.f / ((s_red[4] + s_red[5]) + (s_red[6] + s_red[7]));
    f32x4 o = {0.f, 0.f, 0.f, 0.f};
#pragma unroll 1
    for (int i = 0; i < 64; i += 8) {
        f32x4 vv[8];
#pragma unroll
        for (int u = 0; u < 8; ++u) vv[u] = *(const f32x4*)(vc + (size_t)(wid * 64 + i + u) * 1024);
#pragma unroll
        for (int u = 0; u < 8; ++u) o = o + vv[u] * s_sc[wid * 64 + i + u];
    }
    *(LAS f32x4*)(s_part + wid * 256 + lane * 4) = o;
    __syncthreads();
    const float r = ((s_part[tid] + s_part[256 + tid]) + (s_part[512 + tid] + s_part[768 + tid])) * inv;
    WSP(bf16_t, W_OB)[(size_t)(MP + bs) * 1024 + head * 256 + tid] = (bf16_t)(pk2(r, 0.f) & 0xffffu);
    __syncthreads();
}
__device__ __forceinline__ void phase8(const Params& p, LAS char* lds) {
    const int flip = (blockIdx.x ^ (blockIdx.x >> 8)) & 1;
    for (int j = 0; j < 2; ++j) {
        for (int it = blockIdx.x + ((j ^ flip) ? 512 : 0); it < ((j ^ flip) ? 1024 : 512); it += gridDim.x) {
            if (it < 512) p8_sample(p, it, lds); else p8_prompt(p, it - 512, lds);
        }
    }
}

__device__ __forceinline__ void phase10(const Params& p, LAS char* lds) {
    TIDV;
    int t;
    for (int i = 0; (t = sched(i, 129 * 44)) >= 0; ++i) {
        int mt, nt; tile_mn(t, 129, 44, mt, nt);
        f32x4 acc[4][4]; zero_acc<4>(acc);
        const int m0 = mt * 128, n0 = nt * 128;
        mma_seg<128, 0>(acc, WSP(bf16_t, W_HPB) + (size_t)m0 * 1024, 1024, WSP(bf16_t, W_WGU) + (size_t)n0 * 1024, 1024, 1024, lds, nullptr);
        const int rb = m0 + wm * 64 + fr, cb = (n0 + wn * 64) / 2 + fq * 4;
        const float* ss2 = WSP(float, W_ZERO) + (size_t)MT * 5;
        bf16_t* act = WSP(bf16_t, W_ACT);
#pragma unroll
        for (int mi = 0; mi < 4; ++mi) {
            const int row = rb + mi * 16;
            const float rs = rsqrtf(ss2[row] * (1.f / 1024.f) + EPS);
#pragma unroll
            for (int q = 0; q < 2; ++q) {
                const f32x4 g = acc[mi][2 * q] * rs, u = acc[mi][2 * q + 1] * rs;
                u32x2 o; o.x = pk2(silu_f(g[0]) * u[0], silu_f(g[1]) * u[1]); o.y = pk2(silu_f(g[2]) * u[2], silu_f(g[3]) * u[3]);
                *(u32x2*)(act + (size_t)row * 2816 + cb + q * 16) = o;
            }
        }
    }
}

__device__ __forceinline__ void phase12(const Params& p) {
    const float* hp = WSP(float, W_HP); const float* g = p.in[30];
    const int lane = threadIdx.x & 63, wid = threadIdx.x >> 6;
    for (int it = blockIdx.x; it < MT / 4; it += gridDim.x) {
        const int row = it * 4 + wid;
        const float* src = hp + (size_t)row * 1024;
        f32x4 v[4]; float ss = 0.f;
#pragma unroll
        for (int j = 0; j < 4; ++j) { v[j] = *(const f32x4*)(src + (j * 64 + lane) * 4); ss += (v[j][0] * v[j][0] + v[j][1] * v[j][1]) + (v[j][2] * v[j][2] + v[j][3] * v[j][3]); }
        const float rs = rsqrtf(wave_sum(ss) * (1.f / 1024.f) + EPS);
#pragma unroll
        for (int j = 0; j < 4; ++j) { const f32x4 gv = *(const f32x4*)(g + (j * 64 + lane) * 4);
            *(f32x4*)(p.out + (size_t)row * 1024 + (j * 64 + lane) * 4) = v[j] * rs * gv; }
    }
}

#ifndef DUMP_SEL
#define DUMP_SEL 0
#endif
__device__ __forceinline__ void phase_dump(const Params& p) {
    const int n = MT * 1024;
    for (int i = blockIdx.x * 256 + threadIdx.x; i < n; i += gridDim.x * 256) {
        float v = 0.f;
        if (DUMP_SEL == 1) v = bf2f(WSP(bf16_t, W_CONCAT)[i]);
        else if (DUMP_SEL == 2) v = WSP(float, W_HP)[i];
        else if (DUMP_SEL == 3) v = bf2f(WSP(bf16_t, W_QB)[i]);
        else if (DUMP_SEL == 4) v = bf2f(WSP(bf16_t, W_OB)[i]);
        else if (DUMP_SEL == 5) v = bf2f(WSP(bf16_t, W_HPB)[i]);
        else if (DUMP_SEL == 6) v = bf2f(WSP(bf16_t, W_ACT)[(size_t)(i >> 10) * 2816 + (i & 1023)]);
        p.out[i] = v;
    }
}
__global__ void __launch_bounds__(256, 2) hymba_fwd(Params p) {
    extern __shared__ __attribute__((aligned(16))) char smem_dyn[];
    LAS char* lds = (LAS char*)smem_dyn;
    XcdBarrier xb;
    if (p.fused) {
        if (p.never) cg::this_grid().sync();
        volatile LAS unsigned* st = (volatile LAS unsigned*)(lds + LDS_MISC);
        if (threadIdx.x < 4) st[threadIdx.x] = 0u;
        __syncthreads();
        xb = xcd_barrier_post(WSP(unsigned, W_BAR), st);
    }
#ifndef DUP_MASK
#define DUP_MASK (1<<7)
#endif
#define RUN_PH(k, call) if (p.ph_lo <= (k) && (k) < p.ph_hi) { if ((DUP_MASK >> (k)) & 1) { call; xcd_barrier(xb); } call; if (p.fused && (k) + 1 < p.ph_hi) xcd_barrier(xb); }
#define PH_ON(n) (!defined(ONLY_PH) || ONLY_PH == n)
#ifndef PRE_MASK
#define PRE_MASK 0
#endif
    if (p.fused && ((PRE_MASK >> 2) & 1)) { phase2(p, lds); xcd_barrier(xb); }
    if (p.fused && ((PRE_MASK >> 5) & 1)) { phase5(p, lds); xcd_barrier(xb); }
    if (p.fused && ((PRE_MASK >> 1) & 1)) { phase1(p, lds); xcd_barrier(xb); }
    if (p.fused && ((PRE_MASK >> 6) & 1)) { phase_res<0>(p, lds); xcd_barrier(xb); }
    if (p.fused && ((PRE_MASK >> 11) & 1)) { phase_res<2>(p, lds); xcd_barrier(xb); }
#if PH_ON(0)
    RUN_PH(0, phase0(p, lds))
#endif
#if PH_ON(1)
    RUN_PH(1, phase1(p, lds))
#endif
#if PH_ON(2)
    RUN_PH(2, phase2(p, lds))
#endif
#if PH_ON(3)
    RUN_PH(3, phase3(p, lds))
#endif
#if PH_ON(4)
    RUN_PH(4, phase4(p))
#endif
#if PH_ON(5)
    RUN_PH(5, phase5(p, lds))
#endif
#if PH_ON(6)
    RUN_PH(6, phase_res<0>(p, lds))
#endif
#if PH_ON(7)
    RUN_PH(7, phase7(p, lds))
#endif
#if PH_ON(8)
    RUN_PH(8, phase8(p, lds))
#endif
#if PH_ON(9)
    RUN_PH(9, phase_res<1>(p, lds))
#endif
#if PH_ON(10)
    RUN_PH(10, phase10(p, lds))
#endif
#if PH_ON(11)
    RUN_PH(11, phase11(p, lds))
#endif
#if PH_ON(12)
    RUN_PH(12, phase12(p))
#endif
#ifdef EXTRA_BARS
    if (p.fused) { for (int i = 0; i < EXTRA_BARS; ++i) xcd_barrier(xb); }
#endif
    RUN_PH(13, phase_dump(p))
}

extern "C" void kernel_launch(void* const* d_in, const int* in_sizes, int n_in, void* d_out, int out_size, void* d_ws, size_t ws_size, hipStream_t stream) {
    static int grid = 0;
    if (grid == 0) {
        int dev = 0, cus = 0, per_cu = 0;
        hipGetDevice(&dev);
        hipDeviceGetAttribute(&cus, hipDeviceAttributeMultiprocessorCount, dev);
        hipFuncSetAttribute((const void*)hymba_fwd, hipFuncAttributeMaxDynamicSharedMemorySize, LDS_BYTES);
        hipOccupancyMaxActiveBlocksPerMultiprocessor(&per_cu, (const void*)hymba_fwd, 256, LDS_BYTES);
        if (per_cu > 2) per_cu = 2;
        if (per_cu < 1) per_cu = 1;
        grid = cus * per_cu; grid = (grid / 8) * 8;
        if (ws_size < W_END) fprintf(stderr, "kernel_launch: workspace too small: %zu < %zu\n", ws_size, (size_t)W_END);
    }
    Params p{};
    for (int i = 0; i < 31; ++i) p.in[i] = (const float*)d_in[i];
    p.out = (float*)d_out; p.ws = (char*)d_ws; p.never = 0;
#if FUSED
    hipMemsetAsync((char*)d_ws + W_BAR, 0, XCD_BAR_WORDS * 4, stream);
    p.ph_lo = 0; p.ph_hi = NPH; p.fused = 1;
    void* args[] = {&p};
    hipError_t e = hipLaunchCooperativeKernel((const void*)hymba_fwd, dim3(grid), dim3(256), args, LDS_BYTES, stream);
    if (e != hipSuccess) fprintf(stderr, "cooperative launch failed: %s (grid %d)\n", hipGetErrorString(e), grid);
#else
    p.fused = 0;
    for (int ph = 0; ph < RUN_PHASES; ++ph) {
        p.ph_lo = ph; p.ph_hi = ph + 1;
        hipLaunchKernelGGL(hymba_fwd, dim3(grid), dim3(256), LDS_BYTES, stream, p);
    }
    if (DUMP_SEL) { p.ph_lo = 13; p.ph_hi = 14; hipLaunchKernelGGL(hymba_fwd, dim3(grid), dim3(256), LDS_BYTES, stream, p); }
#endif
}
```

```cpp
#include <hip/hip_runtime.h>
#include <hip/hip_cooperative_groups.h>
#include <stdint.h>
#include <cstdio>
namespace cg = cooperative_groups;

#ifndef FUSED
#define FUSED 1
#endif
#define DUP_MASK 0
#define PRE_MASK 0
#ifndef RUN_PHASES
#define RUN_PHASES 13
#define DUMP_SEL 0
#endif

#define LAS __attribute__((address_space(3)))
typedef unsigned short bf16_t;
typedef short bf16x8 __attribute__((ext_vector_type(8)));
typedef float f32x4 __attribute__((ext_vector_type(4)));
typedef unsigned u32x4 __attribute__((ext_vector_type(4)));
typedef unsigned u32x2 __attribute__((ext_vector_type(2)));

constexpr int MP = 16384, MS = 128, MT = MP + MS;
constexpr int NCH = 128;
constexpr float EPS = 1e-6f;
constexpr int NPH = 13;

constexpr size_t O_YP = 0, O_YS = 16777216, O_SSMP = 16908288, O_CONVP = 17432576, O_GVP = 17457152,
                 O_MK = 17981440, O_MV = 20078592, O_SSMS = 22175744, O_CONVS = 30564352, O_GVS = 30957568;

constexpr size_t al(size_t x) { return (x + 255) & ~(size_t)255; }
constexpr size_t W_BAR = 0;
constexpr size_t W_ZERO = al(W_BAR + 3456 * 4);
constexpr size_t ZERO_FLOATS = (size_t)MT * 7;
constexpr size_t W_WIN = al(W_ZERO + ZERO_FLOATS * 4);
constexpr size_t W_WKV = al(W_WIN + (size_t)2688 * 1024 * 2);
constexpr size_t W_WOUT = al(W_WKV + (size_t)2048 * 1024 * 2);
constexpr size_t W_WQ = al(W_WOUT + (size_t)1024 * 1024 * 2);
constexpr size_t W_WXO = al(W_WQ + (size_t)1024 * 1024 * 2);
constexpr size_t W_WGU = al(W_WXO + (size_t)1024 * 1024 * 2);
constexpr size_t W_WD = al(W_WGU + (size_t)5632 * 1024 * 2);
constexpr size_t W_WSB = al(W_WD + (size_t)1024 * 2816 * 2);
constexpr size_t W_MEMB = al(W_WSB + (size_t)4 * 128 * 128 * 2);
constexpr size_t W_DTRAW = al(W_MEMB + (size_t)2048 * 1024 * 2);
constexpr size_t W_KB = al(W_DTRAW + (size_t)MT * 8 * 4);
constexpr size_t W_VT = al(W_KB + (size_t)2048 * 1024 * 2);
constexpr size_t W_VLNT = al(W_VT + (size_t)2048 * 1024 * 2);
constexpr size_t W_ACUM = al(W_VLNT + (size_t)MP * 512 * 2);
constexpr size_t W_DTV = al(W_ACUM + (size_t)NCH * 8 * 128 * 4);
constexpr size_t W_CONCAT = al(W_DTV + (size_t)NCH * 8 * 128 * 4);
constexpr size_t W_HP = al(W_CONCAT + (size_t)MT * 1024 * 2);
constexpr size_t W_HPB = al(W_HP + (size_t)MT * 1024 * 4);
constexpr size_t W_XB = al(W_HPB + (size_t)MT * 1024 * 2);
constexpr size_t W_UB = al(W_XB + (size_t)MT * 1024 * 2);
constexpr size_t W_VG = al(W_UB + (size_t)MT * 512 * 2);
constexpr size_t W_ZB = al(W_VG + (size_t)MT * 512 * 2);
constexpr size_t W_XBCB = al(W_ZB + (size_t)MT * 512 * 2);
constexpr size_t W_R1END = al(W_XBCB + (size_t)MT * 1024 * 2);
constexpr size_t W_ACT = W_XB;
static_assert((size_t)MT * 2816 * 2 <= W_R1END - W_XB, "act alias");
constexpr size_t W_XN = W_R1END;
constexpr size_t W_XWT = al(W_XN + (size_t)MP * 512 * 2);
constexpr size_t W_XT = al(W_XWT + (size_t)MP * 512 * 2);
constexpr size_t W_BN = al(W_XT + (size_t)MP * 512 * 2);
constexpr size_t W_BT = al(W_BN + (size_t)MP * 256 * 2);
constexpr size_t W_CN = al(W_BT + (size_t)MP * 256 * 2);
constexpr size_t W_R2END = al(W_CN + (size_t)MP * 256 * 2);
constexpr size_t W_QB = W_XN;
static_assert((size_t)MT * 1024 * 2 <= W_BN - W_XN, "qb alias");
constexpr size_t W_SC = W_R2END;
constexpr size_t W_HPREV = al(W_SC + (size_t)NCH * 8 * 64 * 128 * 4);
constexpr size_t W_MT = al(W_HPREV + (size_t)NCH * 8 * 64 * 128 * 2);
constexpr size_t W_END = al(W_MT + (size_t)NCH * 8 * 128 * 128 * 2);
constexpr size_t W_PBUF = W_SC;
constexpr size_t W_OB = W_HPREV;
static_assert((size_t)MT * 1024 * 2 <= W_END - W_HPREV, "ob alias");
static_assert(W_END < (size_t)530 * 1000 * 1000, "workspace too large");

constexpr int LDS_MISC = 65536;
constexpr int LDS_BYTES = 65536 + 4096;

struct Params {
    const float* in[31];
    float* out;
    char* ws;
    int ph_lo, ph_hi, fused, never;
};

__device__ __forceinline__ float bf2f(unsigned h) { return __uint_as_float(h << 16); }
__device__ __forceinline__ unsigned pk2(float lo, float hi) { unsigned r; asm("v_cvt_pk_bf16_f32 %0, %1, %2" : "=v"(r) : "v"(lo), "v"(hi)); return r; }
__device__ __forceinline__ float bflo(unsigned u) { return __uint_as_float(u << 16); }
__device__ __forceinline__ float bfhi(unsigned u) { return __uint_as_float(u & 0xffff0000u); }
__device__ __forceinline__ float rbf(float x) { return bflo(pk2(x, 0.f) & 0xffffu); }
__device__ __forceinline__ float gelu_t(float x) { const float u = 1.5957691216f * (x + 0.044715f * x * x * x); return x / (1.f + __expf(-u)); }
__device__ __forceinline__ float silu_f(float x) { return x / (1.f + __expf(-x)); }
__device__ __forceinline__ float softplus_f(float x) { return x > 20.f ? x : log1pf(expf(x)); }
__device__ __forceinline__ float wave_sum(float v) {
#pragma unroll
    for (int o = 1; o < 64; o <<= 1) v += __shfl_xor(v, o);
    return v;
}
__device__ __forceinline__ float wave_max(float v) {
#pragma unroll
    for (int o = 1; o < 64; o <<= 1) v = fmaxf(v, __shfl_xor(v, o));
    return v;
}
__device__ __forceinline__ u32x4 scale8(u32x4 v, float s) {
    u32x4 o;
    o.x = pk2(bflo(v.x) * s, bfhi(v.x) * s); o.y = pk2(bflo(v.y) * s, bfhi(v.y) * s);
    o.z = pk2(bflo(v.z) * s, bfhi(v.z) * s); o.w = pk2(bflo(v.w) * s, bfhi(v.w) * s);
    return o;
}

#define XB_TMO      128
#define XB_XCNT(j)  (256  + 64 * (j))
#define XB_XSUB(j)  (1280 + 64 * (j))
#define XB_XGEN(j)  (2304 + 64 * (j))
#define XB_TOP      3328
#define XB_TOPGEN   3392
#define XCD_BAR_WORDS 3456
#define XB_SPIN_CAP (1u << 22)
__device__ __forceinline__ unsigned xb_ld(unsigned* p)              { return __hip_atomic_load(p, __ATOMIC_RELAXED, __HIP_MEMORY_SCOPE_AGENT); }
__device__ __forceinline__ unsigned xb_add(unsigned* p, unsigned v) { return __hip_atomic_fetch_add(p, v, __ATOMIC_RELAXED, __HIP_MEMORY_SCOPE_AGENT); }
__device__ __forceinline__ unsigned xb_xcc_id() { return (unsigned)__builtin_amdgcn_s_getreg((3 << 11) | 20) & 0xFu; }
#define XB_SPIN(cond, bar) do { unsigned _sp = 0; while (cond) { __builtin_amdgcn_s_sleep(1); \
    if ((++_sp & 255u) == 0u) { if (xb_ld(&(bar)[XB_TMO])) break; if (_sp > XB_SPIN_CAP) { atomicAdd(&(bar)[XB_TMO], 1u); break; } } } } while (0)
struct XcdBarrier { unsigned* bar; unsigned x; volatile LAS unsigned* st; };
__device__ __forceinline__ XcdBarrier xcd_barrier_post(unsigned* bar, volatile LAS unsigned* st) {
    XcdBarrier b; b.bar = bar; b.x = xb_xcc_id(); b.st = st;
    if (threadIdx.x == 0) (void)xb_add(&bar[XB_XCNT(b.x)], 1u);
    return b;
}
__device__ __forceinline__ void xcd_barrier_complete(unsigned* bar, unsigned x, unsigned& nloc, unsigned& nx) {
    const unsigned G = gridDim.x * gridDim.y * gridDim.z;
    unsigned sum, cnt, mine, sp = 0u;
    for (;;) {
        sum = 0u; cnt = 0u; mine = 0u;
#pragma unroll
        for (unsigned j = 0; j < 16; ++j) { const unsigned c = xb_ld(&bar[XB_XCNT(j)]); sum += c; cnt += (c > 0u) ? 1u : 0u; mine = (j == x) ? c : mine; }
        if (sum == G) break;
        __builtin_amdgcn_s_sleep(1);
        if ((++sp & 255u) == 0u) { if (xb_ld(&bar[XB_TMO])) break; if (sp > XB_SPIN_CAP) { atomicAdd(&bar[XB_TMO], 1u); break; } }
    }
    nloc = mine > 0u ? mine : 1u; nx = cnt > 0u ? cnt : 1u;
}
__device__ __forceinline__ void xcd_barrier(const XcdBarrier& b) {
    asm volatile("s_waitcnt vmcnt(0)" ::: "memory");
    __syncthreads();
    if (threadIdx.x == 0) {
        unsigned* bar = b.bar;
        __builtin_amdgcn_s_waitcnt(0);
        unsigned nloc = b.st[0], nx = b.st[1];
        if (nloc == 0u) { xcd_barrier_complete(bar, b.x, nloc, nx); b.st[0] = nloc; b.st[1] = nx; }
        const unsigned old = xb_add(&bar[XB_XSUB(b.x)], 1u);
        const unsigned gen = old / nloc;
        if (old + 1u == (gen + 1u) * nloc) {
            __builtin_amdgcn_fence(__ATOMIC_RELEASE, "agent");
            asm volatile("s_waitcnt vmcnt(0)" ::: "memory");
            const unsigned og = xb_add(&bar[XB_TOP], 1u);
            const unsigned tg = og / nx;
            if (og + 1u == (tg + 1u) * nx) xb_add(&bar[XB_TOPGEN], 1u);
            else XB_SPIN(xb_ld(&bar[XB_TOPGEN]) == tg, bar);
            __builtin_amdgcn_fence(__ATOMIC_ACQUIRE, "agent");
            xb_add(&bar[XB_XGEN(b.x)], 1u);
            asm volatile("s_waitcnt vmcnt(0)" ::: "memory");
        } else {
            XB_SPIN(xb_ld(&bar[XB_XGEN(b.x)]) == gen, bar);
            __builtin_amdgcn_fence(__ATOMIC_ACQUIRE, "agent");
            asm volatile("s_waitcnt vmcnt(0)" ::: "memory");
        }
    }
    __syncthreads();
}

__device__ __forceinline__ int sched(int i, int T) {
    const int x = blockIdx.x & 7, lb = blockIdx.x >> 3, nlb = gridDim.x >> 3;
    const int chunk = (T + 7) >> 3, local = lb + i * nlb;
    if (local >= chunk) return -1;
    const int t = x * chunk + local;
    return t < T ? t : -1;
}
__device__ __forceinline__ void tile_mn(int t, int NMt, int NNt, int& mt, int& nt) {
    const int per = 8 * NNt, gi = t / per, r = t - gi * per, fm = gi * 8;
    const int gsz = (NMt - fm) < 8 ? (NMt - fm) : 8;
    mt = fm + r % gsz; nt = r / gsz;
}

template <int BN, int AMODE>
__device__ __forceinline__ void mma_seg(f32x4 (&acc)[4][BN / 32], const bf16_t* __restrict__ A, const int lda,
                                        const bf16_t* __restrict__ Bt, const int ldb, const int K, LAS char* lds,
                                        const float* __restrict__ gssrow) {
    constexpr int NI = BN / 32;
    const int tid = threadIdx.x, lane = tid & 63, wid = __builtin_amdgcn_readfirstlane(tid >> 6), wm = wid >> 1, wn = wid & 1, fr = lane & 15, fq = lane >> 4;
    const int srow = tid >> 3, sc = tid & 7;
    const int csw = (sc ^ ((srow >> 1) & 7)) * 8;
    const bf16_t* ap = A + (size_t)srow * lda + (AMODE == 1 ? sc * 8 : csw);
    const bf16_t* bp = Bt + (size_t)srow * ldb + csw;
    const int woff = srow * 128 + ((sc ^ ((srow >> 1) & 7)) << 4);
    const int gl = wid * 1024;
    const int sw = (fr >> 1) & 7;
    const int aoff = (wm * 64 + fr) * 128, boff = 32768 + (wn * (BN / 2) + fr) * 128;
    u32x4 ra[4];
    float asc[4];
    const int nk = K >> 6;
#define MS_ISSUE(kt, buf) do { \
    if (AMODE == 1) { \
        _Pragma("unroll") for (int i = 0; i < 4; ++i) ra[i] = *(const u32x4*)(ap + (size_t)(i * 32) * lda + (kt) * 64); \
        const int k_ = (kt) * 64 + sc * 8; \
        _Pragma("unroll") for (int i = 0; i < 4; ++i) asc[i] = (k_ >= 512) ? rsqrtf(gssrow[(srow + 32 * i) * 2 + ((k_ - 512) >> 8)] * (1.f / 256.f) + EPS) : 1.f; \
    } else { \
        _Pragma("unroll") for (int i = 0; i < 4; ++i) __builtin_amdgcn_global_load_lds((const unsigned*)(ap + (size_t)(i * 32) * lda + (kt) * 64), (LAS unsigned*)(lds + (buf) * 16384 + i * 4096 + gl), 16, 0, 0); \
    } \
    _Pragma("unroll") for (int i = 0; i < NI; ++i) __builtin_amdgcn_global_load_lds((const unsigned*)(bp + (size_t)(i * 32) * ldb + (kt) * 64), (LAS unsigned*)(lds + 32768 + (buf) * 16384 + i * 4096 + gl), 16, 0, 0); \
  } while (0)
#define MS_STORE(buf) do { if (AMODE == 1) { \
    _Pragma("unroll") for (int i = 0; i < 4; ++i) { *(LAS u32x4*)(lds + (buf) * 16384 + woff + i * 4096) = scale8(ra[i], asc[i]); } } \
  } while (0)
    __syncthreads();
    MS_ISSUE(0, 0);
    MS_STORE(0);
    asm volatile("s_waitcnt vmcnt(0)" ::: "memory");
    __syncthreads();
    for (int kt = 0; kt < nk; ++kt) {
        const int cur = kt & 1;
        if (kt + 1 < nk) MS_ISSUE(kt + 1, cur ^ 1);
#pragma unroll
        for (int kk = 0; kk < 2; ++kk) {
            const int co = (((kk * 4 + fq) ^ sw) << 4) + cur * 16384;
            bf16x8 af[4], bfv[NI];
#pragma unroll
            for (int mi = 0; mi < 4; ++mi) af[mi] = *(LAS bf16x8*)(lds + aoff + mi * 2048 + co);
#pragma unroll
            for (int ni = 0; ni < NI; ++ni) bfv[ni] = *(LAS bf16x8*)(lds + boff + ni * 2048 + co);
            __builtin_amdgcn_s_setprio(1);
#pragma unroll
            for (int mi = 0; mi < 4; ++mi)
#pragma unroll
                for (int ni = 0; ni < NI; ++ni) acc[mi][ni] = __builtin_amdgcn_mfma_f32_16x16x32_bf16(bfv[ni], af[mi], acc[mi][ni], 0, 0, 0);
            __builtin_amdgcn_s_setprio(0);
        }
        if (kt + 1 < nk) MS_STORE(cur ^ 1);
        asm volatile("s_waitcnt vmcnt(0)" ::: "memory");
        __syncthreads();
    }
#undef MS_ISSUE
#undef MS_STORE
}
__device__ __forceinline__ void mma_seg_p(f32x4 (&acc)[4][4], const bf16_t* __restrict__ A, const int lda, const bf16_t* __restrict__ Bt, const int ldb, const int K, LAS char* lds,
                                          const bool pf_in, const bf16_t* nA, const bf16_t* nB) {
    const int tid = threadIdx.x, lane = tid & 63, wid = __builtin_amdgcn_readfirstlane(tid >> 6), wm = wid >> 1, wn = wid & 1, fr = lane & 15, fq = lane >> 4;
    const int srow = tid >> 3, sc = tid & 7;
    const int csw = (sc ^ ((srow >> 1) & 7)) * 8;
    const size_t aofs = (size_t)srow * lda + csw, bofs = (size_t)srow * ldb + csw;
    const int gl = wid * 1024;
    const int sw = (fr >> 1) & 7;
    const int aoff = (wm * 64 + fr) * 128, boff = 32768 + (wn * 64 + fr) * 128;
    const int nk = K >> 6;
#define MP_ISSUE(AP, BP, kt, buf) do { \
    _Pragma("unroll") for (int i = 0; i < 4; ++i) __builtin_amdgcn_global_load_lds((const unsigned*)((AP) + aofs + (size_t)(i * 32) * lda + (kt) * 64), (LAS unsigned*)(lds + (buf) * 16384 + i * 4096 + gl), 16, 0, 0); \
    _Pragma("unroll") for (int i = 0; i < 4; ++i) __builtin_amdgcn_global_load_lds((const unsigned*)((BP) + bofs + (size_t)(i * 32) * ldb + (kt) * 64), (LAS unsigned*)(lds + 32768 + (buf) * 16384 + i * 4096 + gl), 16, 0, 0); \
  } while (0)
    if (!pf_in) { __syncthreads(); MP_ISSUE(A, Bt, 0, 0); }
    asm volatile("s_waitcnt vmcnt(0)" ::: "memory");
    __syncthreads();
    for (int kt = 0; kt < nk; ++kt) {
        const int cur = kt & 1;
        if (kt + 1 < nk) MP_ISSUE(A, Bt, kt + 1, cur ^ 1);
#pragma unroll
        for (int kk = 0; kk < 2; ++kk) {
            const int co = (((kk * 4 + fq) ^ sw) << 4) + cur * 16384;
            bf16x8 af[4], bfv[4];
#pragma unroll
            for (int mi = 0; mi < 4; ++mi) af[mi] = *(LAS bf16x8*)(lds + aoff + mi * 2048 + co);
#pragma unroll
            for (int ni = 0; ni < 4; ++ni) bfv[ni] = *(LAS bf16x8*)(lds + boff + ni * 2048 + co);
            __builtin_amdgcn_s_setprio(1);
#pragma unroll
            for (int mi = 0; mi < 4; ++mi)
#pragma unroll
                for (int ni = 0; ni < 4; ++ni) acc[mi][ni] = __builtin_amdgcn_mfma_f32_16x16x32_bf16(bfv[ni], af[mi], acc[mi][ni], 0, 0, 0);
            __builtin_amdgcn_s_setprio(0);
        }
        asm volatile("s_waitcnt vmcnt(0)" ::: "memory");
        __syncthreads();
    }
    if (nA) MP_ISSUE(nA, nB, 0, 0);
#undef MP_ISSUE
}
template <int NI> __device__ __forceinline__ void zero_acc(f32x4 (&acc)[4][NI]) {
#pragma unroll
    for (int mi = 0; mi < 4; ++mi)
#pragma unroll
        for (int ni = 0; ni < NI; ++ni) acc[mi][ni] = (f32x4){0.f, 0.f, 0.f, 0.f};
}
__device__ __forceinline__ float fq_sum(float v) { v += __shfl_xor(v, 16); v += __shfl_xor(v, 32); return v; }
__device__ __forceinline__ float fq_max(float v) { v = fmaxf(v, __shfl_xor(v, 16)); v = fmaxf(v, __shfl_xor(v, 32)); return v; }

#define WSP(T, off) ((T*)(p.ws + (off)))
#define TIDV const int tid = threadIdx.x, lane = tid & 63, wid = tid >> 6, wm = wid >> 1, wn = wid & 1, fr = lane & 15, fq = lane >> 4; (void)wm; (void)wn; (void)fr; (void)fq; (void)lane; (void)wid

__device__ __forceinline__ void p0_transpose(const Params& p, int item, LAS char* lds) {
    TIDV;
    LAS float* tile = (LAS float*)lds;
    int r = item; const float* s0; const float* s1 = nullptr; const float* ksc = nullptr; bf16_t* dst; int K = 1024, NT, ld, mode = 0, kso = 0, nvalid; float mul = 1.f;
    if (r < 672) { s0 = p.in[8]; dst = WSP(bf16_t, W_WIN); NT = 42; ld = 2568; nvalid = 2568; }
    else if ((r -= 672) < 512) { s0 = p.in[23]; s1 = p.in[24]; dst = WSP(bf16_t, W_WKV); mode = 1; NT = 32; ld = 1024; nvalid = 2048; }
    else if ((r -= 512) < 256) { s0 = p.in[19]; dst = WSP(bf16_t, W_WOUT); ksc = p.in[18]; kso = 512; NT = 16; ld = 1024; nvalid = 1024; }
    else if ((r -= 256) < 256) { s0 = p.in[22]; dst = WSP(bf16_t, W_WQ); ksc = p.in[20]; mul = 0.0625f; NT = 16; ld = 1024; nvalid = 1024; }
    else if ((r -= 256) < 256) { s0 = p.in[25]; dst = WSP(bf16_t, W_WXO); NT = 16; ld = 1024; nvalid = 1024; }
    else if ((r -= 256) < 1408) { s0 = p.in[27]; s1 = p.in[28]; dst = WSP(bf16_t, W_WGU); mode = 2; ksc = p.in[26]; NT = 88; ld = 2816; nvalid = 5632; }
    else { r -= 1408; s0 = p.in[29]; dst = WSP(bf16_t, W_WD); K = 2816; NT = 16; ld = 1024; nvalid = 1024; }
    const int kt = r / NT, nt = r - kt * NT, k0 = kt * 64, n0 = nt * 64;
    {
        const int tn = (tid & 15) * 4, tk = tid >> 4, n = n0 + tn;
        const float* src = s0; size_t coff = 0; const bool valid = n < nvalid;
        if (mode == 0) coff = n;
        else if (mode == 1) { if (n >= 1024) { src = s1; coff = n - 1024; } else coff = n; }
        else { const int grp = n >> 5, w = n & 31; coff = grp * 16 + (w & 15); if (w >> 4) src = s1; }
        f32x4 v[4];
#pragma unroll
        for (int i = 0; i < 4; ++i) { const int k = k0 + tk + 16 * i; v[i] = valid ? *(const f32x4*)(src + (size_t)k * ld + coff) : (f32x4){0.f, 0.f, 0.f, 0.f}; }
#pragma unroll
        for (int i = 0; i < 4; ++i) {
            const int k = k0 + tk + 16 * i;
            float sc_ = mul; if (ksc && k >= kso) sc_ *= ksc[k - kso];
            LAS float* t_ = tile + (tk + 16 * i) * 65 + tn;
            t_[0] = v[i][0] * sc_; t_[1] = v[i][1] * sc_; t_[2] = v[i][2] * sc_; t_[3] = v[i][3] * sc_;
        }
    }
    __syncthreads();
    {
        const int c = tid & 7, nl = tid >> 3;
#pragma unroll
        for (int j = 0; j < 2; ++j) {
            const int n = nl + 32 * j;
            const LAS float* s = tile + (c * 8) * 65 + n;
            u32x4 o; o.x = pk2(s[0], s[65]); o.y = pk2(s[2 * 65], s[3 * 65]); o.z = pk2(s[4 * 65], s[5 * 65]); o.w = pk2(s[6 * 65], s[7 * 65]);
            *(u32x4*)(dst + (size_t)(n0 + n) * K + k0 + c * 8) = o;
        }
    }
    __syncthreads();
}
__device__ __forceinline__ void p0_rownorm(const Params& p, int ri) {
    TIDV;
    const int row = ri * 4 + wid;
    const float* src; const float* g; bf16_t* dst;
    if (row < MT) { src = row < MP ? p.in[0] + (size_t)row * 1024 : p.in[1] + (size_t)(row - MP) * 1024; g = p.in[7]; dst = WSP(bf16_t, W_XB) + (size_t)row * 1024; }
    else { const int r2 = row - MT; src = p.in[6] + (size_t)r2 * 1024; g = p.in[21]; dst = WSP(bf16_t, W_MEMB) + (size_t)r2 * 1024; }
    float4 v[4]; float ss = 0.f;
#pragma unroll
    for (int j = 0; j < 4; ++j) { v[j] = *(const float4*)(src + (j * 64 + lane) * 4); ss += v[j].x * v[j].x + v[j].y * v[j].y + v[j].z * v[j].z + v[j].w * v[j].w; }
    const float rstd = rsqrtf(wave_sum(ss) * (1.f / 1024.f) + EPS);
#pragma unroll
    for (int j = 0; j < 4; ++j) {
        const float4 gv = *(const float4*)(g + (j * 64 + lane) * 4);
        u32x2 o; o.x = pk2(v[j].x * rstd * gv.x, v[j].y * rstd * gv.y); o.y = pk2(v[j].z * rstd * gv.z, v[j].w * rstd * gv.w);
        *(u32x2*)(dst + (j * 64 + lane) * 4) = o;
    }
}
__device__ __forceinline__ void phase0(const Params& p, LAS char* lds) {
    const int gtid = blockIdx.x * 256 + threadIdx.x, gn = gridDim.x * 256;
    float* z = WSP(float, W_ZERO);
    for (int i = gtid; i < (int)ZERO_FLOATS; i += gn) z[i] = 0.f;
    bf16_t* wsb = WSP(bf16_t, W_WSB); const float* ws = p.in[11];
    for (int i = gtid; i < 4 * 128 * 128; i += gn) { const int s = i & 127, t = (i >> 7) & 127; wsb[i] = (s <= t) ? (bf16_t)(pk2(ws[i], 0.f) & 0xffffu) : (bf16_t)0; }
    for (int it = blockIdx.x; it < 4064 + 4640; it += gridDim.x) {
        if (it < 4064) p0_transpose(p, it, lds); else p0_rownorm(p, it - 4064);
    }
}

__device__ __forceinline__ void p1_inproj_tile(const Params& p, int mt, int nt, LAS char* lds) {
    TIDV;
    f32x4 acc[4][4]; zero_acc<4>(acc);
    const int m0 = mt * 128, n0 = nt * 128;
    mma_seg<128, 0>(acc, WSP(bf16_t, W_XB) + (size_t)m0 * 1024, 1024, WSP(bf16_t, W_WIN) + (size_t)n0 * 1024, 1024, 1024, lds, nullptr);
    const int rb = m0 + wm * 64 + fr, cb = n0 + wn * 64 + fq * 4;
    if (n0 < 512) {
        bf16_t* ub = WSP(bf16_t, W_UB);
#pragma unroll
        for (int mi = 0; mi < 4; ++mi)
#pragma unroll
            for (int ni = 0; ni < 4; ++ni) { const f32x4 a = acc[mi][ni]; u32x2 o; o.x = pk2(gelu_t(a[0]), gelu_t(a[1])); o.y = pk2(gelu_t(a[2]), gelu_t(a[3]));
                *(u32x2*)(ub + (size_t)(rb + mi * 16) * 512 + cb + ni * 16) = o; }
    } else if (n0 < 1024) {
        bf16_t* vg = WSP(bf16_t, W_VG); float* vstat = WSP(float, W_ZERO);
#pragma unroll
        for (int mi = 0; mi < 4; ++mi) {
            float s1 = 0.f, s2 = 0.f;
#pragma unroll
            for (int ni = 0; ni < 4; ++ni) { const f32x4 a = acc[mi][ni]; const float g0 = gelu_t(a[0]), g1 = gelu_t(a[1]), g2 = gelu_t(a[2]), g3 = gelu_t(a[3]);
                u32x2 o; o.x = pk2(g0, g1); o.y = pk2(g2, g3);
                const float r0 = bflo(o.x), r1 = bfhi(o.x), r2 = bflo(o.y), r3 = bfhi(o.y);
                s1 += (r0 + r1) + (r2 + r3); s2 += (r0 * r0 + r1 * r1) + (r2 * r2 + r3 * r3);
                *(u32x2*)(vg + (size_t)(rb + mi * 16) * 512 + (cb - 512) + ni * 16) = o; }
            s1 = fq_sum(s1); s2 = fq_sum(s2);
            if (fq == 0) { atomicAdd(vstat + (size_t)(rb + mi * 16) * 2, s1); atomicAdd(vstat + (size_t)(rb + mi * 16) * 2 + 1, s2); }
        }
    } else if (n0 < 1536) {
        bf16_t* zb = WSP(bf16_t, W_ZB);
#pragma unroll
        for (int mi = 0; mi < 4; ++mi)
#pragma unroll
            for (int ni = 0; ni < 4; ++ni) { const f32x4 a = acc[mi][ni]; u32x2 o; o.x = pk2(a[0], a[1]); o.y = pk2(a[2], a[3]);
                *(u32x2*)(zb + (size_t)(rb + mi * 16) * 512 + (cb - 1024) + ni * 16) = o; }
    } else if (n0 < 2560) {
        bf16_t* xb = WSP(bf16_t, W_XBCB);
#pragma unroll
        for (int mi = 0; mi < 4; ++mi) {
            const int row = rb + mi * 16;
            float* fo = nullptr;
            if (row < MP) { const int t = row & 2047; if (t >= 2045) fo = p.out + O_CONVP + ((size_t)(row >> 11) * 3 + (t - 2045)) * 1024; }
            else fo = p.out + O_CONVS + ((size_t)(row - MP) * 3 + 2) * 1024;
#pragma unroll
            for (int ni = 0; ni < 4; ++ni) { const f32x4 a = acc[mi][ni]; const int ch = cb - 1536 + ni * 16; u32x2 o; o.x = pk2(a[0], a[1]); o.y = pk2(a[2], a[3]);
                *(u32x2*)(xb + (size_t)row * 1024 + ch) = o;
                if (fo) *(f32x4*)(fo + ch) = a; }
        }
    } else {
        float* dtr = WSP(float, W_DTRAW);
        if (wn == 0 && fq < 2) {
#pragma unroll
            for (int mi = 0; mi < 4; ++mi) *(f32x4*)(dtr + (size_t)(rb + mi * 16) * 8 + fq * 4) = acc[mi][0];
        }
    }
}
__device__ __forceinline__ void p1_memkv_tile(const Params& p, int mt, int nt, LAS char* lds) {
    TIDV;
    f32x4 acc[4][4]; zero_acc<4>(acc);
    const int m0 = mt * 128, n0 = nt * 128;
    mma_seg<128, 0>(acc, WSP(bf16_t, W_MEMB) + (size_t)m0 * 1024, 1024, WSP(bf16_t, W_WKV) + (size_t)n0 * 1024, 1024, 1024, lds, nullptr);
    const int rb = m0 + wm * 64 + fr, cb = n0 + wn * 64 + fq * 4;
    if (n0 < 1024) {
        bf16_t* kb = WSP(bf16_t, W_KB);
#pragma unroll
        for (int mi = 0; mi < 4; ++mi)
#pragma unroll
            for (int ni = 0; ni < 4; ++ni) { const f32x4 a = acc[mi][ni]; const size_t o_ = (size_t)(rb + mi * 16) * 1024 + cb + ni * 16;
                *(f32x4*)(p.out + O_MK + o_) = a; u32x2 o; o.x = pk2(a[0], a[1]); o.y = pk2(a[2], a[3]); *(u32x2*)(kb + o_) = o; }
    } else {
        bf16_t* vT = WSP(bf16_t, W_VT);
#pragma unroll
        for (int mi = 0; mi < 4; ++mi)
#pragma unroll
            for (int ni = 0; ni < 4; ++ni) { const f32x4 a = acc[mi][ni]; const int row = rb + mi * 16, c = cb - 1024 + ni * 16;
                *(f32x4*)(p.out + O_MV + (size_t)row * 1024 + c) = a;
                const int b = row >> 8, m = row & 255, head = c >> 8, d = c & 255;
                bf16_t* vp = vT + ((size_t)(b * 4 + head) * 256 + d) * 256 + m;
                const unsigned q0 = pk2(a[0], a[1]), q1 = pk2(a[2], a[3]);
                vp[0] = (bf16_t)(q0 & 0xffffu); vp[256] = (bf16_t)(q0 >> 16); vp[512] = (bf16_t)(q1 & 0xffffu); vp[768] = (bf16_t)(q1 >> 16); }
    }
}
__device__ __forceinline__ void phase1(const Params& p, LAS char* lds) {
    constexpr int T1 = 129 * 21, T2 = 16 * 16;
    int t;
    for (int i = 0; (t = sched(i, T1 + T2)) >= 0; ++i) {
        int mt, nt;
        if (t < T1) { tile_mn(t, 129, 21, mt, nt); p1_inproj_tile(p, mt, nt, lds); }
        else { tile_mn(t - T1, 16, 16, mt, nt); p1_memkv_tile(p, mt, nt, lds); }
    }
}

__device__ __forceinline__ void p2_conv(const Params& p, int item, LAS char* lds) {
    TIDV;
    const int cc = item >> 4, slab = item & 15, c = cc & 15, tok0 = cc * 128, ch0 = slab * 64;
    const int cgp = tid & 7, r0 = tid >> 3;
    LAS float* s_acum = (LAS float*)(lds + 40960); LAS float* s_dt = s_acum + 128; LAS float* s_tot = s_acum + 256;
    if (slab < 8) {
        const int h = slab;
        float v = 0.f, dtv = 0.f;
        if (tid < 128) {
            dtv = softplus_f(WSP(float, W_DTRAW)[(size_t)(tok0 + tid) * 8 + h] + p.in[15][h]);
            v = dtv * (-expf(p.in[16][h]));
#pragma unroll
            for (int d = 1; d < 64; d <<= 1) { const float t = __shfl_up(v, d); if (lane >= d) v += t; }
            if (lane == 63) s_tot[wid] = v;
        }
        __syncthreads();
        if (tid < 128) {
            if (wid == 1) v += s_tot[0];
            s_acum[tid] = v; s_dt[tid] = dtv;
            WSP(float, W_ACUM)[(size_t)(cc * 8 + h) * 128 + tid] = v;
            WSP(float, W_DTV)[(size_t)(cc * 8 + h) * 128 + tid] = dtv;
        }
        __syncthreads();
    }
    const bf16_t* xin = WSP(bf16_t, W_XBCB);
    const int chb = ch0 + cgp * 8;
    u32x4 rin[7];
#pragma unroll
    for (int i = 0; i < 7; ++i) {
        const int rr = r0 * 4 - 3 + i;
        if (rr < 0 && c == 0) rin[i] = (u32x4){0u, 0u, 0u, 0u};
        else rin[i] = *(const u32x4*)(xin + (size_t)(tok0 + rr) * 1024 + chb);
    }
    const float* cw = p.in[13]; const float* cbp = p.in[14];
    float o[4][8];
#pragma unroll
    for (int e = 0; e < 8; ++e) {
        const float w0 = cw[chb + e], w1 = cw[1024 + chb + e], w2 = cw[2048 + chb + e], w3 = cw[3072 + chb + e], bb = cbp[chb + e];
        float xin_[7];
#pragma unroll
        for (int i = 0; i < 7; ++i) { const unsigned u = (e >> 1) == 0 ? rin[i].x : (e >> 1) == 1 ? rin[i].y : (e >> 1) == 2 ? rin[i].z : rin[i].w; xin_[i] = (e & 1) ? bfhi(u) : bflo(u); }
#pragma unroll
        for (int r = 0; r < 4; ++r) o[r][e] = silu_f(bb + xin_[r] * w0 + xin_[r + 1] * w1 + xin_[r + 2] * w2 + xin_[r + 3] * w3);
    }
    {
        bf16_t* dstn; int ldn, cofs;
        if (slab < 8) { dstn = WSP(bf16_t, W_XN); ldn = 512; cofs = chb; }
        else if (slab < 12) { dstn = WSP(bf16_t, W_BN); ldn = 256; cofs = chb - 512; }
        else { dstn = WSP(bf16_t, W_CN); ldn = 256; cofs = chb - 768; }
#pragma unroll
        for (int r = 0; r < 4; ++r) { u32x4 q; q.x = pk2(o[r][0], o[r][1]); q.y = pk2(o[r][2], o[r][3]); q.z = pk2(o[r][4], o[r][5]); q.w = pk2(o[r][6], o[r][7]);
            *(u32x4*)(dstn + (size_t)(tok0 + r0 * 4 + r) * ldn + cofs) = q; }
    }
    if (slab < 12) {
        float wv[4] = {1.f, 1.f, 1.f, 1.f};
        if (slab < 8) { const float al_ = s_acum[127];
#pragma unroll
            for (int r = 0; r < 4; ++r) wv[r] = __expf(al_ - s_acum[r0 * 4 + r]) * s_dt[r0 * 4 + r]; }
#pragma unroll
        for (int e = 0; e < 8; ++e) {
            u32x2 q; q.x = pk2(o[0][e], o[1][e]); q.y = pk2(o[2][e], o[3][e]);
            *(LAS u32x2*)(lds + (cgp * 8 + e) * 256 + r0 * 8) = q;
            if (slab < 8) { u32x2 q2; q2.x = pk2(o[0][e] * wv[0], o[1][e] * wv[1]); q2.y = pk2(o[2][e] * wv[2], o[3][e] * wv[3]);
                *(LAS u32x2*)(lds + 16384 + (cgp * 8 + e) * 256 + r0 * 8) = q2; }
        }
        __syncthreads();
        bf16_t* d1; bf16_t* d2 = nullptr; size_t rowbase;
        if (slab < 8) { d1 = WSP(bf16_t, W_XT); d2 = WSP(bf16_t, W_XWT); rowbase = (size_t)(cc * 8 + slab) * 64; }
        else { const int g = (slab - 8) >> 1, half = (slab - 8) & 1; d1 = WSP(bf16_t, W_BT); rowbase = (size_t)(cc * 2 + g) * 128 + half * 64; }
#pragma unroll
        for (int i = 0; i < 4; ++i) {
            const int id = tid + 256 * i, pr = id >> 4, scn = id & 15;
            *(u32x4*)(d1 + (rowbase + pr) * 128 + scn * 8) = *(LAS u32x4*)(lds + pr * 256 + scn * 16);
            if (slab < 8) *(u32x4*)(d2 + (rowbase + pr) * 128 + scn * 8) = *(LAS u32x4*)(lds + 16384 + pr * 256 + scn * 16);
        }
    }
    __syncthreads();
}
__device__ __forceinline__ void p2_vln(const Params& p, int item, LAS char* lds) {
    TIDV;
    const int cc = item >> 2, head = item & 3, c = cc & 15, b = cc >> 4, tok0 = cc * 128;
    const int cgp = tid & 15, r0 = tid >> 4;
    const int chb = head * 128 + cgp * 8;
    const bf16_t* vg = WSP(bf16_t, W_VG); const float* vstat = WSP(float, W_ZERO);
    float lg[8], lb[8];
#pragma unroll
    for (int e = 0; e < 8; ++e) { lg[e] = p.in[9][chb + e]; lb[e] = p.in[10][chb + e]; }
    float o[8][8];
#pragma unroll
    for (int r = 0; r < 8; ++r) {
        const int tok = tok0 + r0 * 8 + r;
        const u32x4 q = *(const u32x4*)(vg + (size_t)tok * 512 + chb);
        const float mean = vstat[(size_t)tok * 2] * (1.f / 512.f);
        const float var = vstat[(size_t)tok * 2 + 1] * (1.f / 512.f) - mean * mean;
        const float rstd = rsqrtf(fmaxf(var, 0.f) + EPS);
        const float xv[8] = {bflo(q.x), bfhi(q.x), bflo(q.y), bfhi(q.y), bflo(q.z), bfhi(q.z), bflo(q.w), bfhi(q.w)};
#pragma unroll
        for (int e = 0; e < 8; ++e) o[r][e] = (xv[e] - mean) * rstd * lg[e] + lb[e];
        if (c == 15) {
            float* go = p.out + O_GVP + ((size_t)(b * 128 + r0 * 8 + r)) * 512 + chb;
            *(f32x4*)go = (f32x4){o[r][0], o[r][1], o[r][2], o[r][3]}; *(f32x4*)(go + 4) = (f32x4){o[r][4], o[r][5], o[r][6], o[r][7]};
        }
    }
#pragma unroll
    for (int e = 0; e < 8; ++e) {
        u32x4 q; q.x = pk2(o[0][e], o[1][e]); q.y = pk2(o[2][e], o[3][e]); q.z = pk2(o[4][e], o[5][e]); q.w = pk2(o[6][e], o[7][e]);
        *(LAS u32x4*)(lds + (cgp * 8 + e) * 256 + r0 * 16) = q;
    }
    __syncthreads();
    bf16_t* dst = WSP(bf16_t, W_VLNT) + (size_t)(cc * 4 + head) * 128 * 128;
#pragma unroll
    for (int i = 0; i < 8; ++i) { const int id = tid + 256 * i, pr = id >> 4, scn = id & 15;
        *(u32x4*)(dst + (size_t)pr * 128 + scn * 8) = *(LAS u32x4*)(lds + pr * 256 + scn * 16); }
    __syncthreads();
}
__device__ __forceinline__ void p2_sample_ssd(const Params& p, int item, LAS char* lds) {
    TIDV;
    const int bs = item >> 3, h = item & 7, g = h >> 2;
    LAS float* s_x = (LAS float*)lds; LAS float* s_B = s_x + 64; LAS float* s_C = s_B + 128; LAS float* s_y = s_C + 128;
    const float* scv = p.in[3] + (size_t)bs * 3 * 1024;
    const float* xrow = p.out + O_CONVS + ((size_t)bs * 3 + 2) * 1024;
    const float* cw = p.in[13]; const float* cbp = p.in[14];
    for (int idx = tid; idx < 320; idx += 256) {
        int ch; if (idx < 64) ch = h * 64 + idx; else if (idx < 192) ch = 512 + g * 128 + (idx - 64); else ch = 768 + g * 128 + (idx - 192);
        const float v = cbp[ch] + scv[ch] * cw[ch] + scv[1024 + ch] * cw[1024 + ch] + scv[2048 + ch] * cw[2048 + ch] + xrow[ch] * cw[3072 + ch];
        s_x[idx] = silu_f(v);
    }
    __syncthreads();
    const float dt = softplus_f(WSP(float, W_DTRAW)[(size_t)(MP + bs) * 8 + h] + p.in[15][h]);
    const float dA = expf(dt * (-expf(p.in[16][h])));
    const int l = tid & 31, rg = tid >> 5;
    const f32x4 Bv = *(LAS f32x4*)(s_B + l * 4), Cv = *(LAS f32x4*)(s_C + l * 4);
    const float* h0 = p.in[2] + ((size_t)(bs * 8 + h) * 64) * 128;
    float* ho = p.out + O_SSMS + ((size_t)(bs * 8 + h) * 64) * 128;
    f32x4 hv[8];
#pragma unroll
    for (int i = 0; i < 8; ++i) hv[i] = *(const f32x4*)(h0 + (size_t)(rg + 8 * i) * 128 + l * 4);
#pragma unroll
    for (int i = 0; i < 8; ++i) {
        const int pp = rg + 8 * i;
        const float dx = dt * s_x[pp];
        f32x4 hn = hv[i] * dA + Bv * dx;
        *(f32x4*)(ho + (size_t)pp * 128 + l * 4) = hn;
        float y = hn[0] * Cv[0] + hn[1] * Cv[1] + hn[2] * Cv[2] + hn[3] * Cv[3];
        y += __shfl_xor(y, 16); y += __shfl_xor(y, 8); y += __shfl_xor(y, 4); y += __shfl_xor(y, 2); y += __shfl_xor(y, 1);
        if (l == 0) s_y[pp] = y;
    }
    __syncthreads();
    if (tid < 64) {
        const float xv = s_x[tid];
        const float y = s_y[tid] + p.in[17][h] * xv;
        const float z = bf2f(WSP(bf16_t, W_ZB)[(size_t)(MP + bs) * 512 + h * 64 + tid]);
        const float yz = y * silu_f(z);
        const unsigned q = pk2(yz, 0.f) & 0xffffu;
        WSP(bf16_t, W_CONCAT)[(size_t)(MP + bs) * 1024 + 512 + h * 64 + tid] = (bf16_t)q;
        const float yr = bflo(q);
        const float ssq = wave_sum(yr * yr);
        if (tid == 0) atomicAdd(WSP(float, W_ZERO) + (size_t)MT * 2 + (size_t)(MP + bs) * 2 + g, ssq);
    }
    __syncthreads();
}
__device__ __forceinline__ void p2_sample_misc(const Params& p, int bs) {
    TIDV;
    const float* vstat = WSP(float, W_ZERO);
    const int tok = MP + bs;
    const float mean = vstat[(size_t)tok * 2] * (1.f / 512.f);
    const float var = vstat[(size_t)tok * 2 + 1] * (1.f / 512.f) - mean * mean;
    const float rstd = rsqrtf(fmaxf(var, 0.f) + EPS);
    for (int ch = tid; ch < 512; ch += 256) {
        const int hd = ch >> 7;
        const float v = bf2f(WSP(bf16_t, W_VG)[(size_t)tok * 512 + ch]);
        const float vl = (v - mean) * rstd * p.in[9][ch] + p.in[10][ch];
        p.out[O_GVS + (size_t)bs * 512 + ch] = vl;
        const float u = bf2f(WSP(bf16_t, W_UB)[(size_t)tok * 512 + ch]);
        const float gout = u * (p.in[11][hd * 128 * 128] * vl + p.in[12][hd * 128]);
        WSP(bf16_t, W_CONCAT)[(size_t)tok * 1024 + ch] = (bf16_t)(pk2(gout, 0.f) & 0xffffu);
    }
    const float* scv = p.in[3] + (size_t)bs * 3 * 1024;
    float* co = p.out + O_CONVS + (size_t)bs * 3 * 1024;
    for (int i = tid; i < 2048; i += 256) co[i] = scv[1024 + i];
}
__device__ __forceinline__ void phase2(const Params& p, LAS char* lds) {
    constexpr int N1 = 1024, N2 = 2048, N3 = 512, N4 = 128;
    for (int it = blockIdx.x; it < N1 + N2 + N3 + N4; it += gridDim.x) {
        if (it < N1) p2_sample_ssd(p, it, lds);
        else if (it < N1 + N2) p2_conv(p, it - N1, lds);
        else if (it < N1 + N2 + N3) p2_vln(p, it - N1 - N2, lds);
        else p2_sample_misc(p, it - N1 - N2 - N3);
    }
}

__device__ __forceinline__ void p3_cb(const Params& p, int item, LAS char* lds) {
    TIDV;
    const int cc = item >> 1, g = item & 1, tok0 = cc * 128;
    f32x4 acc[4][4]; zero_acc<4>(acc);
    mma_seg<128, 0>(acc, WSP(bf16_t, W_CN) + (size_t)tok0 * 256 + g * 128, 256, WSP(bf16_t, W_BN) + (size_t)tok0 * 256 + g * 128, 256, 128, lds, nullptr);
    const int tb = wm * 64 + fr, sb = wn * 64 + fq * 4;
#pragma unroll 1
    for (int jh = 0; jh < 4; ++jh) {
        const int h = g * 4 + jh;
        const float* ac = WSP(float, W_ACUM) + (size_t)(cc * 8 + h) * 128;
        const float* dv = WSP(float, W_DTV) + (size_t)(cc * 8 + h) * 128;
        bf16_t* mt_ = WSP(bf16_t, W_MT) + (size_t)(cc * 8 + h) * 128 * 128;
        float at[4];
#pragma unroll
        for (int mi = 0; mi < 4; ++mi) at[mi] = ac[tb + mi * 16];
#pragma unroll
        for (int ni = 0; ni < 4; ++ni) {
            const f32x4 as = *(const f32x4*)(ac + sb + ni * 16), ds = *(const f32x4*)(dv + sb + ni * 16);
#pragma unroll
            for (int mi = 0; mi < 4; ++mi) {
                const int t = tb + mi * 16, s0 = sb + ni * 16;
                float v[4];
#pragma unroll
                for (int j = 0; j < 4; ++j) v[j] = (s0 + j <= t) ? acc[mi][ni][j] * __expf(at[mi] - as[j]) * ds[j] : 0.f;
                u32x2 o; o.x = pk2(v[0], v[1]); o.y = pk2(v[2], v[3]);
                *(u32x2*)(mt_ + (size_t)t * 128 + s0) = o;
            }
        }
    }
}
__device__ __forceinline__ void p3_gmlp(const Params& p, int item, LAS char* lds) {
    TIDV;
    const int cc = item >> 2, head = item & 3, tok0 = cc * 128;
    f32x4 acc[4][4]; zero_acc<4>(acc);
    mma_seg<128, 0>(acc, WSP(bf16_t, W_WSB) + (size_t)head * 128 * 128, 128, WSP(bf16_t, W_VLNT) + (size_t)(cc * 4 + head) * 128 * 128, 128, 128, lds, nullptr);
    const int tb = wm * 64 + fr, db = wn * 64 + fq * 4;
    const bf16_t* ub = WSP(bf16_t, W_UB); bf16_t* cat = WSP(bf16_t, W_CONCAT);
#pragma unroll
    for (int mi = 0; mi < 4; ++mi) {
        const int t = tb + mi * 16;
        const float bias = p.in[12][head * 128 + t];
#pragma unroll
        for (int ni = 0; ni < 4; ++ni) {
            const int d = db + ni * 16;
            const u32x2 uq = *(const u32x2*)(ub + (size_t)(tok0 + t) * 512 + head * 128 + d);
            const f32x4 a = acc[mi][ni];
            u32x2 o; o.x = pk2((a[0] + bias) * bflo(uq.x), (a[1] + bias) * bfhi(uq.x)); o.y = pk2((a[2] + bias) * bflo(uq.y), (a[3] + bias) * bfhi(uq.y));
            *(u32x2*)(cat + (size_t)(tok0 + t) * 1024 + head * 128 + d) = o;
        }
    }
}
__device__ __forceinline__ void p3_states(const Params& p, int item, LAS char* lds) {
    TIDV;
    const int cc = item >> 3, h = item & 7, g = h >> 2;
    f32x4 acc[4][2]; zero_acc<2>(acc);
    mma_seg<64, 0>(acc, WSP(bf16_t, W_BT) + (size_t)(cc * 2 + g) * 128 * 128, 128, WSP(bf16_t, W_XWT) + (size_t)(cc * 8 + h) * 64 * 128, 128, 128, lds, nullptr);
    float* sc = WSP(float, W_SC) + (size_t)(cc * 8 + h) * 64 * 128;
    const int nb = wm * 64 + fr, pb = wn * 32 + fq * 4;
#pragma unroll
    for (int mi = 0; mi < 4; ++mi)
#pragma unroll
        for (int ni = 0; ni < 2; ++ni)
#pragma unroll
            for (int j = 0; j < 4; ++j) sc[(size_t)(pb + ni * 16 + j) * 128 + nb + mi * 16] = acc[mi][ni][j];
}
__device__ __forceinline__ void phase3(const Params& p, LAS char* lds) {
    constexpr int N1 = 256, N2 = 512, N3 = 1024;
    for (int it = blockIdx.x; it < N1 + N2 + N3; it += gridDim.x) {
        if (it < N1) p3_cb(p, it, lds);
        else if (it < N1 + N2) p3_gmlp(p, it - N1, lds);
        else p3_states(p, it - N1 - N2, lds);
    }
}

__device__ __forceinline__ void phase4(const Params& p) {
    for (int it = blockIdx.x; it < 512; it += gridDim.x) {
        const int idx4 = it * 256 + threadIdx.x;
        const int bh = idx4 >> 11, rem = (idx4 & 2047) * 4, b = bh >> 3, h = bh & 7;
        f32x4 st = {0.f, 0.f, 0.f, 0.f};
        const float* sc = WSP(float, W_SC); bf16_t* hp_ = WSP(bf16_t, W_HPREV); const float* ac = WSP(float, W_ACUM);
        f32x4 nxt = *(const f32x4*)(sc + ((size_t)((b * 16) * 8 + h)) * 8192 + rem);
#pragma unroll 1
        for (int c = 0; c < 16; ++c) {
            const size_t base = ((size_t)((b * 16 + c) * 8 + h)) * 8192 + rem;
            const f32x4 cur = nxt;
            if (c + 1 < 16) nxt = *(const f32x4*)(sc + base + 8 * 8192);
            u32x2 o; o.x = pk2(st[0], st[1]); o.y = pk2(st[2], st[3]);
            *(u32x2*)(hp_ + base) = o;
            const float dec = __expf(ac[(size_t)((b * 16 + c) * 8 + h) * 128 + 127]);
            st = st * dec + cur;
        }
        *(f32x4*)(p.out + O_SSMP + (size_t)idx4 * 4) = st;
    }
}

__device__ __forceinline__ void p5_y(const Params& p, int item, LAS char* lds) {
    TIDV;
    const int cc = item >> 3, h = item & 7, g = h >> 2, tok0 = cc * 128;
    f32x4 acc[4][2]; zero_acc<2>(acc);
    mma_seg<64, 0>(acc, WSP(bf16_t, W_CN) + (size_t)tok0 * 256 + g * 128, 256, WSP(bf16_t, W_HPREV) + (size_t)(cc * 8 + h) * 64 * 128, 128, 128, lds, nullptr);
    const float* ac = WSP(float, W_ACUM) + (size_t)(cc * 8 + h) * 128;
    const int tb = wm * 64 + fr, pb = wn * 32 + fq * 4;
#pragma unroll
    for (int mi = 0; mi < 4; ++mi) { const float e = __expf(ac[tb + mi * 16]);
#pragma unroll
        for (int ni = 0; ni < 2; ++ni) acc[mi][ni] = acc[mi][ni] * e; }
    mma_seg<64, 0>(acc, WSP(bf16_t, W_MT) + (size_t)(cc * 8 + h) * 128 * 128, 128, WSP(bf16_t, W_XT) + (size_t)(cc * 8 + h) * 64 * 128, 128, 128, lds, nullptr);
    const float dsk = p.in[17][h];
    const bf16_t* xn = WSP(bf16_t, W_XN); const bf16_t* zb = WSP(bf16_t, W_ZB); bf16_t* cat = WSP(bf16_t, W_CONCAT);
    float* gss = WSP(float, W_ZERO) + (size_t)MT * 2;
#pragma unroll
    for (int mi = 0; mi < 4; ++mi) {
        const int tok = tok0 + tb + mi * 16;
        float ssq = 0.f;
#pragma unroll
        for (int ni = 0; ni < 2; ++ni) {
            const int pc = h * 64 + pb + ni * 16;
            const u32x2 xq = *(const u32x2*)(xn + (size_t)tok * 512 + pc), zq = *(const u32x2*)(zb + (size_t)tok * 512 + pc);
            const f32x4 a = acc[mi][ni];
            const float y0 = (a[0] + dsk * bflo(xq.x)) * silu_f(bflo(zq.x)), y1 = (a[1] + dsk * bfhi(xq.x)) * silu_f(bfhi(zq.x));
            const float y2 = (a[2] + dsk * bflo(xq.y)) * silu_f(bflo(zq.y)), y3 = (a[3] + dsk * bfhi(xq.y)) * silu_f(bfhi(zq.y));
            u32x2 o; o.x = pk2(y0, y1); o.y = pk2(y2, y3);
            const float r0 = bflo(o.x), r1 = bfhi(o.x), r2 = bflo(o.y), r3 = bfhi(o.y);
            ssq += (r0 * r0 + r1 * r1) + (r2 * r2 + r3 * r3);
            *(u32x2*)(cat + (size_t)tok * 1024 + 512 + pc) = o;
        }
        ssq = fq_sum(ssq);
        if (fq == 0) atomicAdd(gss + (size_t)tok * 2 + g, ssq);
    }
}
__device__ __forceinline__ void phase5(const Params& p, LAS char* lds) {
    for (int it = blockIdx.x; it < 1024; it += gridDim.x) p5_y(p, it, lds);
}

template <int MODE>
__device__ __forceinline__ void res_gemm_tile(const Params& p, int mt, int nt, LAS char* lds) {
    TIDV;
    f32x4 acc[4][4]; zero_acc<4>(acc);
    const int m0 = mt * 128, n0 = nt * 128;
    if (MODE == 0) {
        const bf16_t* Ab = WSP(bf16_t, W_CONCAT) + (size_t)m0 * 1024; const bf16_t* Wb = WSP(bf16_t, W_WOUT) + (size_t)n0 * 1024;
        const float* gss = WSP(float, W_ZERO) + (size_t)MT * 2;
        float r0[4], r1[4];
#pragma unroll
        for (int mi = 0; mi < 4; ++mi) { const int row = m0 + wm * 64 + mi * 16 + fr;
            r0[mi] = rsqrtf(gss[(size_t)row * 2] * (1.f / 256.f) + EPS); r1[mi] = rsqrtf(gss[(size_t)row * 2 + 1] * (1.f / 256.f) + EPS); }
        mma_seg<128, 0>(acc, Ab + 512, 1024, Wb + 512, 1024, 256, lds, nullptr);
#pragma unroll
        for (int mi = 0; mi < 4; ++mi) { const float f = r0[mi] / r1[mi];
#pragma unroll
            for (int ni = 0; ni < 4; ++ni) acc[mi][ni] = acc[mi][ni] * f; }
        mma_seg<128, 0>(acc, Ab + 768, 1024, Wb + 768, 1024, 256, lds, nullptr);
#pragma unroll
        for (int mi = 0; mi < 4; ++mi)
#pragma unroll
            for (int ni = 0; ni < 4; ++ni) acc[mi][ni] = acc[mi][ni] * r1[mi];
        mma_seg<128, 0>(acc, Ab, 1024, Wb, 1024, 512, lds, nullptr);
    }
    else if (MODE == 1) mma_seg<128, 0>(acc, WSP(bf16_t, W_OB) + (size_t)m0 * 1024, 1024, WSP(bf16_t, W_WXO) + (size_t)n0 * 1024, 1024, 1024, lds, nullptr);
    else mma_seg<128, 0>(acc, WSP(bf16_t, W_ACT) + (size_t)m0 * 2816, 2816, WSP(bf16_t, W_WD) + (size_t)n0 * 2816, 2816, 2816, lds, nullptr);
    const int rb = m0 + wm * 64 + fr, cb = n0 + wn * 64 + fq * 4;
    float* hp = WSP(float, W_HP); bf16_t* hpb = WSP(bf16_t, W_HPB);
    float* ssq_ = WSP(float, W_ZERO) + (size_t)MT * 4 + (size_t)MT * MODE;
#pragma unroll
    for (int mi = 0; mi < 4; ++mi) {
        const int row = rb + mi * 16;
        const float* rsrc;
        if (MODE == 0) rsrc = row < MP ? p.in[0] + (size_t)row * 1024 : p.in[1] + (size_t)(row - MP) * 1024;
        else rsrc = hp + (size_t)row * 1024;
        float ssq = 0.f;
#pragma unroll
        for (int ni = 0; ni < 4; ++ni) {
            const int col = cb + ni * 16;
            const f32x4 r = *(const f32x4*)(rsrc + col);
            const f32x4 v = acc[mi][ni] + r;
            *(f32x4*)(hp + (size_t)row * 1024 + col) = v;
            ssq += (v[0] * v[0] + v[1] * v[1]) + (v[2] * v[2] + v[3] * v[3]);
            if (MODE != 2) { u32x2 o; o.x = pk2(v[0], v[1]); o.y = pk2(v[2], v[3]); *(u32x2*)(hpb + (size_t)row * 1024 + col) = o; }
        }
        ssq = fq_sum(ssq);
        if (fq == 0) atomicAdd(ssq_ + row, ssq);
    }
}
template <int MODE>
__device__ __forceinline__ void phase_res(const Params& p, LAS char* lds) {
    int t;
    for (int i = 0; (t = sched(i, 129 * 8)) >= 0; ++i) { int mt, nt; tile_mn(t, 129, 8, mt, nt); res_gemm_tile<MODE>(p, mt, nt, lds); }
}

__device__ __forceinline__ void phase7(const Params& p, LAS char* lds) {
    TIDV;
    int t;
    for (int i = 0; (t = sched(i, 129 * 8)) >= 0; ++i) {
        int mt, nt; tile_mn(t, 129, 8, mt, nt);
        f32x4 acc[4][4]; zero_acc<4>(acc);
        const int m0 = mt * 128, n0 = nt * 128;
        mma_seg<128, 0>(acc, WSP(bf16_t, W_HPB) + (size_t)m0 * 1024, 1024, WSP(bf16_t, W_WQ) + (size_t)n0 * 1024, 1024, 1024, lds, nullptr);
        const int rb = m0 + wm * 64 + fr, cb = n0 + wn * 64 + fq * 4;
        const float* ss1 = WSP(float, W_ZERO) + (size_t)MT * 4;
        bf16_t* qb = WSP(bf16_t, W_QB);
#pragma unroll
        for (int mi = 0; mi < 4; ++mi) {
            const int row = rb + mi * 16;
            const float rs = rsqrtf(ss1[row] * (1.f / 1024.f) + EPS);
#pragma unroll
            for (int ni = 0; ni < 4; ++ni) { const f32x4 a = acc[mi][ni] * rs; u32x2 o; o.x = pk2(a[0], a[1]); o.y = pk2(a[2], a[3]);
                *(u32x2*)(qb + (size_t)row * 1024 + cb + ni * 16) = o; }
        }
    }
}

__device__ __forceinline__ void p8_prompt(const Params& p, int item, LAS char* lds) {
    TIDV;
    const int qt = item & 15, head = (item >> 4) & 3, b = item >> 6;
    const int tokq = b * 2048 + qt * 128;
    const bf16_t* qa = WSP(bf16_t, W_QB) + (size_t)tokq * 1024 + head * 256;
    const bf16_t* kbp = WSP(bf16_t, W_KB) + (size_t)(b * 256) * 1024 + head * 256;
    f32x4 s0[4][4], s1[4][4]; zero_acc<4>(s0); zero_acc<4>(s1);
    mma_seg<128, 0>(s0, qa, 1024, kbp, 1024, 256, lds, nullptr);
    mma_seg<128, 0>(s1, qa, 1024, kbp + (size_t)128 * 1024, 1024, 256, lds, nullptr);
    LAS float* red = (LAS float*)(lds + LDS_MISC + 64);
    float rinv[4];
    float mx[4];
#pragma unroll
    for (int mi = 0; mi < 4; ++mi) {
        float m = -3.0e38f;
#pragma unroll
        for (int ni = 0; ni < 4; ++ni)
#pragma unroll
            for (int j = 0; j < 4; ++j) m = fmaxf(m, fmaxf(s0[mi][ni][j], s1[mi][ni][j]));
        m = fq_max(m);
        if (fq == 0) red[wn * 128 + wm * 64 + mi * 16 + fr] = m;
        mx[mi] = m;
    }
    __syncthreads();
#pragma unroll
    for (int mi = 0; mi < 4; ++mi) mx[mi] = fmaxf(mx[mi], red[(wn ^ 1) * 128 + wm * 64 + mi * 16 + fr]);
#pragma unroll
    for (int mi = 0; mi < 4; ++mi) {
        float sum = 0.f;
        const int t = wm * 64 + mi * 16 + fr;
#pragma unroll
        for (int ni = 0; ni < 4; ++ni) {
            const int mcol = wn * 64 + ni * 16 + fq * 4;
            u32x2 o0, o1;
            o0.x = pk2(__expf(s0[mi][ni][0] - mx[mi]), __expf(s0[mi][ni][1] - mx[mi])); o0.y = pk2(__expf(s0[mi][ni][2] - mx[mi]), __expf(s0[mi][ni][3] - mx[mi]));
            o1.x = pk2(__expf(s1[mi][ni][0] - mx[mi]), __expf(s1[mi][ni][1] - mx[mi])); o1.y = pk2(__expf(s1[mi][ni][2] - mx[mi]), __expf(s1[mi][ni][3] - mx[mi]));
            sum += (bflo(o0.x) + bfhi(o0.x)) + (bflo(o0.y) + bfhi(o0.y)) + (bflo(o1.x) + bfhi(o1.x)) + (bflo(o1.y) + bfhi(o1.y));
            const int c0 = mcol >> 3, c1 = (mcol + 128) >> 3, sub = (mcol & 7) * 2;
            *(LAS u32x2*)(lds + t * 512 + ((c0 ^ (t & 15)) << 4) + sub) = o0;
            *(LAS u32x2*)(lds + t * 512 + ((c1 ^ (t & 15)) << 4) + sub) = o1;
        }
        sum = fq_sum(sum);
        if (fq == 0) red[256 + wn * 128 + t] = sum;
        rinv[mi] = sum;
        __builtin_amdgcn_sched_barrier(0);
    }
    __syncthreads();
#pragma unroll
    for (int mi = 0; mi < 4; ++mi) rinv[mi] = 1.f / (rinv[mi] + red[256 + (wn ^ 1) * 128 + wm * 64 + mi * 16 + fr]);
    const bf16_t* vtp = WSP(bf16_t, W_VT) + (size_t)(b * 4 + head) * 256 * 256;
    bf16_t* ob = WSP(bf16_t, W_OB);
#pragma unroll 1
    for (int nn = 0; nn < 2; ++nn) {
        f32x4 acc[4][4]; zero_acc<4>(acc);
        const bf16_t* vb = vtp + (size_t)(nn * 128 + wn * 64 + fr) * 256 + fq * 8;
        bf16x8 bcur[4], bnxt[4];
#pragma unroll
        for (int ni = 0; ni < 4; ++ni) bcur[ni] = *(const bf16x8*)(vb + (size_t)(ni * 16) * 256);
#pragma unroll 1
        for (int kk = 0; kk < 8; ++kk) {
            if (kk + 1 < 8) {
#pragma unroll
                for (int ni = 0; ni < 4; ++ni) bnxt[ni] = *(const bf16x8*)(vb + (size_t)(ni * 16) * 256 + (kk + 1) * 32);
            }
            bf16x8 af[4];
#pragma unroll
            for (int mi = 0; mi < 4; ++mi) { const int t = wm * 64 + mi * 16 + fr; af[mi] = *(LAS bf16x8*)(lds + t * 512 + (((kk * 4 + fq) ^ (t & 15)) << 4)); }
#pragma unroll
            for (int mi = 0; mi < 4; ++mi)
#pragma unroll
                for (int ni = 0; ni < 4; ++ni) acc[mi][ni] = __builtin_amdgcn_mfma_f32_16x16x32_bf16(bcur[ni], af[mi], acc[mi][ni], 0, 0, 0);
            if (kk + 1 < 8) {
#pragma unroll
                for (int ni = 0; ni < 4; ++ni) bcur[ni] = bnxt[ni];
            }
        }
#pragma unroll
        for (int mi = 0; mi < 4; ++mi)
#pragma unroll
            for (int ni = 0; ni < 4; ++ni) { const f32x4 a = acc[mi][ni] * rinv[mi]; u32x2 o; o.x = pk2(a[0], a[1]); o.y = pk2(a[2], a[3]);
                *(u32x2*)(ob + (size_t)(tokq + wm * 64 + mi * 16 + fr) * 1024 + head * 256 + nn * 128 + wn * 64 + ni * 16 + fq * 4) = o; }
    }
    __syncthreads();
}
__device__ __forceinline__ void p8_sample(const Params& p, int item, LAS char* lds) {
    TIDV;
    const int bs = item >> 2, head = item & 3;
    LAS float* s_q = (LAS float*)lds; LAS float* s_sc = s_q + 256; LAS float* s_red = s_sc + 256; LAS float* s_part = s_red + 16;
    s_q[tid] = bf2f(WSP(bf16_t, W_QB)[(size_t)(MP + bs) * 1024 + head * 256 + tid]);
    __syncthreads();
    const f32x4 qv = *(LAS f32x4*)(s_q + lane * 4);
    const float* kc = p.in[4] + ((size_t)(bs * 256) * 4 + head) * 256 + lane * 4;
    const float* vc = p.in[5] + ((size_t)(bs * 256) * 4 + head) * 256 + lane * 4;
#pragma unroll 1
    for (int i = 0; i < 64; i += 8) {
        f32x4 kv[8];
#pragma unroll
        for (int u = 0; u < 8; ++u) kv[u] = *(const f32x4*)(kc + (size_t)(wid * 64 + i + u) * 1024);
#pragma unroll
        for (int u = 0; u < 8; ++u) { float d = kv[u][0] * qv[0] + kv[u][1] * qv[1] + kv[u][2] * qv[2] + kv[u][3] * qv[3]; d = wave_sum(d); if (lane == 0) s_sc[wid * 64 + i + u] = d; }
    }
    __syncthreads();
    const float sv = s_sc[tid];
    float m = wave_max(sv);
    if (lane == 0) s_red[wid] = m;
    __syncthreads();
    m = fmaxf(fmaxf(s_red[0], s_red[1]), fmaxf(s_red[2], s_red[3]));
    const float e = __expf(sv - m);
    float sm = wave_sum(e);
    if (lane == 0) s_red[4 + wid] = sm;
    s_sc[tid] = e;
    __syncthreads();
    const float inv = 1.f / ((s_red[4] + s_red[5]) + (s_red[6] + s_red[7]));
    f32x4 o = {0.f, 0.f, 0.f, 0.f};
#pragma unroll 1
    for (int i = 0; i < 64; i += 8) {
        f32x4 vv[8];
#pragma unroll
        for (int u = 0; u < 8; ++u) vv[u] = *(const f32x4*)(vc + (size_t)(wid * 64 + i + u) * 1024);
#pragma unroll
        for (int u = 0; u < 8; ++u) o = o + vv[u] * s_sc[wid * 64 + i + u];
    }
    *(LAS f32x4*)(s_part + wid * 256 + lane * 4) = o;
    __syncthreads();
    const float r = ((s_part[tid] + s_part[256 + tid]) + (s_part[512 + tid] + s_part[768 + tid])) * inv;
    WSP(bf16_t, W_OB)[(size_t)(MP + bs) * 1024 + head * 256 + tid] = (bf16_t)(pk2(r, 0.f) & 0xffffu);
    __syncthreads();
}
__device__ __forceinline__ void phase8(const Params& p, LAS char* lds) {
    const int flip = (blockIdx.x ^ (blockIdx.x >> 8)) & 1;
    for (int j = 0; j < 2; ++j) {
        for (int it = blockIdx.x + ((j ^ flip) ? 512 : 0); it < ((j ^ flip) ? 1024 : 512); it += gridDim.x) {
            if (it < 512) p8_sample(p, it, lds); else p8_prompt(p, it - 512, lds);
        }
    }
}

__device__ __forceinline__ void phase10(const Params& p, LAS char* lds) {
    TIDV;
    int t = sched(0, 129 * 44);
    bool pf = false;
    for (int i = 0; t >= 0; ++i) {
        int mt, nt; tile_mn(t, 129, 44, mt, nt);
        const int tn = sched(i + 1, 129 * 44);
        const bf16_t* nA = nullptr; const bf16_t* nB = nullptr;
        if (tn >= 0) { int mt2, nt2; tile_mn(tn, 129, 44, mt2, nt2); nA = WSP(bf16_t, W_HPB) + (size_t)mt2 * 128 * 1024; nB = WSP(bf16_t, W_WGU) + (size_t)nt2 * 128 * 1024; }
        f32x4 acc[4][4]; zero_acc<4>(acc);
        const int m0 = mt * 128, n0 = nt * 128;
        mma_seg_p(acc, WSP(bf16_t, W_HPB) + (size_t)m0 * 1024, 1024, WSP(bf16_t, W_WGU) + (size_t)n0 * 1024, 1024, 1024, lds, pf, nA, nB);
        pf = (tn >= 0);
        const int rb = m0 + wm * 64 + fr, cb = (n0 + wn * 64) / 2 + fq * 4;
        const float* ss2 = WSP(float, W_ZERO) + (size_t)MT * 5;
        bf16_t* act = WSP(bf16_t, W_ACT);
#pragma unroll
        for (int mi = 0; mi < 4; ++mi) {
            const int row = rb + mi * 16;
            const float rs = rsqrtf(ss2[row] * (1.f / 1024.f) + EPS);
#pragma unroll
            for (int q = 0; q < 2; ++q) {
                const f32x4 g = acc[mi][2 * q] * rs, u = acc[mi][2 * q + 1] * rs;
                u32x2 o; o.x = pk2(silu_f(g[0]) * u[0], silu_f(g[1]) * u[1]); o.y = pk2(silu_f(g[2]) * u[2], silu_f(g[3]) * u[3]);
                *(u32x2*)(act + (size_t)row * 2816 + cb + q * 16) = o;
            }
        }
        t = tn;
    }
}

__device__ __forceinline__ void phase12(const Params& p) {
    const float* hp = WSP(float, W_HP); const float* ss3 = WSP(float, W_ZERO) + (size_t)MT * 6; const float* g = p.in[30];
    const int n4 = MT * 256;
    for (int i = blockIdx.x * 256 + threadIdx.x; i < n4; i += gridDim.x * 256) {
        const int row = i >> 8, c = (i & 255) * 4;
        const float rs = rsqrtf(ss3[row] * (1.f / 1024.f) + EPS);
        const f32x4 v = *(const f32x4*)(hp + (size_t)i * 4), gv = *(const f32x4*)(g + c);
        *(f32x4*)(p.out + (size_t)i * 4) = v * rs * gv;
    }
}

#ifndef DUMP_SEL
#define DUMP_SEL 0
#endif
__device__ __forceinline__ void phase_dump(const Params& p) {
    const int n = MT * 1024;
    for (int i = blockIdx.x * 256 + threadIdx.x; i < n; i += gridDim.x * 256) {
        float v = 0.f;
        if (DUMP_SEL == 1) v = bf2f(WSP(bf16_t, W_CONCAT)[i]);
        else if (DUMP_SEL == 2) v = WSP(float, W_HP)[i];
        else if (DUMP_SEL == 3) v = bf2f(WSP(bf16_t, W_QB)[i]);
        else if (DUMP_SEL == 4) v = bf2f(WSP(bf16_t, W_OB)[i]);
        else if (DUMP_SEL == 5) v = bf2f(WSP(bf16_t, W_HPB)[i]);
        else if (DUMP_SEL == 6) v = bf2f(WSP(bf16_t, W_ACT)[(size_t)(i >> 10) * 2816 + (i & 1023)]);
        p.out[i] = v;
    }
}
__global__ void __launch_bounds__(256, 2) hymba_fwd(Params p) {
    extern __shared__ __attribute__((aligned(16))) char smem_dyn[];
    LAS char* lds = (LAS char*)smem_dyn;
    XcdBarrier xb;
    if (p.fused) {
        if (p.never) cg::this_grid().sync();
        volatile LAS unsigned* st = (volatile LAS unsigned*)(lds + LDS_MISC);
        if (threadIdx.x < 4) st[threadIdx.x] = 0u;
        __syncthreads();
        xb = xcd_barrier_post(WSP(unsigned, W_BAR), st);
    }
#ifndef DUP_MASK
#define DUP_MASK (1<<7)
#endif
#define RUN_PH(k, call) if (p.ph_lo <= (k) && (k) < p.ph_hi) { if ((DUP_MASK >> (k)) & 1) { call; xcd_barrier(xb); } call; if (p.fused && (k) + 1 < p.ph_hi) xcd_barrier(xb); }
#define PH_ON(n) (!defined(ONLY_PH) || ONLY_PH == n)
#ifndef PRE_MASK
#define PRE_MASK 0
#endif
    if (p.fused && ((PRE_MASK >> 2) & 1)) { phase2(p, lds); xcd_barrier(xb); }
    if (p.fused && ((PRE_MASK >> 5) & 1)) { phase5(p, lds); xcd_barrier(xb); }
    if (p.fused && ((PRE_MASK >> 1) & 1)) { phase1(p, lds); xcd_barrier(xb); }
    if (p.fused && ((PRE_MASK >> 6) & 1)) { phase_res<0>(p, lds); xcd_barrier(xb); }
    if (p.fused && ((PRE_MASK >> 11) & 1)) { phase_res<2>(p, lds); xcd_barrier(xb); }
#if PH_ON(0)
    RUN_PH(0, phase0(p, lds))
#endif
#if PH_ON(1)
    RUN_PH(1, phase1(p, lds))
#endif
#if PH_ON(2)
    RUN_PH(2, phase2(p, lds))
#endif
#if PH_ON(3)
    RUN_PH(3, phase3(p, lds))
#endif
#if PH_ON(4)
    RUN_PH(4, phase4(p))
#endif
#if PH_ON(5)
    RUN_PH(5, phase5(p, lds))
#endif
#if PH_ON(6)
    RUN_PH(6, phase_res<0>(p, lds))
#endif
#if PH_ON(7)
    RUN_PH(7, phase7(p, lds))
#endif
#if PH_ON(8)
    RUN_PH(8, phase8(p, lds))
#endif
#if PH_ON(9)
    RUN_PH(9, phase_res<1>(p, lds))
#endif
#if PH_ON(10)
    RUN_PH(10, phase10(p, lds))
#endif
#if PH_ON(11)
    RUN_PH(11, phase_res<2>(p, lds))
#endif
#if PH_ON(12)
    RUN_PH(12, phase12(p))
#endif
#ifdef EXTRA_BARS
    if (p.fused) { for (int i = 0; i < EXTRA_BARS; ++i) xcd_barrier(xb); }
#endif
    RUN_PH(13, phase_dump(p))
}

extern "C" void kernel_launch(void* const* d_in, const int* in_sizes, int n_in, void* d_out, int out_size, void* d_ws, size_t ws_size, hipStream_t stream) {
    static int grid = 0;
    if (grid == 0) {
        int dev = 0, cus = 0, per_cu = 0;
        hipGetDevice(&dev);
        hipDeviceGetAttribute(&cus, hipDeviceAttributeMultiprocessorCount, dev);
        hipFuncSetAttribute((const void*)hymba_fwd, hipFuncAttributeMaxDynamicSharedMemorySize, LDS_BYTES);
        hipOccupancyMaxActiveBlocksPerMultiprocessor(&per_cu, (const void*)hymba_fwd, 256, LDS_BYTES);
        if (per_cu > 2) per_cu = 2;
        if (per_cu < 1) per_cu = 1;
        grid = cus * per_cu; grid = (grid / 8) * 8;
        if (ws_size < W_END) fprintf(stderr, "kernel_launch: workspace too small: %zu < %zu\n", ws_size, (size_t)W_END);
    }
    Params p{};
    for (int i = 0; i < 31; ++i) p.in[i] = (const float*)d_in[i];
    p.out = (float*)d_out; p.ws = (char*)d_ws; p.never = 0;
#if FUSED
    hipMemsetAsync((char*)d_ws + W_BAR, 0, XCD_BAR_WORDS * 4, stream);
    p.ph_lo = 0; p.ph_hi = NPH; p.fused = 1;
    void* args[] = {&p};
    hipError_t e = hipLaunchCooperativeKernel((const void*)hymba_fwd, dim3(grid), dim3(256), args, LDS_BYTES, stream);
    if (e != hipSuccess) fprintf(stderr, "cooperative launch failed: %s (grid %d)\n", hipGetErrorString(e), grid);
#else
    p.fused = 0;
    for (int ph = 0; ph < RUN_PHASES; ++ph) {
        p.ph_lo = ph; p.ph_hi = ph + 1;
        hipLaunchKernelGGL(hymba_fwd, dim3(grid), dim3(256), LDS_BYTES, stream, p);
    }
    if (DUMP_SEL) { p.ph_lo = 13; p.ph_hi = 14; hipLaunchKernelGGL(hymba_fwd, dim3(grid), dim3(256), LDS_BYTES, stream, p); }
#endif
}
```

```cpp
#include <hip/hip_runtime.h>
#include <hip/hip_cooperative_groups.h>
#include <stdint.h>
#include <cstdio>
namespace cg = cooperative_groups;

#ifndef FUSED
#define FUSED 1
#endif
#define DUP_MASK 0
#define PRE_MASK 0
#ifndef RUN_PHASES
#define RUN_PHASES 13
#define DUMP_SEL 0
#endif

#define LAS __attribute__((address_space(3)))
typedef unsigned short bf16_t;
typedef short bf16x8 __attribute__((ext_vector_type(8)));
typedef float f32x4 __attribute__((ext_vector_type(4)));
typedef unsigned u32x4 __attribute__((ext_vector_type(4)));
typedef unsigned u32x2 __attribute__((ext_vector_type(2)));

constexpr int MP = 16384, MS = 128, MT = MP + MS;
constexpr int NCH = 128;
constexpr float EPS = 1e-6f;
constexpr int NPH = 13;

constexpr size_t O_YP = 0, O_YS = 16777216, O_SSMP = 16908288, O_CONVP = 17432576, O_GVP = 17457152,
                 O_MK = 17981440, O_MV = 20078592, O_SSMS = 22175744, O_CONVS = 30564352, O_GVS = 30957568;

constexpr size_t al(size_t x) { return (x + 255) & ~(size_t)255; }
constexpr size_t W_BAR = 0;
constexpr size_t W_ZERO = al(W_BAR + 3456 * 4);
constexpr size_t ZERO_FLOATS = (size_t)MT * 7;
constexpr size_t W_WIN = al(W_ZERO + ZERO_FLOATS * 4);
constexpr size_t W_WKV = al(W_WIN + (size_t)2688 * 1024 * 2);
constexpr size_t W_WOUT = al(W_WKV + (size_t)2048 * 1024 * 2);
constexpr size_t W_WQ = al(W_WOUT + (size_t)1024 * 1024 * 2);
constexpr size_t W_WXO = al(W_WQ + (size_t)1024 * 1024 * 2);
constexpr size_t W_WGU = al(W_WXO + (size_t)1024 * 1024 * 2);
constexpr size_t W_WD = al(W_WGU + (size_t)5632 * 1024 * 2);
constexpr size_t W_WSB = al(W_WD + (size_t)1024 * 2816 * 2);
constexpr size_t W_MEMB = al(W_WSB + (size_t)4 * 128 * 128 * 2);
constexpr size_t W_DTRAW = al(W_MEMB + (size_t)2048 * 1024 * 2);
constexpr size_t W_KB = al(W_DTRAW + (size_t)MT * 8 * 4);
constexpr size_t W_VT = al(W_KB + (size_t)2048 * 1024 * 2);
constexpr size_t W_VLNT = al(W_VT + (size_t)2048 * 1024 * 2);
constexpr size_t W_ACUM = al(W_VLNT + (size_t)MP * 512 * 2);
constexpr size_t W_DTV = al(W_ACUM + (size_t)NCH * 8 * 128 * 4);
constexpr size_t W_CONCAT = al(W_DTV + (size_t)NCH * 8 * 128 * 4);
constexpr size_t W_HP = al(W_CONCAT + (size_t)MT * 1024 * 2);
constexpr size_t W_HPB = al(W_HP + (size_t)MT * 1024 * 4);
constexpr size_t W_XB = al(W_HPB + (size_t)MT * 1024 * 2);
constexpr size_t W_UB = al(W_XB + (size_t)MT * 1024 * 2);
constexpr size_t W_VG = al(W_UB + (size_t)MT * 512 * 2);
constexpr size_t W_ZB = al(W_VG + (size_t)MT * 512 * 2);
constexpr size_t W_XBCB = al(W_ZB + (size_t)MT * 512 * 2);
constexpr size_t W_R1END = al(W_XBCB + (size_t)MT * 1024 * 2);
constexpr size_t W_ACT = W_XB;
static_assert((size_t)MT * 2816 * 2 <= W_R1END - W_XB, "act alias");
constexpr size_t W_XN = W_R1END;
constexpr size_t W_XWT = al(W_XN + (size_t)MP * 512 * 2);
constexpr size_t W_XT = al(W_XWT + (size_t)MP * 512 * 2);
constexpr size_t W_BN = al(W_XT + (size_t)MP * 512 * 2);
constexpr size_t W_BT = al(W_BN + (size_t)MP * 256 * 2);
constexpr size_t W_CN = al(W_BT + (size_t)MP * 256 * 2);
constexpr size_t W_R2END = al(W_CN + (size_t)MP * 256 * 2);
constexpr size_t W_QB = W_XN;
static_assert((size_t)MT * 1024 * 2 <= W_BN - W_XN, "qb alias");
constexpr size_t W_SC = W_R2END;
constexpr size_t W_HPREV = al(W_SC + (size_t)NCH * 8 * 64 * 128 * 4);
constexpr size_t W_MT = al(W_HPREV + (size_t)NCH * 8 * 64 * 128 * 2);
constexpr size_t W_END = al(W_MT + (size_t)NCH * 8 * 128 * 128 * 2);
constexpr size_t W_PBUF = W_SC;
constexpr size_t W_OB = W_HPREV;
static_assert((size_t)MT * 1024 * 2 <= W_END - W_HPREV, "ob alias");
static_assert(W_END < (size_t)530 * 1000 * 1000, "workspace too large");

constexpr int LDS_MISC = 65536;
constexpr int LDS_BYTES = 65536 + 4096;

struct Params {
    const float* in[31];
    float* out;
    char* ws;
    int ph_lo, ph_hi, fused, never;
};

__device__ __forceinline__ float bf2f(unsigned h) { return __uint_as_float(h << 16); }
__device__ __forceinline__ unsigned pk2(float lo, float hi) { unsigned r; asm("v_cvt_pk_bf16_f32 %0, %1, %2" : "=v"(r) : "v"(lo), "v"(hi)); return r; }
__device__ __forceinline__ float bflo(unsigned u) { return __uint_as_float(u << 16); }
__device__ __forceinline__ float bfhi(unsigned u) { return __uint_as_float(u & 0xffff0000u); }
__device__ __forceinline__ float rbf(float x) { return bflo(pk2(x, 0.f) & 0xffffu); }
__device__ __forceinline__ float gelu_t(float x) { const float u = 1.5957691216f * (x + 0.044715f * x * x * x); return x * __builtin_amdgcn_rcpf(1.f + __expf(-u)); }
__device__ __forceinline__ float silu_f(float x) { return x * __builtin_amdgcn_rcpf(1.f + __expf(-x)); }
__device__ __forceinline__ float softplus_f(float x) { return x > 20.f ? x : log1pf(expf(x)); }
__device__ __forceinline__ float wave_sum(float v) {
#pragma unroll
    for (int o = 1; o < 64; o <<= 1) v += __shfl_xor(v, o);
    return v;
}
__device__ __forceinline__ float wave_max(float v) {
#pragma unroll
    for (int o = 1; o < 64; o <<= 1) v = fmaxf(v, __shfl_xor(v, o));
    return v;
}
__device__ __forceinline__ u32x4 scale8(u32x4 v, float s) {
    u32x4 o;
    o.x = pk2(bflo(v.x) * s, bfhi(v.x) * s); o.y = pk2(bflo(v.y) * s, bfhi(v.y) * s);
    o.z = pk2(bflo(v.z) * s, bfhi(v.z) * s); o.w = pk2(bflo(v.w) * s, bfhi(v.w) * s);
    return o;
}

#define XB_TMO      128
#define XB_XCNT(j)  (256  + 64 * (j))
#define XB_XSUB(j)  (1280 + 64 * (j))
#define XB_XGEN(j)  (2304 + 64 * (j))
#define XB_TOP      3328
#define XB_TOPGEN   3392
#define XCD_BAR_WORDS 3456
#define XB_SPIN_CAP (1u << 22)
__device__ __forceinline__ unsigned xb_ld(unsigned* p)              { return __hip_atomic_load(p, __ATOMIC_RELAXED, __HIP_MEMORY_SCOPE_AGENT); }
__device__ __forceinline__ unsigned xb_add(unsigned* p, unsigned v) { return __hip_atomic_fetch_add(p, v, __ATOMIC_RELAXED, __HIP_MEMORY_SCOPE_AGENT); }
__device__ __forceinline__ unsigned xb_xcc_id() { return (unsigned)__builtin_amdgcn_s_getreg((3 << 11) | 20) & 0xFu; }
#define XB_SPIN(cond, bar) do { unsigned _sp = 0; while (cond) { __builtin_amdgcn_s_sleep(1); \
    if ((++_sp & 255u) == 0u) { if (xb_ld(&(bar)[XB_TMO])) break; if (_sp > XB_SPIN_CAP) { atomicAdd(&(bar)[XB_TMO], 1u); break; } } } } while (0)
struct XcdBarrier { unsigned* bar; unsigned x; volatile LAS unsigned* st; };
__device__ __forceinline__ XcdBarrier xcd_barrier_post(unsigned* bar, volatile LAS unsigned* st) {
    XcdBarrier b; b.bar = bar; b.x = xb_xcc_id(); b.st = st;
    if (threadIdx.x == 0) (void)xb_add(&bar[XB_XCNT(b.x)], 1u);
    return b;
}
__device__ __forceinline__ void xcd_barrier_complete(unsigned* bar, unsigned x, unsigned& nloc, unsigned& nx) {
    const unsigned G = gridDim.x * gridDim.y * gridDim.z;
    unsigned sum, cnt, mine, sp = 0u;
    for (;;) {
        sum = 0u; cnt = 0u; mine = 0u;
#pragma unroll
        for (unsigned j = 0; j < 16; ++j) { const unsigned c = xb_ld(&bar[XB_XCNT(j)]); sum += c; cnt += (c > 0u) ? 1u : 0u; mine = (j == x) ? c : mine; }
        if (sum == G) break;
        __builtin_amdgcn_s_sleep(1);
        if ((++sp & 255u) == 0u) { if (xb_ld(&bar[XB_TMO])) break; if (sp > XB_SPIN_CAP) { atomicAdd(&bar[XB_TMO], 1u); break; } }
    }
    nloc = mine > 0u ? mine : 1u; nx = cnt > 0u ? cnt : 1u;
}
__device__ __forceinline__ void xcd_barrier(const XcdBarrier& b) {
    asm volatile("s_waitcnt vmcnt(0)" ::: "memory");
    __syncthreads();
    if (threadIdx.x == 0) {
        unsigned* bar = b.bar;
        __builtin_amdgcn_s_waitcnt(0);
        unsigned nloc = b.st[0], nx = b.st[1];
        if (nloc == 0u) { xcd_barrier_complete(bar, b.x, nloc, nx); b.st[0] = nloc; b.st[1] = nx; }
        const unsigned old = xb_add(&bar[XB_XSUB(b.x)], 1u);
        const unsigned gen = old / nloc;
        if (old + 1u == (gen + 1u) * nloc) {
            __builtin_amdgcn_fence(__ATOMIC_RELEASE, "agent");
            asm volatile("s_waitcnt vmcnt(0)" ::: "memory");
            const unsigned og = xb_add(&bar[XB_TOP], 1u);
            const unsigned tg = og / nx;
            if (og + 1u == (tg + 1u) * nx) xb_add(&bar[XB_TOPGEN], 1u);
            else XB_SPIN(xb_ld(&bar[XB_TOPGEN]) == tg, bar);
            __builtin_amdgcn_fence(__ATOMIC_ACQUIRE, "agent");
            xb_add(&bar[XB_XGEN(b.x)], 1u);
            asm volatile("s_waitcnt vmcnt(0)" ::: "memory");
        } else {
            XB_SPIN(xb_ld(&bar[XB_XGEN(b.x)]) == gen, bar);
            __builtin_amdgcn_fence(__ATOMIC_ACQUIRE, "agent");
            asm volatile("s_waitcnt vmcnt(0)" ::: "memory");
        }
    }
    __syncthreads();
}

__device__ __forceinline__ int sched(int i, int T) {
    const int x = blockIdx.x & 7, lb = blockIdx.x >> 3, nlb = gridDim.x >> 3;
    const int chunk = (T + 7) >> 3, local = lb + i * nlb;
    if (local >= chunk) return -1;
    const int t = x * chunk + local;
    return t < T ? t : -1;
}
__device__ __forceinline__ void tile_mn(int t, int NMt, int NNt, int& mt, int& nt) {
    const int per = 8 * NNt, gi = t / per, r = t - gi * per, fm = gi * 8;
    const int gsz = (NMt - fm) < 8 ? (NMt - fm) : 8;
    mt = fm + r % gsz; nt = r / gsz;
}

template <int BN, int AMODE>
__device__ __forceinline__ void mma_seg(f32x4 (&acc)[4][BN / 32], const bf16_t* __restrict__ A, const int lda,
                                        const bf16_t* __restrict__ Bt, const int ldb, const int K, LAS char* lds,
                                        const float* __restrict__ gssrow) {
    constexpr int NI = BN / 32;
    const int tid = threadIdx.x, lane = tid & 63, wid = __builtin_amdgcn_readfirstlane(tid >> 6), wm = wid >> 1, wn = wid & 1, fr = lane & 15, fq = lane >> 4;
    const int srow = tid >> 3, sc = tid & 7;
    const int csw = (sc ^ ((srow >> 1) & 7)) * 8;
    const bf16_t* ap = A + (size_t)srow * lda + (AMODE == 1 ? sc * 8 : csw);
    const bf16_t* bp = Bt + (size_t)srow * ldb + csw;
    const int woff = srow * 128 + ((sc ^ ((srow >> 1) & 7)) << 4);
    const int gl = wid * 1024;
    const int sw = (fr >> 1) & 7;
    const int aoff = (wm * 64 + fr) * 128, boff = 32768 + (wn * (BN / 2) + fr) * 128;
    u32x4 ra[4];
    float asc[4];
    const int nk = K >> 6;
#define MS_ISSUE(kt, buf) do { \
    if (AMODE == 1) { \
        _Pragma("unroll") for (int i = 0; i < 4; ++i) ra[i] = *(const u32x4*)(ap + (size_t)(i * 32) * lda + (kt) * 64); \
        const int k_ = (kt) * 64 + sc * 8; \
        _Pragma("unroll") for (int i = 0; i < 4; ++i) asc[i] = (k_ >= 512) ? rsqrtf(gssrow[(srow + 32 * i) * 2 + ((k_ - 512) >> 8)] * (1.f / 256.f) + EPS) : 1.f; \
    } else { \
        _Pragma("unroll") for (int i = 0; i < 4; ++i) __builtin_amdgcn_global_load_lds((const unsigned*)(ap + (size_t)(i * 32) * lda + (kt) * 64), (LAS unsigned*)(lds + (buf) * 16384 + i * 4096 + gl), 16, 0, 0); \
    } \
    _Pragma("unroll") for (int i = 0; i < NI; ++i) __builtin_amdgcn_global_load_lds((const unsigned*)(bp + (size_t)(i * 32) * ldb + (kt) * 64), (LAS unsigned*)(lds + 32768 + (buf) * 16384 + i * 4096 + gl), 16, 0, 0); \
  } while (0)
#define MS_STORE(buf) do { if (AMODE == 1) { \
    _Pragma("unroll") for (int i = 0; i < 4; ++i) { *(LAS u32x4*)(lds + (buf) * 16384 + woff + i * 4096) = scale8(ra[i], asc[i]); } } \
  } while (0)
    __syncthreads();
    MS_ISSUE(0, 0);
    MS_STORE(0);
    asm volatile("s_waitcnt vmcnt(0)" ::: "memory");
    __syncthreads();
    for (int kt = 0; kt < nk; ++kt) {
        const int cur = kt & 1;
        if (kt + 1 < nk) MS_ISSUE(kt + 1, cur ^ 1);
#pragma unroll
        for (int kk = 0; kk < 2; ++kk) {
            const int co = (((kk * 4 + fq) ^ sw) << 4) + cur * 16384;
            bf16x8 af[4], bfv[NI];
#pragma unroll
            for (int mi = 0; mi < 4; ++mi) af[mi] = *(LAS bf16x8*)(lds + aoff + mi * 2048 + co);
#pragma unroll
            for (int ni = 0; ni < NI; ++ni) bfv[ni] = *(LAS bf16x8*)(lds + boff + ni * 2048 + co);
            __builtin_amdgcn_s_setprio(1);
#pragma unroll
            for (int mi = 0; mi < 4; ++mi)
#pragma unroll
                for (int ni = 0; ni < NI; ++ni) acc[mi][ni] = __builtin_amdgcn_mfma_f32_16x16x32_bf16(bfv[ni], af[mi], acc[mi][ni], 0, 0, 0);
            __builtin_amdgcn_s_setprio(0);
        }
        if (kt + 1 < nk) MS_STORE(cur ^ 1);
        asm volatile("s_waitcnt vmcnt(0)" ::: "memory");
        __syncthreads();
    }
#undef MS_ISSUE
#undef MS_STORE
}
__device__ __forceinline__ void mma_seg_p(f32x4 (&acc)[4][4], const bf16_t* __restrict__ A, const int lda, const bf16_t* __restrict__ Bt, const int ldb, const int K, LAS char* lds,
                                          const bool pf_in, const bf16_t* nA, const bf16_t* nB) {
    const int tid = threadIdx.x, lane = tid & 63, wid = __builtin_amdgcn_readfirstlane(tid >> 6), wm = wid >> 1, wn = wid & 1, fr = lane & 15, fq = lane >> 4;
    const int srow = tid >> 3, sc = tid & 7;
    const int csw = (sc ^ ((srow >> 1) & 7)) * 8;
    const size_t aofs = (size_t)srow * lda + csw, bofs = (size_t)srow * ldb + csw;
    const int gl = wid * 1024;
    const int sw = (fr >> 1) & 7;
    const int aoff = (wm * 64 + fr) * 128, boff = 32768 + (wn * 64 + fr) * 128;
    const int nk = K >> 6;
#define MP_ISSUE(AP, BP, kt, buf) do { \
    _Pragma("unroll") for (int i = 0; i < 4; ++i) __builtin_amdgcn_global_load_lds((const unsigned*)((AP) + aofs + (size_t)(i * 32) * lda + (kt) * 64), (LAS unsigned*)(lds + (buf) * 16384 + i * 4096 + gl), 16, 0, 0); \
    _Pragma("unroll") for (int i = 0; i < 4; ++i) __builtin_amdgcn_global_load_lds((const unsigned*)((BP) + bofs + (size_t)(i * 32) * ldb + (kt) * 64), (LAS unsigned*)(lds + 32768 + (buf) * 16384 + i * 4096 + gl), 16, 0, 0); \
  } while (0)
    if (!pf_in) { __syncthreads(); MP_ISSUE(A, Bt, 0, 0); }
    asm volatile("s_waitcnt vmcnt(0)" ::: "memory");
    __syncthreads();
    for (int kt = 0; kt < nk; ++kt) {
        const int cur = kt & 1;
        if (kt + 1 < nk) MP_ISSUE(A, Bt, kt + 1, cur ^ 1);
#pragma unroll
        for (int kk = 0; kk < 2; ++kk) {
            const int co = (((kk * 4 + fq) ^ sw) << 4) + cur * 16384;
            bf16x8 af[4], bfv[4];
#pragma unroll
            for (int mi = 0; mi < 4; ++mi) af[mi] = *(LAS bf16x8*)(lds + aoff + mi * 2048 + co);
#pragma unroll
            for (int ni = 0; ni < 4; ++ni) bfv[ni] = *(LAS bf16x8*)(lds + boff + ni * 2048 + co);
            __builtin_amdgcn_s_setprio(1);
#pragma unroll
            for (int mi = 0; mi < 4; ++mi)
#pragma unroll
                for (int ni = 0; ni < 4; ++ni) acc[mi][ni] = __builtin_amdgcn_mfma_f32_16x16x32_bf16(bfv[ni], af[mi], acc[mi][ni], 0, 0, 0);
            __builtin_amdgcn_s_setprio(0);
        }
        asm volatile("s_waitcnt vmcnt(0)" ::: "memory");
        __syncthreads();
    }
    if (nA) MP_ISSUE(nA, nB, 0, 0);
#undef MP_ISSUE
}
template <int NI> __device__ __forceinline__ void zero_acc(f32x4 (&acc)[4][NI]) {
#pragma unroll
    for (int mi = 0; mi < 4; ++mi)
#pragma unroll
        for (int ni = 0; ni < NI; ++ni) acc[mi][ni] = (f32x4){0.f, 0.f, 0.f, 0.f};
}
__device__ __forceinline__ float fq_sum(float v) { v += __shfl_xor(v, 16); v += __shfl_xor(v, 32); return v; }
__device__ __forceinline__ float fq_max(float v) { v = fmaxf(v, __shfl_xor(v, 16)); v = fmaxf(v, __shfl_xor(v, 32)); return v; }

#define WSP(T, off) ((T*)(p.ws + (off)))
#define TIDV const int tid = threadIdx.x, lane = tid & 63, wid = tid >> 6, wm = wid >> 1, wn = wid & 1, fr = lane & 15, fq = lane >> 4; (void)wm; (void)wn; (void)fr; (void)fq; (void)lane; (void)wid

__device__ __forceinline__ void p0_transpose(const Params& p, int item, LAS char* lds) {
    TIDV;
    LAS float* tile = (LAS float*)lds;
    int r = item; const float* s0; const float* s1 = nullptr; const float* ksc = nullptr; bf16_t* dst; int K = 1024, NT, ld, mode = 0, kso = 0, nvalid; float mul = 1.f;
    if (r < 672) { s0 = p.in[8]; dst = WSP(bf16_t, W_WIN); NT = 42; ld = 2568; nvalid = 2568; }
    else if ((r -= 672) < 512) { s0 = p.in[23]; s1 = p.in[24]; dst = WSP(bf16_t, W_WKV); mode = 1; NT = 32; ld = 1024; nvalid = 2048; }
    else if ((r -= 512) < 256) { s0 = p.in[19]; dst = WSP(bf16_t, W_WOUT); ksc = p.in[18]; kso = 512; NT = 16; ld = 1024; nvalid = 1024; }
    else if ((r -= 256) < 256) { s0 = p.in[22]; dst = WSP(bf16_t, W_WQ); ksc = p.in[20]; mul = 0.0625f; NT = 16; ld = 1024; nvalid = 1024; }
    else if ((r -= 256) < 256) { s0 = p.in[25]; dst = WSP(bf16_t, W_WXO); NT = 16; ld = 1024; nvalid = 1024; }
    else if ((r -= 256) < 1408) { s0 = p.in[27]; s1 = p.in[28]; dst = WSP(bf16_t, W_WGU); mode = 2; ksc = p.in[26]; NT = 88; ld = 2816; nvalid = 5632; }
    else { r -= 1408; s0 = p.in[29]; dst = WSP(bf16_t, W_WD); K = 2816; NT = 16; ld = 1024; nvalid = 1024; }
    const int kt = r / NT, nt = r - kt * NT, k0 = kt * 64, n0 = nt * 64;
    {
        const int tn = (tid & 15) * 4, tk = tid >> 4, n = n0 + tn;
        const float* src = s0; size_t coff = 0; const bool valid = n < nvalid;
        if (mode == 0) coff = n;
        else if (mode == 1) { if (n >= 1024) { src = s1; coff = n - 1024; } else coff = n; }
        else { const int grp = n >> 5, w = n & 31; coff = grp * 16 + (w & 15); if (w >> 4) src = s1; }
        f32x4 v[4];
#pragma unroll
        for (int i = 0; i < 4; ++i) { const int k = k0 + tk + 16 * i; v[i] = valid ? *(const f32x4*)(src + (size_t)k * ld + coff) : (f32x4){0.f, 0.f, 0.f, 0.f}; }
#pragma unroll
        for (int i = 0; i < 4; ++i) {
            const int k = k0 + tk + 16 * i;
            float sc_ = mul; if (ksc && k >= kso) sc_ *= ksc[k - kso];
            LAS float* t_ = tile + (tk + 16 * i) * 65 + tn;
            t_[0] = v[i][0] * sc_; t_[1] = v[i][1] * sc_; t_[2] = v[i][2] * sc_; t_[3] = v[i][3] * sc_;
        }
    }
    __syncthreads();
    {
        const int c = tid & 7, nl = tid >> 3;
#pragma unroll
        for (int j = 0; j < 2; ++j) {
            const int n = nl + 32 * j;
            const LAS float* s = tile + (c * 8) * 65 + n;
            u32x4 o; o.x = pk2(s[0], s[65]); o.y = pk2(s[2 * 65], s[3 * 65]); o.z = pk2(s[4 * 65], s[5 * 65]); o.w = pk2(s[6 * 65], s[7 * 65]);
            *(u32x4*)(dst + (size_t)(n0 + n) * K + k0 + c * 8) = o;
        }
    }
    __syncthreads();
}
__device__ __forceinline__ void p0_rownorm(const Params& p, int ri) {
    TIDV;
    const int row = ri * 4 + wid;
    const float* src; const float* g; bf16_t* dst;
    if (row < MT) { src = row < MP ? p.in[0] + (size_t)row * 1024 : p.in[1] + (size_t)(row - MP) * 1024; g = p.in[7]; dst = WSP(bf16_t, W_XB) + (size_t)row * 1024; }
    else { const int r2 = row - MT; src = p.in[6] + (size_t)r2 * 1024; g = p.in[21]; dst = WSP(bf16_t, W_MEMB) + (size_t)r2 * 1024; }
    float4 v[4]; float ss = 0.f;
#pragma unroll
    for (int j = 0; j < 4; ++j) { v[j] = *(const float4*)(src + (j * 64 + lane) * 4); ss += v[j].x * v[j].x + v[j].y * v[j].y + v[j].z * v[j].z + v[j].w * v[j].w; }
    const float rstd = rsqrtf(wave_sum(ss) * (1.f / 1024.f) + EPS);
#pragma unroll
    for (int j = 0; j < 4; ++j) {
        const float4 gv = *(const float4*)(g + (j * 64 + lane) * 4);
        u32x2 o; o.x = pk2(v[j].x * rstd * gv.x, v[j].y * rstd * gv.y); o.y = pk2(v[j].z * rstd * gv.z, v[j].w * rstd * gv.w);
        *(u32x2*)(dst + (j * 64 + lane) * 4) = o;
    }
}
__device__ __forceinline__ void phase0(const Params& p, LAS char* lds) {
    const int gtid = blockIdx.x * 256 + threadIdx.x, gn = gridDim.x * 256;
    float* z = WSP(float, W_ZERO);
    for (int i = gtid; i < (int)ZERO_FLOATS; i += gn) z[i] = 0.f;
    bf16_t* wsb = WSP(bf16_t, W_WSB); const float* ws = p.in[11];
    for (int i = gtid; i < 4 * 128 * 128; i += gn) { const int s = i & 127, t = (i >> 7) & 127; wsb[i] = (s <= t) ? (bf16_t)(pk2(ws[i], 0.f) & 0xffffu) : (bf16_t)0; }
    for (int it = blockIdx.x; it < 4064 + 4640; it += gridDim.x) {
        if (it < 4064) p0_transpose(p, it, lds); else p0_rownorm(p, it - 4064);
    }
}

__device__ __forceinline__ void p1_inproj_tile(const Params& p, int mt, int nt, LAS char* lds) {
    TIDV;
    f32x4 acc[4][4]; zero_acc<4>(acc);
    const int m0 = mt * 128, n0 = nt * 128;
    mma_seg<128, 0>(acc, WSP(bf16_t, W_XB) + (size_t)m0 * 1024, 1024, WSP(bf16_t, W_WIN) + (size_t)n0 * 1024, 1024, 1024, lds, nullptr);
    const int rb = m0 + wm * 64 + fr, cb = n0 + wn * 64 + fq * 4;
    if (n0 < 512) {
        bf16_t* ub = WSP(bf16_t, W_UB);
#pragma unroll
        for (int mi = 0; mi < 4; ++mi)
#pragma unroll
            for (int ni = 0; ni < 4; ++ni) { const f32x4 a = acc[mi][ni]; u32x2 o; o.x = pk2(gelu_t(a[0]), gelu_t(a[1])); o.y = pk2(gelu_t(a[2]), gelu_t(a[3]));
                *(u32x2*)(ub + (size_t)(rb + mi * 16) * 512 + cb + ni * 16) = o; }
    } else if (n0 < 1024) {
        bf16_t* vg = WSP(bf16_t, W_VG); float* vstat = WSP(float, W_ZERO);
#pragma unroll
        for (int mi = 0; mi < 4; ++mi) {
            float s1 = 0.f, s2 = 0.f;
#pragma unroll
            for (int ni = 0; ni < 4; ++ni) { const f32x4 a = acc[mi][ni]; const float g0 = gelu_t(a[0]), g1 = gelu_t(a[1]), g2 = gelu_t(a[2]), g3 = gelu_t(a[3]);
                u32x2 o; o.x = pk2(g0, g1); o.y = pk2(g2, g3);
                const float r0 = bflo(o.x), r1 = bfhi(o.x), r2 = bflo(o.y), r3 = bfhi(o.y);
                s1 += (r0 + r1) + (r2 + r3); s2 += (r0 * r0 + r1 * r1) + (r2 * r2 + r3 * r3);
                *(u32x2*)(vg + (size_t)(rb + mi * 16) * 512 + (cb - 512) + ni * 16) = o; }
            s1 = fq_sum(s1); s2 = fq_sum(s2);
            if (fq == 0) { atomicAdd(vstat + (size_t)(rb + mi * 16) * 2, s1); atomicAdd(vstat + (size_t)(rb + mi * 16) * 2 + 1, s2); }
        }
    } else if (n0 < 1536) {
        bf16_t* zb = WSP(bf16_t, W_ZB);
#pragma unroll
        for (int mi = 0; mi < 4; ++mi)
#pragma unroll
            for (int ni = 0; ni < 4; ++ni) { const f32x4 a = acc[mi][ni]; u32x2 o; o.x = pk2(a[0], a[1]); o.y = pk2(a[2], a[3]);
                *(u32x2*)(zb + (size_t)(rb + mi * 16) * 512 + (cb - 1024) + ni * 16) = o; }
    } else if (n0 < 2560) {
        bf16_t* xb = WSP(bf16_t, W_XBCB);
#pragma unroll
        for (int mi = 0; mi < 4; ++mi) {
            const int row = rb + mi * 16;
            float* fo = nullptr;
            if (row < MP) { const int t = row & 2047; if (t >= 2045) fo = p.out + O_CONVP + ((size_t)(row >> 11) * 3 + (t - 2045)) * 1024; }
            else fo = p.out + O_CONVS + ((size_t)(row - MP) * 3 + 2) * 1024;
#pragma unroll
            for (int ni = 0; ni < 4; ++ni) { const f32x4 a = acc[mi][ni]; const int ch = cb - 1536 + ni * 16; u32x2 o; o.x = pk2(a[0], a[1]); o.y = pk2(a[2], a[3]);
                *(u32x2*)(xb + (size_t)row * 1024 + ch) = o;
                if (fo) *(f32x4*)(fo + ch) = a; }
        }
    } else {
        float* dtr = WSP(float, W_DTRAW);
        if (wn == 0 && fq < 2) {
#pragma unroll
            for (int mi = 0; mi < 4; ++mi) *(f32x4*)(dtr + (size_t)(rb + mi * 16) * 8 + fq * 4) = acc[mi][0];
        }
    }
}
__device__ __forceinline__ void p1_memkv_tile(const Params& p, int mt, int nt, LAS char* lds) {
    TIDV;
    f32x4 acc[4][4]; zero_acc<4>(acc);
    const int m0 = mt * 128, n0 = nt * 128;
    mma_seg<128, 0>(acc, WSP(bf16_t, W_MEMB) + (size_t)m0 * 1024, 1024, WSP(bf16_t, W_WKV) + (size_t)n0 * 1024, 1024, 1024, lds, nullptr);
    const int rb = m0 + wm * 64 + fr, cb = n0 + wn * 64 + fq * 4;
    if (n0 < 1024) {
        bf16_t* kb = WSP(bf16_t, W_KB);
#pragma unroll
        for (int mi = 0; mi < 4; ++mi)
#pragma unroll
            for (int ni = 0; ni < 4; ++ni) { const f32x4 a = acc[mi][ni]; const size_t o_ = (size_t)(rb + mi * 16) * 1024 + cb + ni * 16;
                *(f32x4*)(p.out + O_MK + o_) = a; u32x2 o; o.x = pk2(a[0], a[1]); o.y = pk2(a[2], a[3]); *(u32x2*)(kb + o_) = o; }
    } else {
        bf16_t* vT = WSP(bf16_t, W_VT);
#pragma unroll
        for (int mi = 0; mi < 4; ++mi)
#pragma unroll
            for (int ni = 0; ni < 4; ++ni) { const f32x4 a = acc[mi][ni]; const int row = rb + mi * 16, c = cb - 1024 + ni * 16;
                *(f32x4*)(p.out + O_MV + (size_t)row * 1024 + c) = a;
                const int b = row >> 8, m = row & 255, head = c >> 8, d = c & 255;
                bf16_t* vp = vT + ((size_t)(b * 4 + head) * 256 + d) * 256 + m;
                const unsigned q0 = pk2(a[0], a[1]), q1 = pk2(a[2], a[3]);
                vp[0] = (bf16_t)(q0 & 0xffffu); vp[256] = (bf16_t)(q0 >> 16); vp[512] = (bf16_t)(q1 & 0xffffu); vp[768] = (bf16_t)(q1 >> 16); }
    }
}
__device__ __forceinline__ void phase1(const Params& p, LAS char* lds) {
    constexpr int T1 = 129 * 21, T2 = 16 * 16;
    int t;
    for (int i = 0; (t = sched(i, T1 + T2)) >= 0; ++i) {
        int mt, nt;
        if (t < T1) { tile_mn(t, 129, 21, mt, nt); p1_inproj_tile(p, mt, nt, lds); }
        else { tile_mn(t - T1, 16, 16, mt, nt); p1_memkv_tile(p, mt, nt, lds); }
    }
}

__device__ __forceinline__ void p2_conv(const Params& p, int item, LAS char* lds) {
    TIDV;
    const int cc = item >> 4, slab = item & 15, c = cc & 15, tok0 = cc * 128, ch0 = slab * 64;
    const int cgp = tid & 7, r0 = tid >> 3;
    LAS float* s_acum = (LAS float*)(lds + 40960); LAS float* s_dt = s_acum + 128; LAS float* s_tot = s_acum + 256;
    if (slab < 8) {
        const int h = slab;
        float v = 0.f, dtv = 0.f;
        if (tid < 128) {
            dtv = softplus_f(WSP(float, W_DTRAW)[(size_t)(tok0 + tid) * 8 + h] + p.in[15][h]);
            v = dtv * (-expf(p.in[16][h]));
#pragma unroll
            for (int d = 1; d < 64; d <<= 1) { const float t = __shfl_up(v, d); if (lane >= d) v += t; }
            if (lane == 63) s_tot[wid] = v;
        }
        __syncthreads();
        if (tid < 128) {
            if (wid == 1) v += s_tot[0];
            s_acum[tid] = v; s_dt[tid] = dtv;
            WSP(float, W_ACUM)[(size_t)(cc * 8 + h) * 128 + tid] = v;
            WSP(float, W_DTV)[(size_t)(cc * 8 + h) * 128 + tid] = dtv;
        }
        __syncthreads();
    }
    const bf16_t* xin = WSP(bf16_t, W_XBCB);
    const int chb = ch0 + cgp * 8;
    u32x4 rin[7];
#pragma unroll
    for (int i = 0; i < 7; ++i) {
        const int rr = r0 * 4 - 3 + i;
        if (rr < 0 && c == 0) rin[i] = (u32x4){0u, 0u, 0u, 0u};
        else rin[i] = *(const u32x4*)(xin + (size_t)(tok0 + rr) * 1024 + chb);
    }
    const float* cw = p.in[13]; const float* cbp = p.in[14];
    float o[4][8];
#pragma unroll
    for (int e = 0; e < 8; ++e) {
        const float w0 = cw[chb + e], w1 = cw[1024 + chb + e], w2 = cw[2048 + chb + e], w3 = cw[3072 + chb + e], bb = cbp[chb + e];
        float xin_[7];
#pragma unroll
        for (int i = 0; i < 7; ++i) { const unsigned u = (e >> 1) == 0 ? rin[i].x : (e >> 1) == 1 ? rin[i].y : (e >> 1) == 2 ? rin[i].z : rin[i].w; xin_[i] = (e & 1) ? bfhi(u) : bflo(u); }
#pragma unroll
        for (int r = 0; r < 4; ++r) o[r][e] = silu_f(bb + xin_[r] * w0 + xin_[r + 1] * w1 + xin_[r + 2] * w2 + xin_[r + 3] * w3);
    }
    {
        bf16_t* dstn; int ldn, cofs;
        if (slab < 8) { dstn = WSP(bf16_t, W_XN); ldn = 512; cofs = chb; }
        else if (slab < 12) { dstn = WSP(bf16_t, W_BN); ldn = 256; cofs = chb - 512; }
        else { dstn = WSP(bf16_t, W_CN); ldn = 256; cofs = chb - 768; }
#pragma unroll
        for (int r = 0; r < 4; ++r) { u32x4 q; q.x = pk2(o[r][0], o[r][1]); q.y = pk2(o[r][2], o[r][3]); q.z = pk2(o[r][4], o[r][5]); q.w = pk2(o[r][6], o[r][7]);
            *(u32x4*)(dstn + (size_t)(tok0 + r0 * 4 + r) * ldn + cofs) = q; }
    }
    if (slab < 12) {
        float wv[4] = {1.f, 1.f, 1.f, 1.f};
        if (slab < 8) { const float al_ = s_acum[127];
#pragma unroll
            for (int r = 0; r < 4; ++r) wv[r] = __expf(al_ - s_acum[r0 * 4 + r]) * s_dt[r0 * 4 + r]; }
#pragma unroll
        for (int e = 0; e < 8; ++e) {
            u32x2 q; q.x = pk2(o[0][e], o[1][e]); q.y = pk2(o[2][e], o[3][e]);
            *(LAS u32x2*)(lds + (cgp * 8 + e) * 256 + r0 * 8) = q;
            if (slab < 8) { u32x2 q2; q2.x = pk2(o[0][e] * wv[0], o[1][e] * wv[1]); q2.y = pk2(o[2][e] * wv[2], o[3][e] * wv[3]);
                *(LAS u32x2*)(lds + 16384 + (cgp * 8 + e) * 256 + r0 * 8) = q2; }
        }
        __syncthreads();
        bf16_t* d1; bf16_t* d2 = nullptr; size_t rowbase;
        if (slab < 8) { d1 = WSP(bf16_t, W_XT); d2 = WSP(bf16_t, W_XWT); rowbase = (size_t)(cc * 8 + slab) * 64; }
        else { const int g = (slab - 8) >> 1, half = (slab - 8) & 1; d1 = WSP(bf16_t, W_BT); rowbase = (size_t)(cc * 2 + g) * 128 + half * 64; }
#pragma unroll
        for (int i = 0; i < 4; ++i) {
            const int id = tid + 256 * i, pr = id >> 4, scn = id & 15;
            *(u32x4*)(d1 + (rowbase + pr) * 128 + scn * 8) = *(LAS u32x4*)(lds + pr * 256 + scn * 16);
            if (slab < 8) *(u32x4*)(d2 + (rowbase + pr) * 128 + scn * 8) = *(LAS u32x4*)(lds + 16384 + pr * 256 + scn * 16);
        }
    }
    __syncthreads();
}
__device__ __forceinline__ void p2_vln(const Params& p, int item, LAS char* lds) {
    TIDV;
    const int cc = item >> 2, head = item & 3, c = cc & 15, b = cc >> 4, tok0 = cc * 128;
    const int cgp = tid & 15, r0 = tid >> 4;
    const int chb = head * 128 + cgp * 8;
    const bf16_t* vg = WSP(bf16_t, W_VG); const float* vstat = WSP(float, W_ZERO);
    float lg[8], lb[8];
#pragma unroll
    for (int e = 0; e < 8; ++e) { lg[e] = p.in[9][chb + e]; lb[e] = p.in[10][chb + e]; }
    float o[8][8];
#pragma unroll
    for (int r = 0; r < 8; ++r) {
        const int tok = tok0 + r0 * 8 + r;
        const u32x4 q = *(const u32x4*)(vg + (size_t)tok * 512 + chb);
        const float mean = vstat[(size_t)tok * 2] * (1.f / 512.f);
        const float var = vstat[(size_t)tok * 2 + 1] * (1.f / 512.f) - mean * mean;
        const float rstd = rsqrtf(fmaxf(var, 0.f) + EPS);
        const float xv[8] = {bflo(q.x), bfhi(q.x), bflo(q.y), bfhi(q.y), bflo(q.z), bfhi(q.z), bflo(q.w), bfhi(q.w)};
#pragma unroll
        for (int e = 0; e < 8; ++e) o[r][e] = (xv[e] - mean) * rstd * lg[e] + lb[e];
        if (c == 15) {
            float* go = p.out + O_GVP + ((size_t)(b * 128 + r0 * 8 + r)) * 512 + chb;
            *(f32x4*)go = (f32x4){o[r][0], o[r][1], o[r][2], o[r][3]}; *(f32x4*)(go + 4) = (f32x4){o[r][4], o[r][5], o[r][6], o[r][7]};
        }
    }
#pragma unroll
    for (int e = 0; e < 8; ++e) {
        u32x4 q; q.x = pk2(o[0][e], o[1][e]); q.y = pk2(o[2][e], o[3][e]); q.z = pk2(o[4][e], o[5][e]); q.w = pk2(o[6][e], o[7][e]);
        *(LAS u32x4*)(lds + (cgp * 8 + e) * 256 + r0 * 16) = q;
    }
    __syncthreads();
    bf16_t* dst = WSP(bf16_t, W_VLNT) + (size_t)(cc * 4 + head) * 128 * 128;
#pragma unroll
    for (int i = 0; i < 8; ++i) { const int id = tid + 256 * i, pr = id >> 4, scn = id & 15;
        *(u32x4*)(dst + (size_t)pr * 128 + scn * 8) = *(LAS u32x4*)(lds + pr * 256 + scn * 16); }
    __syncthreads();
}
__device__ __forceinline__ void p2_sample_ssd(const Params& p, int item, LAS char* lds) {
    TIDV;
    const int bs = item >> 3, h = item & 7, g = h >> 2;
    LAS float* s_x = (LAS float*)lds; LAS float* s_B = s_x + 64; LAS float* s_C = s_B + 128; LAS float* s_y = s_C + 128;
    const float* scv = p.in[3] + (size_t)bs * 3 * 1024;
    const float* xrow = p.out + O_CONVS + ((size_t)bs * 3 + 2) * 1024;
    const float* cw = p.in[13]; const float* cbp = p.in[14];
    for (int idx = tid; idx < 320; idx += 256) {
        int ch; if (idx < 64) ch = h * 64 + idx; else if (idx < 192) ch = 512 + g * 128 + (idx - 64); else ch = 768 + g * 128 + (idx - 192);
        const float v = cbp[ch] + scv[ch] * cw[ch] + scv[1024 + ch] * cw[1024 + ch] + scv[2048 + ch] * cw[2048 + ch] + xrow[ch] * cw[3072 + ch];
        s_x[idx] = silu_f(v);
    }
    __syncthreads();
    const float dt = softplus_f(WSP(float, W_DTRAW)[(size_t)(MP + bs) * 8 + h] + p.in[15][h]);
    const float dA = expf(dt * (-expf(p.in[16][h])));
    const int l = tid & 31, rg = tid >> 5;
    const f32x4 Bv = *(LAS f32x4*)(s_B + l * 4), Cv = *(LAS f32x4*)(s_C + l * 4);
    const float* h0 = p.in[2] + ((size_t)(bs * 8 + h) * 64) * 128;
    float* ho = p.out + O_SSMS + ((size_t)(bs * 8 + h) * 64) * 128;
    f32x4 hv[8];
#pragma unroll
    for (int i = 0; i < 8; ++i) hv[i] = *(const f32x4*)(h0 + (size_t)(rg + 8 * i) * 128 + l * 4);
#pragma unroll
    for (int i = 0; i < 8; ++i) {
        const int pp = rg + 8 * i;
        const float dx = dt * s_x[pp];
        f32x4 hn = hv[i] * dA + Bv * dx;
        *(f32x4*)(ho + (size_t)pp * 128 + l * 4) = hn;
        float y = hn[0] * Cv[0] + hn[1] * Cv[1] + hn[2] * Cv[2] + hn[3] * Cv[3];
        y += __shfl_xor(y, 16); y += __shfl_xor(y, 8); y += __shfl_xor(y, 4); y += __shfl_xor(y, 2); y += __shfl_xor(y, 1);
        if (l == 0) s_y[pp] = y;
    }
    __syncthreads();
    if (tid < 64) {
        const float xv = s_x[tid];
        const float y = s_y[tid] + p.in[17][h] * xv;
        const float z = bf2f(WSP(bf16_t, W_ZB)[(size_t)(MP + bs) * 512 + h * 64 + tid]);
        const float yz = y * silu_f(z);
        const unsigned q = pk2(yz, 0.f) & 0xffffu;
        WSP(bf16_t, W_CONCAT)[(size_t)(MP + bs) * 1024 + 512 + h * 64 + tid] = (bf16_t)q;
        const float yr = bflo(q);
        const float ssq = wave_sum(yr * yr);
        if (tid == 0) atomicAdd(WSP(float, W_ZERO) + (size_t)MT * 2 + (size_t)(MP + bs) * 2 + g, ssq);
    }
    __syncthreads();
}
__device__ __forceinline__ void p2_sample_misc(const Params& p, int bs) {
    TIDV;
    const float* vstat = WSP(float, W_ZERO);
    const int tok = MP + bs;
    const float mean = vstat[(size_t)tok * 2] * (1.f / 512.f);
    const float var = vstat[(size_t)tok * 2 + 1] * (1.f / 512.f) - mean * mean;
    const float rstd = rsqrtf(fmaxf(var, 0.f) + EPS);
    for (int ch = tid; ch < 512; ch += 256) {
        const int hd = ch >> 7;
        const float v = bf2f(WSP(bf16_t, W_VG)[(size_t)tok * 512 + ch]);
        const float vl = (v - mean) * rstd * p.in[9][ch] + p.in[10][ch];
        p.out[O_GVS + (size_t)bs * 512 + ch] = vl;
        const float u = bf2f(WSP(bf16_t, W_UB)[(size_t)tok * 512 + ch]);
        const float gout = u * (p.in[11][hd * 128 * 128] * vl + p.in[12][hd * 128]);
        WSP(bf16_t, W_CONCAT)[(size_t)tok * 1024 + ch] = (bf16_t)(pk2(gout, 0.f) & 0xffffu);
    }
    const float* scv = p.in[3] + (size_t)bs * 3 * 1024;
    float* co = p.out + O_CONVS + (size_t)bs * 3 * 1024;
    for (int i = tid; i < 2048; i += 256) co[i] = scv[1024 + i];
}
__device__ __forceinline__ void phase2(const Params& p, LAS char* lds) {
    constexpr int N1 = 1024, N2 = 2048, N3 = 512, N4 = 128;
    for (int it = blockIdx.x; it < N1 + N2 + N3 + N4; it += gridDim.x) {
        if (it < N1) p2_sample_ssd(p, it, lds);
        else if (it < N1 + N2) p2_conv(p, it - N1, lds);
        else if (it < N1 + N2 + N3) p2_vln(p, it - N1 - N2, lds);
        else p2_sample_misc(p, it - N1 - N2 - N3);
    }
}

__device__ __forceinline__ void p3_cb(const Params& p, int item, LAS char* lds) {
    TIDV;
    const int cc = item >> 1, g = item & 1, tok0 = cc * 128;
    f32x4 acc[4][4]; zero_acc<4>(acc);
    mma_seg<128, 0>(acc, WSP(bf16_t, W_CN) + (size_t)tok0 * 256 + g * 128, 256, WSP(bf16_t, W_BN) + (size_t)tok0 * 256 + g * 128, 256, 128, lds, nullptr);
    const int tb = wm * 64 + fr, sb = wn * 64 + fq * 4;
#pragma unroll 1
    for (int jh = 0; jh < 4; ++jh) {
        const int h = g * 4 + jh;
        const float* ac = WSP(float, W_ACUM) + (size_t)(cc * 8 + h) * 128;
        const float* dv = WSP(float, W_DTV) + (size_t)(cc * 8 + h) * 128;
        bf16_t* mt_ = WSP(bf16_t, W_MT) + (size_t)(cc * 8 + h) * 128 * 128;
        float at[4];
#pragma unroll
        for (int mi = 0; mi < 4; ++mi) at[mi] = ac[tb + mi * 16];
#pragma unroll
        for (int ni = 0; ni < 4; ++ni) {
            const f32x4 as = *(const f32x4*)(ac + sb + ni * 16), ds = *(const f32x4*)(dv + sb + ni * 16);
#pragma unroll
            for (int mi = 0; mi < 4; ++mi) {
                const int t = tb + mi * 16, s0 = sb + ni * 16;
                float v[4];
#pragma unroll
                for (int j = 0; j < 4; ++j) v[j] = (s0 + j <= t) ? acc[mi][ni][j] * __expf(at[mi] - as[j]) * ds[j] : 0.f;
                u32x2 o; o.x = pk2(v[0], v[1]); o.y = pk2(v[2], v[3]);
                *(u32x2*)(mt_ + (size_t)t * 128 + s0) = o;
            }
        }
    }
}
__device__ __forceinline__ void p3_gmlp(const Params& p, int item, LAS char* lds) {
    TIDV;
    const int cc = item >> 2, head = item & 3, tok0 = cc * 128;
    f32x4 acc[4][4]; zero_acc<4>(acc);
    mma_seg<128, 0>(acc, WSP(bf16_t, W_WSB) + (size_t)head * 128 * 128, 128, WSP(bf16_t, W_VLNT) + (size_t)(cc * 4 + head) * 128 * 128, 128, 128, lds, nullptr);
    const int tb = wm * 64 + fr, db = wn * 64 + fq * 4;
    const bf16_t* ub = WSP(bf16_t, W_UB); bf16_t* cat = WSP(bf16_t, W_CONCAT);
#pragma unroll
    for (int mi = 0; mi < 4; ++mi) {
        const int t = tb + mi * 16;
        const float bias = p.in[12][head * 128 + t];
#pragma unroll
        for (int ni = 0; ni < 4; ++ni) {
            const int d = db + ni * 16;
            const u32x2 uq = *(const u32x2*)(ub + (size_t)(tok0 + t) * 512 + head * 128 + d);
            const f32x4 a = acc[mi][ni];
            u32x2 o; o.x = pk2((a[0] + bias) * bflo(uq.x), (a[1] + bias) * bfhi(uq.x)); o.y = pk2((a[2] + bias) * bflo(uq.y), (a[3] + bias) * bfhi(uq.y));
            *(u32x2*)(cat + (size_t)(tok0 + t) * 1024 + head * 128 + d) = o;
        }
    }
}
__device__ __forceinline__ void p3_states(const Params& p, int item, LAS char* lds) {
    TIDV;
    const int cc = item >> 3, h = item & 7, g = h >> 2;
    f32x4 acc[4][2]; zero_acc<2>(acc);
    mma_seg<64, 0>(acc, WSP(bf16_t, W_BT) + (size_t)(cc * 2 + g) * 128 * 128, 128, WSP(bf16_t, W_XWT) + (size_t)(cc * 8 + h) * 64 * 128, 128, 128, lds, nullptr);
    float* sc = WSP(float, W_SC) + (size_t)(cc * 8 + h) * 64 * 128;
    const int nb = wm * 64 + fr, pb = wn * 32 + fq * 4;
#pragma unroll
    for (int mi = 0; mi < 4; ++mi)
#pragma unroll
        for (int ni = 0; ni < 2; ++ni)
#pragma unroll
            for (int j = 0; j < 4; ++j) sc[(size_t)(pb + ni * 16 + j) * 128 + nb + mi * 16] = acc[mi][ni][j];
}
__device__ __forceinline__ void phase3(const Params& p, LAS char* lds) {
    constexpr int N1 = 256, N2 = 512, N3 = 1024;
    for (int it = blockIdx.x; it < N1 + N2 + N3; it += gridDim.x) {
        if (it < N1) p3_cb(p, it, lds);
        else if (it < N1 + N2) p3_gmlp(p, it - N1, lds);
        else p3_states(p, it - N1 - N2, lds);
    }
}

__device__ __forceinline__ void phase4(const Params& p) {
    for (int it = blockIdx.x; it < 512; it += gridDim.x) {
        const int idx4 = it * 256 + threadIdx.x;
        const int bh = idx4 >> 11, rem = (idx4 & 2047) * 4, b = bh >> 3, h = bh & 7;
        f32x4 st = {0.f, 0.f, 0.f, 0.f};
        const float* sc = WSP(float, W_SC); bf16_t* hp_ = WSP(bf16_t, W_HPREV); const float* ac = WSP(float, W_ACUM);
        f32x4 nxt = *(const f32x4*)(sc + ((size_t)((b * 16) * 8 + h)) * 8192 + rem);
#pragma unroll 1
        for (int c = 0; c < 16; ++c) {
            const size_t base = ((size_t)((b * 16 + c) * 8 + h)) * 8192 + rem;
            const f32x4 cur = nxt;
            if (c + 1 < 16) nxt = *(const f32x4*)(sc + base + 8 * 8192);
            u32x2 o; o.x = pk2(st[0], st[1]); o.y = pk2(st[2], st[3]);
            *(u32x2*)(hp_ + base) = o;
            const float dec = __expf(ac[(size_t)((b * 16 + c) * 8 + h) * 128 + 127]);
            st = st * dec + cur;
        }
        *(f32x4*)(p.out + O_SSMP + (size_t)idx4 * 4) = st;
    }
}

__device__ __forceinline__ void p5_y(const Params& p, int item, LAS char* lds) {
    TIDV;
    const int cc = item >> 3, h = item & 7, g = h >> 2, tok0 = cc * 128;
    f32x4 acc[4][2]; zero_acc<2>(acc);
    mma_seg<64, 0>(acc, WSP(bf16_t, W_CN) + (size_t)tok0 * 256 + g * 128, 256, WSP(bf16_t, W_HPREV) + (size_t)(cc * 8 + h) * 64 * 128, 128, 128, lds, nullptr);
    const float* ac = WSP(float, W_ACUM) + (size_t)(cc * 8 + h) * 128;
    const int tb = wm * 64 + fr, pb = wn * 32 + fq * 4;
#pragma unroll
    for (int mi = 0; mi < 4; ++mi) { const float e = __expf(ac[tb + mi * 16]);
#pragma unroll
        for (int ni = 0; ni < 2; ++ni) acc[mi][ni] = acc[mi][ni] * e; }
    mma_seg<64, 0>(acc, WSP(bf16_t, W_MT) + (size_t)(cc * 8 + h) * 128 * 128, 128, WSP(bf16_t, W_XT) + (size_t)(cc * 8 + h) * 64 * 128, 128, 128, lds, nullptr);
    const float dsk = p.in[17][h];
    const bf16_t* xn = WSP(bf16_t, W_XN); const bf16_t* zb = WSP(bf16_t, W_ZB); bf16_t* cat = WSP(bf16_t, W_CONCAT);
    float* gss = WSP(float, W_ZERO) + (size_t)MT * 2;
#pragma unroll
    for (int mi = 0; mi < 4; ++mi) {
        const int tok = tok0 + tb + mi * 16;
        float ssq = 0.f;
#pragma unroll
        for (int ni = 0; ni < 2; ++ni) {
            const int pc = h * 64 + pb + ni * 16;
            const u32x2 xq = *(const u32x2*)(xn + (size_t)tok * 512 + pc), zq = *(const u32x2*)(zb + (size_t)tok * 512 + pc);
            const f32x4 a = acc[mi][ni];
            const float y0 = (a[0] + dsk * bflo(xq.x)) * silu_f(bflo(zq.x)), y1 = (a[1] + dsk * bfhi(xq.x)) * silu_f(bfhi(zq.x));
            const float y2 = (a[2] + dsk * bflo(xq.y)) * silu_f(bflo(zq.y)), y3 = (a[3] + dsk * bfhi(xq.y)) * silu_f(bfhi(zq.y));
            u32x2 o; o.x = pk2(y0, y1); o.y = pk2(y2, y3);
            const float r0 = bflo(o.x), r1 = bfhi(o.x), r2 = bflo(o.y), r3 = bfhi(o.y);
            ssq += (r0 * r0 + r1 * r1) + (r2 * r2 + r3 * r3);
            *(u32x2*)(cat + (size_t)tok * 1024 + 512 + pc) = o;
        }
        ssq = fq_sum(ssq);
        if (fq == 0) atomicAdd(gss + (size_t)tok * 2 + g, ssq);
    }
}
__device__ __forceinline__ void phase5(const Params& p, LAS char* lds) {
    for (int it = blockIdx.x; it < 1024; it += gridDim.x) p5_y(p, it, lds);
}

template <int MODE>
__device__ __forceinline__ void res_gemm_tile(const Params& p, int mt, int nt, LAS char* lds) {
    TIDV;
    f32x4 acc[4][4]; zero_acc<4>(acc);
    const int m0 = mt * 128, n0 = nt * 128;
    if (MODE == 0) {
        const bf16_t* Ab = WSP(bf16_t, W_CONCAT) + (size_t)m0 * 1024; const bf16_t* Wb = WSP(bf16_t, W_WOUT) + (size_t)n0 * 1024;
        const float* gss = WSP(float, W_ZERO) + (size_t)MT * 2;
        float r0[4], r1[4];
#pragma unroll
        for (int mi = 0; mi < 4; ++mi) { const int row = m0 + wm * 64 + mi * 16 + fr;
            r0[mi] = rsqrtf(gss[(size_t)row * 2] * (1.f / 256.f) + EPS); r1[mi] = rsqrtf(gss[(size_t)row * 2 + 1] * (1.f / 256.f) + EPS); }
        mma_seg<128, 0>(acc, Ab + 512, 1024, Wb + 512, 1024, 256, lds, nullptr);
#pragma unroll
        for (int mi = 0; mi < 4; ++mi) { const float f = r0[mi] / r1[mi];
#pragma unroll
            for (int ni = 0; ni < 4; ++ni) acc[mi][ni] = acc[mi][ni] * f; }
        mma_seg<128, 0>(acc, Ab + 768, 1024, Wb + 768, 1024, 256, lds, nullptr);
#pragma unroll
        for (int mi = 0; mi < 4; ++mi)
#pragma unroll
            for (int ni = 0; ni < 4; ++ni) acc[mi][ni] = acc[mi][ni] * r1[mi];
        mma_seg<128, 0>(acc, Ab, 1024, Wb, 1024, 512, lds, nullptr);
    }
    else if (MODE == 1) mma_seg<128, 0>(acc, WSP(bf16_t, W_OB) + (size_t)m0 * 1024, 1024, WSP(bf16_t, W_WXO) + (size_t)n0 * 1024, 1024, 1024, lds, nullptr);
    else mma_seg<128, 0>(acc, WSP(bf16_t, W_ACT) + (size_t)m0 * 2816, 2816, WSP(bf16_t, W_WD) + (size_t)n0 * 2816, 2816, 2816, lds, nullptr);
    const int rb = m0 + wm * 64 + fr, cb = n0 + wn * 64 + fq * 4;
    float* hp = WSP(float, W_HP); bf16_t* hpb = WSP(bf16_t, W_HPB);
    float* ssq_ = WSP(float, W_ZERO) + (size_t)MT * 4 + (size_t)MT * MODE;
#pragma unroll
    for (int mi = 0; mi < 4; ++mi) {
        const int row = rb + mi * 16;
        const float* rsrc;
        if (MODE == 0) rsrc = row < MP ? p.in[0] + (size_t)row * 1024 : p.in[1] + (size_t)(row - MP) * 1024;
        else rsrc = hp + (size_t)row * 1024;
        float ssq = 0.f;
#pragma unroll
        for (int ni = 0; ni < 4; ++ni) {
            const int col = cb + ni * 16;
            const f32x4 r = *(const f32x4*)(rsrc + col);
            const f32x4 v = acc[mi][ni] + r;
            *(f32x4*)(hp + (size_t)row * 1024 + col) = v;
            ssq += (v[0] * v[0] + v[1] * v[1]) + (v[2] * v[2] + v[3] * v[3]);
            if (MODE != 2) { u32x2 o; o.x = pk2(v[0], v[1]); o.y = pk2(v[2], v[3]); *(u32x2*)(hpb + (size_t)row * 1024 + col) = o; }
        }
        ssq = fq_sum(ssq);
        if (fq == 0) atomicAdd(ssq_ + row, ssq);
    }
}
template <int MODE>
__device__ __forceinline__ void phase_res(const Params& p, LAS char* lds) {
    int t;
    for (int i = 0; (t = sched(i, 129 * 8)) >= 0; ++i) { int mt, nt; tile_mn(t, 129, 8, mt, nt); res_gemm_tile<MODE>(p, mt, nt, lds); }
}

__device__ __forceinline__ void phase7(const Params& p, LAS char* lds) {
    TIDV;
    int t;
    for (int i = 0; (t = sched(i, 129 * 8)) >= 0; ++i) {
        int mt, nt; tile_mn(t, 129, 8, mt, nt);
        f32x4 acc[4][4]; zero_acc<4>(acc);
        const int m0 = mt * 128, n0 = nt * 128;
        mma_seg<128, 0>(acc, WSP(bf16_t, W_HPB) + (size_t)m0 * 1024, 1024, WSP(bf16_t, W_WQ) + (size_t)n0 * 1024, 1024, 1024, lds, nullptr);
        const int rb = m0 + wm * 64 + fr, cb = n0 + wn * 64 + fq * 4;
        const float* ss1 = WSP(float, W_ZERO) + (size_t)MT * 4;
        bf16_t* qb = WSP(bf16_t, W_QB);
#pragma unroll
        for (int mi = 0; mi < 4; ++mi) {
            const int row = rb + mi * 16;
            const float rs = rsqrtf(ss1[row] * (1.f / 1024.f) + EPS);
#pragma unroll
            for (int ni = 0; ni < 4; ++ni) { const f32x4 a = acc[mi][ni] * rs; u32x2 o; o.x = pk2(a[0], a[1]); o.y = pk2(a[2], a[3]);
                *(u32x2*)(qb + (size_t)row * 1024 + cb + ni * 16) = o; }
        }
    }
}

__device__ __forceinline__ void p8_prompt(const Params& p, int item, LAS char* lds) {
    TIDV;
    const int qt = item & 15, head = (item >> 4) & 3, b = item >> 6;
    const int tokq = b * 2048 + qt * 128;
    const bf16_t* qa = WSP(bf16_t, W_QB) + (size_t)tokq * 1024 + head * 256;
    const bf16_t* kbp = WSP(bf16_t, W_KB) + (size_t)(b * 256) * 1024 + head * 256;
    f32x4 s0[4][4], s1[4][4]; zero_acc<4>(s0); zero_acc<4>(s1);
    mma_seg<128, 0>(s0, qa, 1024, kbp, 1024, 256, lds, nullptr);
    mma_seg<128, 0>(s1, qa, 1024, kbp + (size_t)128 * 1024, 1024, 256, lds, nullptr);
    LAS float* red = (LAS float*)(lds + LDS_MISC + 64);
    float rinv[4];
    float mx[4];
#pragma unroll
    for (int mi = 0; mi < 4; ++mi) {
        float m = -3.0e38f;
#pragma unroll
        for (int ni = 0; ni < 4; ++ni)
#pragma unroll
            for (int j = 0; j < 4; ++j) m = fmaxf(m, fmaxf(s0[mi][ni][j], s1[mi][ni][j]));
        m = fq_max(m);
        if (fq == 0) red[wn * 128 + wm * 64 + mi * 16 + fr] = m;
        mx[mi] = m;
    }
    __syncthreads();
#pragma unroll
    for (int mi = 0; mi < 4; ++mi) mx[mi] = fmaxf(mx[mi], red[(wn ^ 1) * 128 + wm * 64 + mi * 16 + fr]);
#pragma unroll
    for (int mi = 0; mi < 4; ++mi) {
        float sum = 0.f;
        const int t = wm * 64 + mi * 16 + fr;
#pragma unroll
        for (int ni = 0; ni < 4; ++ni) {
            const int mcol = wn * 64 + ni * 16 + fq * 4;
            u32x2 o0, o1;
            o0.x = pk2(__expf(s0[mi][ni][0] - mx[mi]), __expf(s0[mi][ni][1] - mx[mi])); o0.y = pk2(__expf(s0[mi][ni][2] - mx[mi]), __expf(s0[mi][ni][3] - mx[mi]));
            o1.x = pk2(__expf(s1[mi][ni][0] - mx[mi]), __expf(s1[mi][ni][1] - mx[mi])); o1.y = pk2(__expf(s1[mi][ni][2] - mx[mi]), __expf(s1[mi][ni][3] - mx[mi]));
            sum += (bflo(o0.x) + bfhi(o0.x)) + (bflo(o0.y) + bfhi(o0.y)) + (bflo(o1.x) + bfhi(o1.x)) + (bflo(o1.y) + bfhi(o1.y));
            const int c0 = mcol >> 3, c1 = (mcol + 128) >> 3, sub = (mcol & 7) * 2;
            *(LAS u32x2*)(lds + t * 512 + ((c0 ^ (t & 15)) << 4) + sub) = o0;
            *(LAS u32x2*)(lds + t * 512 + ((c1 ^ (t & 15)) << 4) + sub) = o1;
        }
        sum = fq_sum(sum);
        if (fq == 0) red[256 + wn * 128 + t] = sum;
        rinv[mi] = sum;
        __builtin_amdgcn_sched_barrier(0);
    }
    __syncthreads();
#pragma unroll
    for (int mi = 0; mi < 4; ++mi) rinv[mi] = 1.f / (rinv[mi] + red[256 + (wn ^ 1) * 128 + wm * 64 + mi * 16 + fr]);
    const bf16_t* vtp = WSP(bf16_t, W_VT) + (size_t)(b * 4 + head) * 256 * 256;
    bf16_t* ob = WSP(bf16_t, W_OB);
#pragma unroll 1
    for (int nn = 0; nn < 2; ++nn) {
        f32x4 acc[4][4]; zero_acc<4>(acc);
        const bf16_t* vb = vtp + (size_t)(nn * 128 + wn * 64 + fr) * 256 + fq * 8;
        bf16x8 bcur[4], bnxt[4];
#pragma unroll
        for (int ni = 0; ni < 4; ++ni) bcur[ni] = *(const bf16x8*)(vb + (size_t)(ni * 16) * 256);
#pragma unroll 1
        for (int kk = 0; kk < 8; ++kk) {
            if (kk + 1 < 8) {
#pragma unroll
                for (int ni = 0; ni < 4; ++ni) bnxt[ni] = *(const bf16x8*)(vb + (size_t)(ni * 16) * 256 + (kk + 1) * 32);
            }
            bf16x8 af[4];
#pragma unroll
            for (int mi = 0; mi < 4; ++mi) { const int t = wm * 64 + mi * 16 + fr; af[mi] = *(LAS bf16x8*)(lds + t * 512 + (((kk * 4 + fq) ^ (t & 15)) << 4)); }
#pragma unroll
            for (int mi = 0; mi < 4; ++mi)
#pragma unroll
                for (int ni = 0; ni < 4; ++ni) acc[mi][ni] = __builtin_amdgcn_mfma_f32_16x16x32_bf16(bcur[ni], af[mi], acc[mi][ni], 0, 0, 0);
            if (kk + 1 < 8) {
#pragma unroll
                for (int ni = 0; ni < 4; ++ni) bcur[ni] = bnxt[ni];
            }
        }
#pragma unroll
        for (int mi = 0; mi < 4; ++mi)
#pragma unroll
            for (int ni = 0; ni < 4; ++ni) { const f32x4 a = acc[mi][ni] * rinv[mi]; u32x2 o; o.x = pk2(a[0], a[1]); o.y = pk2(a[2], a[3]);
                *(u32x2*)(ob + (size_t)(tokq + wm * 64 + mi * 16 + fr) * 1024 + head * 256 + nn * 128 + wn * 64 + ni * 16 + fq * 4) = o; }
    }
    __syncthreads();
}
__device__ __forceinline__ void p8_sample(const Params& p, int item, LAS char* lds) {
    TIDV;
    const int bs = item >> 2, head = item & 3;
    LAS float* s_q = (LAS float*)lds; LAS float* s_sc = s_q + 256; LAS float* s_red = s_sc + 256; LAS float* s_part = s_red + 16;
    s_q[tid] = bf2f(WSP(bf16_t, W_QB)[(size_t)(MP + bs) * 1024 + head * 256 + tid]);
    __syncthreads();
    const f32x4 qv = *(LAS f32x4*)(s_q + lane * 4);
    const float* kc = p.in[4] + ((size_t)(bs * 256) * 4 + head) * 256 + lane * 4;
    const float* vc = p.in[5] + ((size_t)(bs * 256) * 4 + head) * 256 + lane * 4;
#pragma unroll 1
    for (int i = 0; i < 64; i += 8) {
        f32x4 kv[8];
#pragma unroll
        for (int u = 0; u < 8; ++u) kv[u] = *(const f32x4*)(kc + (size_t)(wid * 64 + i + u) * 1024);
#pragma unroll
        for (int u = 0; u < 8; ++u) { float d = kv[u][0] * qv[0] + kv[u][1] * qv[1] + kv[u][2] * qv[2] + kv[u][3] * qv[3]; d = wave_sum(d); if (lane == 0) s_sc[wid * 64 + i + u] = d; }
    }
    __syncthreads();
    const float sv = s_sc[tid];
    float m = wave_max(sv);
    if (lane == 0) s_red[wid] = m;
    __syncthreads();
    m = fmaxf(fmaxf(s_red[0], s_red[1]), fmaxf(s_red[2], s_red[3]));
    const float e = __expf(sv - m);
    float sm = wave_sum(e);
    if (lane == 0) s_red[4 + wid] = sm;
    s_sc[tid] = e;
    __syncthreads();
    const float inv = 1.f / ((s_red[4] + s_red[5]) + (s_red[6] + s_red[7]));
    f32x4 o = {0.f, 0.f, 0.f, 0.f};
#pragma unroll 1
    for (int i = 0; i < 64; i += 8) {
        f32x4 vv[8];
#pragma unroll
        for (int u = 0; u < 8; ++u) vv[u] = *(const f32x4*)(vc + (size_t)(wid * 64 + i + u) * 1024);
#pragma unroll
        for (int u = 0; u < 8; ++u) o = o + vv[u] * s_sc[wid * 64 + i + u];
    }
    *(LAS f32x4*)(s_part + wid * 256 + lane * 4) = o;
    __syncthreads();
    const float r = ((s_part[tid] + s_part[256 + tid]) + (s_part[512 + tid] + s_part[768 + tid])) * inv;
    WSP(bf16_t, W_OB)[(size_t)(MP + bs) * 1024 + head * 256 + tid] = (bf16_t)(pk2(r, 0.f) & 0xffffu);
    __syncthreads();
}
__device__ __forceinline__ void phase8(const Params& p, LAS char* lds) {
    const int flip = (blockIdx.x ^ (blockIdx.x >> 8)) & 1;
    for (int j = 0; j < 2; ++j) {
        for (int it = blockIdx.x + ((j ^ flip) ? 512 : 0); it < ((j ^ flip) ? 1024 : 512); it += gridDim.x) {
            if (it < 512) p8_sample(p, it, lds); else p8_prompt(p, it - 512, lds);
        }
    }
}

__device__ __forceinline__ void phase10(const Params& p, LAS char* lds) {
    TIDV;
    int t = sched(0, 129 * 44);
    bool pf = false;
    for (int i = 0; t >= 0; ++i) {
        int mt, nt; tile_mn(t, 129, 44, mt, nt);
        const int tn = sched(i + 1, 129 * 44);
        const bf16_t* nA = nullptr; const bf16_t* nB = nullptr;
        if (tn >= 0) { int mt2, nt2; tile_mn(tn, 129, 44, mt2, nt2); nA = WSP(bf16_t, W_HPB) + (size_t)mt2 * 128 * 1024; nB = WSP(bf16_t, W_WGU) + (size_t)nt2 * 128 * 1024; }
        f32x4 acc[4][4]; zero_acc<4>(acc);
        const int m0 = mt * 128, n0 = nt * 128;
        mma_seg_p(acc, WSP(bf16_t, W_HPB) + (size_t)m0 * 1024, 1024, WSP(bf16_t, W_WGU) + (size_t)n0 * 1024, 1024, 1024, lds, pf, nA, nB);
        pf = (tn >= 0);
        const int rb = m0 + wm * 64 + fr, cb = (n0 + wn * 64) / 2 + fq * 4;
        const float* ss2 = WSP(float, W_ZERO) + (size_t)MT * 5;
        bf16_t* act = WSP(bf16_t, W_ACT);
#pragma unroll
        for (int mi = 0; mi < 4; ++mi) {
            const int row = rb + mi * 16;
            const float rs = rsqrtf(ss2[row] * (1.f / 1024.f) + EPS);
#pragma unroll
            for (int q = 0; q < 2; ++q) {
                const f32x4 g = acc[mi][2 * q] * rs, u = acc[mi][2 * q + 1] * rs;
                u32x2 o; o.x = pk2(silu_f(g[0]) * u[0], silu_f(g[1]) * u[1]); o.y = pk2(silu_f(g[2]) * u[2], silu_f(g[3]) * u[3]);
                *(u32x2*)(act + (size_t)row * 2816 + cb + q * 16) = o;
            }
        }
        t = tn;
    }
}

__device__ __forceinline__ void phase12(const Params& p) {
    const float* hp = WSP(float, W_HP); const float* ss3 = WSP(float, W_ZERO) + (size_t)MT * 6; const float* g = p.in[30];
    const int n4 = MT * 256;
    for (int i = blockIdx.x * 256 + threadIdx.x; i < n4; i += gridDim.x * 256) {
        const int row = i >> 8, c = (i & 255) * 4;
        const float rs = rsqrtf(ss3[row] * (1.f / 1024.f) + EPS);
        const f32x4 v = *(const f32x4*)(hp + (size_t)i * 4), gv = *(const f32x4*)(g + c);
        *(f32x4*)(p.out + (size_t)i * 4) = v * rs * gv;
    }
}

#ifndef DUMP_SEL
#define DUMP_SEL 0
#endif
__device__ __forceinline__ void phase_dump(const Params& p) {
    const int n = MT * 1024;
    for (int i = blockIdx.x * 256 + threadIdx.x; i < n; i += gridDim.x * 256) {
        float v = 0.f;
        if (DUMP_SEL == 1) v = bf2f(WSP(bf16_t, W_CONCAT)[i]);
        else if (DUMP_SEL == 2) v = WSP(float, W_HP)[i];
        else if (DUMP_SEL == 3) v = bf2f(WSP(bf16_t, W_QB)[i]);
        else if (DUMP_SEL == 4) v = bf2f(WSP(bf16_t, W_OB)[i]);
        else if (DUMP_SEL == 5) v = bf2f(WSP(bf16_t, W_HPB)[i]);
        else if (DUMP_SEL == 6) v = bf2f(WSP(bf16_t, W_ACT)[(size_t)(i >> 10) * 2816 + (i & 1023)]);
        p.out[i] = v;
    }
}
__global__ void __launch_bounds__(256, 2) hymba_fwd(Params p) {
    extern __shared__ __attribute__((aligned(16))) char smem_dyn[];
    LAS char* lds = (LAS char*)smem_dyn;
    XcdBarrier xb;
    if (p.fused) {
        if (p.never) cg::this_grid().sync();
        volatile LAS unsigned* st = (volatile LAS unsigned*)(lds + LDS_MISC);
        if (threadIdx.x < 4) st[threadIdx.x] = 0u;
        __syncthreads();
        xb = xcd_barrier_post(WSP(unsigned, W_BAR), st);
    }
#ifndef DUP_MASK
#define DUP_MASK (1<<7)
#endif
#define RUN_PH(k, call) if (p.ph_lo <= (k) && (k) < p.ph_hi) { if ((DUP_MASK >> (k)) & 1) { call; xcd_barrier(xb); } call; if (p.fused && (k) + 1 < p.ph_hi) xcd_barrier(xb); }
#define PH_ON(n) (!defined(ONLY_PH) || ONLY_PH == n)
#ifndef PRE_MASK
#define PRE_MASK 0
#endif
    if (p.fused && ((PRE_MASK >> 2) & 1)) { phase2(p, lds); xcd_barrier(xb); }
    if (p.fused && ((PRE_MASK >> 5) & 1)) { phase5(p, lds); xcd_barrier(xb); }
    if (p.fused && ((PRE_MASK >> 1) & 1)) { phase1(p, lds); xcd_barrier(xb); }
    if (p.fused && ((PRE_MASK >> 6) & 1)) { phase_res<0>(p, lds); xcd_barrier(xb); }
    if (p.fused && ((PRE_MASK >> 11) & 1)) { phase_res<2>(p, lds); xcd_barrier(xb); }
#if PH_ON(0)
    RUN_PH(0, phase0(p, lds))
#endif
#if PH_ON(1)
    RUN_PH(1, phase1(p, lds))
#endif
#if PH_ON(2)
    RUN_PH(2, phase2(p, lds))
#endif
#if PH_ON(3)
    RUN_PH(3, phase3(p, lds))
#endif
#if PH_ON(4)
    RUN_PH(4, phase4(p))
#endif
#if PH_ON(5)
    RUN_PH(5, phase5(p, lds))
#endif
#if PH_ON(6)
    RUN_PH(6, phase_res<0>(p, lds))
#endif
#if PH_ON(7)
    RUN_PH(7, phase7(p, lds))
#endif
#if PH_ON(8)
    RUN_PH(8, phase8(p, lds))
#endif
#if PH_ON(9)
    RUN_PH(9, phase_res<1>(p, lds))
#endif
#if PH_ON(10)
    RUN_PH(10, phase10(p, lds))
#endif
#if PH_ON(11)
    RUN_PH(11, phase_res<2>(p, lds))
#endif
#if PH_ON(12)
    RUN_PH(12, phase12(p))
#endif
#ifdef EXTRA_BARS
    if (p.fused) { for (int i = 0; i < EXTRA_BARS; ++i) xcd_barrier(xb); }
#endif
    RUN_PH(13, phase_dump(p))
}

extern "C" void kernel_launch(void* const* d_in, const int* in_sizes, int n_in, void* d_out, int out_size, void* d_ws, size_t ws_size, hipStream_t stream) {
    static int grid = 0;
    if (grid == 0) {
        int dev = 0, cus = 0, per_cu = 0;
        hipGetDevice(&dev);
        hipDeviceGetAttribute(&cus, hipDeviceAttributeMultiprocessorCount, dev);
        hipFuncSetAttribute((const void*)hymba_fwd, hipFuncAttributeMaxDynamicSharedMemorySize, LDS_BYTES);
        hipOccupancyMaxActiveBlocksPerMultiprocessor(&per_cu, (const void*)hymba_fwd, 256, LDS_BYTES);
        if (per_cu > 2) per_cu = 2;
        if (per_cu < 1) per_cu = 1;
        grid = cus * per_cu; grid = (grid / 8) * 8;
        if (ws_size < W_END) fprintf(stderr, "kernel_launch: workspace too small: %zu < %zu\n", ws_size, (size_t)W_END);
    }
    Params p{};
    for (int i = 0; i < 31; ++i) p.in[i] = (const float*)d_in[i];
    p.out = (float*)d_out; p.ws = (char*)d_ws; p.never = 0;
#if FUSED
    hipMemsetAsync((char*)d_ws + W_BAR, 0, XCD_BAR_WORDS * 4, stream);
    p.ph_lo = 0; p.ph_hi = NPH; p.fused = 1;
    void* args[] = {&p};
    hipError_t e = hipLaunchCooperativeKernel((const void*)hymba_fwd, dim3(grid), dim3(256), args, LDS_BYTES, stream);
    if (e != hipSuccess) fprintf(stderr, "cooperative launch failed: %s (grid %d)\n", hipGetErrorString(e), grid);
#else
    p.fused = 0;
    for (int ph = 0; ph < RUN_PHASES; ++ph) {
        p.ph_lo = ph; p.ph_hi = ph + 1;
        hipLaunchKernelGGL(hymba_fwd, dim3(grid), dim3(256), LDS_BYTES, stream, p);
    }
    if (DUMP_SEL) { p.ph_lo = 13; p.ph_hi = 14; hipLaunchKernelGGL(hymba_fwd, dim3(grid), dim3(256), LDS_BYTES, stream, p); }
#endif
}
```

```cpp
#include <hip/hip_runtime.h>
#include <hip/hip_cooperative_groups.h>
#include <stdint.h>
#include <cstdio>
namespace cg = cooperative_groups;

#ifndef FUSED
#define FUSED 1
#ifndef DUPM
#define DUPM 0
#endif
#endif
#define DUP_MASK 0
#define PRE_MASK 0
#ifndef RUN_PHASES
#define RUN_PHASES 13
#define DUMP_SEL 0
#endif

#define LAS __attribute__((address_space(3)))
typedef unsigned short bf16_t;
typedef short bf16x8 __attribute__((ext_vector_type(8)));
typedef float f32x4 __attribute__((ext_vector_type(4)));
typedef unsigned u32x4 __attribute__((ext_vector_type(4)));
typedef unsigned u32x2 __attribute__((ext_vector_type(2)));

constexpr int MP = 16384, MS = 128, MT = MP + MS;
constexpr int NCH = 128;
constexpr float EPS = 1e-6f;
constexpr int NPH = 13;

constexpr size_t O_YP = 0, O_YS = 16777216, O_SSMP = 16908288, O_CONVP = 17432576, O_GVP = 17457152,
                 O_MK = 17981440, O_MV = 20078592, O_SSMS = 22175744, O_CONVS = 30564352, O_GVS = 30957568;

constexpr size_t al(size_t x) { return (x + 255) & ~(size_t)255; }
constexpr size_t W_BAR = 0;
constexpr size_t W_ZERO = al(W_BAR + 3456 * 4);
constexpr size_t ZERO_FLOATS = (size_t)MT * 7;
constexpr size_t W_WIN = al(W_ZERO + ZERO_FLOATS * 4);
constexpr size_t W_WKV = al(W_WIN + (size_t)2816 * 1024 * 2);
constexpr size_t W_WOUT = al(W_WKV + (size_t)2048 * 1024 * 2);
constexpr size_t W_WQ = al(W_WOUT + (size_t)1024 * 1024 * 2);
constexpr size_t W_WXO = al(W_WQ + (size_t)1024 * 1024 * 2);
constexpr size_t W_WGU = al(W_WXO + (size_t)1024 * 1024 * 2);
constexpr size_t W_WD = al(W_WGU + (size_t)5632 * 1024 * 2);
constexpr size_t W_WSB = al(W_WD + (size_t)1024 * 2816 * 2);
constexpr size_t W_MEMB = al(W_WSB + (size_t)4 * 128 * 128 * 2);
constexpr size_t W_DTRAW = al(W_MEMB + (size_t)2048 * 1024 * 2);
constexpr size_t W_KB = al(W_DTRAW + (size_t)MT * 8 * 4);
constexpr size_t W_VT = al(W_KB + (size_t)2048 * 1024 * 2);
constexpr size_t W_VLNT = al(W_VT + (size_t)2048 * 1024 * 2);
constexpr size_t W_ACUM = al(W_VLNT + (size_t)MP * 512 * 2);
constexpr size_t W_DTV = al(W_ACUM + (size_t)NCH * 8 * 128 * 4);
constexpr size_t W_CONCAT = al(W_DTV + (size_t)NCH * 8 * 128 * 4);
constexpr size_t W_HP = al(W_CONCAT + (size_t)MT * 1024 * 2);
constexpr size_t W_HPB = al(W_HP + (size_t)MT * 1024 * 4);
constexpr size_t W_XB = al(W_HPB + (size_t)MT * 1024 * 2);
constexpr size_t W_UB = al(W_XB + (size_t)MT * 1024 * 2);
constexpr size_t W_VG = al(W_UB + (size_t)MT * 512 * 2);
constexpr size_t W_ZB = al(W_VG + (size_t)MT * 512 * 2);
constexpr size_t W_XBCB = al(W_ZB + (size_t)MT * 512 * 2);
constexpr size_t W_R1END = al(W_XBCB + (size_t)MT * 1024 * 2);
constexpr size_t W_ACT = W_XB;
static_assert((size_t)MT * 2816 * 2 <= W_R1END - W_XB, "act alias");
constexpr size_t W_XN = W_R1END;
constexpr size_t W_XWT = al(W_XN + (size_t)MP * 512 * 2);
constexpr size_t W_XT = al(W_XWT + (size_t)MP * 512 * 2);
constexpr size_t W_BN = al(W_XT + (size_t)MP * 512 * 2);
constexpr size_t W_BT = al(W_BN + (size_t)MP * 256 * 2);
constexpr size_t W_CN = al(W_BT + (size_t)MP * 256 * 2);
constexpr size_t W_R2END = al(W_CN + (size_t)MP * 256 * 2);
constexpr size_t W_QB = W_XN;
static_assert((size_t)MT * 1024 * 2 <= W_BN - W_XN, "qb alias");
constexpr size_t W_SC = W_R2END;
constexpr size_t W_HPREV = al(W_SC + (size_t)NCH * 8 * 64 * 128 * 4);
constexpr size_t W_MT = al(W_HPREV + (size_t)NCH * 8 * 64 * 128 * 2);
constexpr size_t W_END = al(W_MT + (size_t)NCH * 8 * 128 * 128 * 2);
constexpr size_t W_PBUF = W_SC;
constexpr size_t W_OB = W_HPREV;
static_assert((size_t)MT * 1024 * 2 <= W_END - W_HPREV, "ob alias");
static_assert(W_END < (size_t)530 * 1000 * 1000, "workspace too large");

constexpr int LDS_MISC = 131072;
constexpr int LDS_BYTES = 131072 + 8192;
#define RTID ((int)threadIdx.x)
#define RBID ((int)blockIdx.x)
#define RGRID ((int)gridDim.x)
#define VTID ((int)(threadIdx.x & 255u))
#define VBID ((int)(blockIdx.x * 2u + (unsigned)__builtin_amdgcn_readfirstlane((int)(threadIdx.x >> 8))))
#define VGRID ((int)(gridDim.x * 2u))

struct Params {
    const float* in[31];
    float* out;
    char* ws;
    int ph_lo, ph_hi, fused, never;
};

__device__ __forceinline__ float bf2f(unsigned h) { return __uint_as_float(h << 16); }
__device__ __forceinline__ unsigned pk2(float lo, float hi) { unsigned r; asm("v_cvt_pk_bf16_f32 %0, %1, %2" : "=v"(r) : "v"(lo), "v"(hi)); return r; }
__device__ __forceinline__ float bflo(unsigned u) { return __uint_as_float(u << 16); }
__device__ __forceinline__ float bfhi(unsigned u) { return __uint_as_float(u & 0xffff0000u); }
__device__ __forceinline__ float rbf(float x) { return bflo(pk2(x, 0.f) & 0xffffu); }
__device__ __forceinline__ float gelu_t(float x) { const float u = 1.5957691216f * (x + 0.044715f * x * x * x); return x * __builtin_amdgcn_rcpf(1.f + __expf(-u)); }
__device__ __forceinline__ float silu_f(float x) { return x * __builtin_amdgcn_rcpf(1.f + __expf(-x)); }
__device__ __forceinline__ float softplus_f(float x) { return x > 20.f ? x : log1pf(expf(x)); }
__device__ __forceinline__ float wave_sum(float v) {
#pragma unroll
    for (int o = 1; o < 64; o <<= 1) v += __shfl_xor(v, o);
    return v;
}
__device__ __forceinline__ float wave_max(float v) {
#pragma unroll
    for (int o = 1; o < 64; o <<= 1) v = fmaxf(v, __shfl_xor(v, o));
    return v;
}
__device__ __forceinline__ u32x4 scale8(u32x4 v, float s) {
    u32x4 o;
    o.x = pk2(bflo(v.x) * s, bfhi(v.x) * s); o.y = pk2(bflo(v.y) * s, bfhi(v.y) * s);
    o.z = pk2(bflo(v.z) * s, bfhi(v.z) * s); o.w = pk2(bflo(v.w) * s, bfhi(v.w) * s);
    return o;
}

#define XB_TMO      128
#define XB_XCNT(j)  (256  + 64 * (j))
#define XB_XSUB(j)  (1280 + 64 * (j))
#define XB_XGEN(j)  (2304 + 64 * (j))
#define XB_TOP      3328
#define XB_TOPGEN   3392
#define XCD_BAR_WORDS 3456
#define XB_SPIN_CAP (1u << 22)
__device__ __forceinline__ unsigned xb_ld(unsigned* p)              { return __hip_atomic_load(p, __ATOMIC_RELAXED, __HIP_MEMORY_SCOPE_AGENT); }
__device__ __forceinline__ unsigned xb_add(unsigned* p, unsigned v) { return __hip_atomic_fetch_add(p, v, __ATOMIC_RELAXED, __HIP_MEMORY_SCOPE_AGENT); }
__device__ __forceinline__ unsigned xb_xcc_id() { return (unsigned)__builtin_amdgcn_s_getreg((3 << 11) | 20) & 0xFu; }
#define XB_SPIN(cond, bar) do { unsigned _sp = 0; while (cond) { __builtin_amdgcn_s_sleep(1); \
    if ((++_sp & 255u) == 0u) { if (xb_ld(&(bar)[XB_TMO])) break; if (_sp > XB_SPIN_CAP) { atomicAdd(&(bar)[XB_TMO], 1u); break; } } } } while (0)
struct XcdBarrier { unsigned* bar; unsigned x; volatile LAS unsigned* st; };
__device__ __forceinline__ XcdBarrier xcd_barrier_post(unsigned* bar, volatile LAS unsigned* st) {
    XcdBarrier b; b.bar = bar; b.x = xb_xcc_id(); b.st = st;
    if (threadIdx.x == 0) (void)xb_add(&bar[XB_XCNT(b.x)], 1u);
    return b;
}
__device__ __forceinline__ void xcd_barrier_complete(unsigned* bar, unsigned x, unsigned& nloc, unsigned& nx) {
    const unsigned G = gridDim.x * gridDim.y * gridDim.z;
    unsigned sum, cnt, mine, sp = 0u;
    for (;;) {
        sum = 0u; cnt = 0u; mine = 0u;
#pragma unroll
        for (unsigned j = 0; j < 16; ++j) { const unsigned c = xb_ld(&bar[XB_XCNT(j)]); sum += c; cnt += (c > 0u) ? 1u : 0u; mine = (j == x) ? c : mine; }
        if (sum == G) break;
        __builtin_amdgcn_s_sleep(1);
        if ((++sp & 255u) == 0u) { if (xb_ld(&bar[XB_TMO])) break; if (sp > XB_SPIN_CAP) { atomicAdd(&bar[XB_TMO], 1u); break; } }
    }
    nloc = mine > 0u ? mine : 1u; nx = cnt > 0u ? cnt : 1u;
}
__device__ __forceinline__ void xcd_barrier(const XcdBarrier& b) {
    asm volatile("s_waitcnt vmcnt(0)" ::: "memory");
    __syncthreads();
    if (threadIdx.x == 0) {
        unsigned* bar = b.bar;
        __builtin_amdgcn_s_waitcnt(0);
        unsigned nloc = b.st[0], nx = b.st[1];
        if (nloc == 0u) { xcd_barrier_complete(bar, b.x, nloc, nx); b.st[0] = nloc; b.st[1] = nx; }
        const unsigned old = xb_add(&bar[XB_XSUB(b.x)], 1u);
        const unsigned gen = old / nloc;
        if (old + 1u == (gen + 1u) * nloc) {
            __builtin_amdgcn_fence(__ATOMIC_RELEASE, "agent");
            asm volatile("s_waitcnt vmcnt(0)" ::: "memory");
            const unsigned og = xb_add(&bar[XB_TOP], 1u);
            const unsigned tg = og / nx;
            if (og + 1u == (tg + 1u) * nx) xb_add(&bar[XB_TOPGEN], 1u);
            else XB_SPIN(xb_ld(&bar[XB_TOPGEN]) == tg, bar);
            __builtin_amdgcn_fence(__ATOMIC_ACQUIRE, "agent");
            xb_add(&bar[XB_XGEN(b.x)], 1u);
            asm volatile("s_waitcnt vmcnt(0)" ::: "memory");
        } else {
            XB_SPIN(xb_ld(&bar[XB_XGEN(b.x)]) == gen, bar);
            __builtin_amdgcn_fence(__ATOMIC_ACQUIRE, "agent");
            asm volatile("s_waitcnt vmcnt(0)" ::: "memory");
        }
    }
    __syncthreads();
}

__device__ __forceinline__ int sched(int i, int T) {
    const int x = VBID & 7, lb = VBID >> 3, nlb = VGRID >> 3;
    const int chunk = (T + 7) >> 3, local = lb + i * nlb;
    if (local >= chunk) return -1;
    const int t = x * chunk + local;
    return t < T ? t : -1;
}
__device__ __forceinline__ void tile_mn(int t, int NMt, int NNt, int& mt, int& nt) {
    const int per = 8 * NNt, gi = t / per, r = t - gi * per, fm = gi * 8;
    const int gsz = (NMt - fm) < 8 ? (NMt - fm) : 8;
    mt = fm + r % gsz; nt = r / gsz;
}

template <int BN, int AMODE>
__device__ __forceinline__ void mma_seg(f32x4 (&acc)[4][BN / 32], const bf16_t* __restrict__ A, const int lda,
                                        const bf16_t* __restrict__ Bt, const int ldb, const int K, LAS char* lds,
                                        const float* __restrict__ gssrow) {
    constexpr int NI = BN / 32;
    const int tid = VTID, lane = tid & 63, wid = __builtin_amdgcn_readfirstlane(tid >> 6), wm = wid >> 1, wn = wid & 1, fr = lane & 15, fq = lane >> 4;
    const int srow = tid >> 3, sc = tid & 7;
    const int csw = (sc ^ ((srow >> 1) & 7)) * 8;
    const bf16_t* ap = A + (size_t)srow * lda + (AMODE == 1 ? sc * 8 : csw);
    const bf16_t* bp = Bt + (size_t)srow * ldb + csw;
    const int woff = srow * 128 + ((sc ^ ((srow >> 1) & 7)) << 4);
    const int gl = wid * 1024;
    const int sw = (fr >> 1) & 7;
    const int aoff = (wm * 64 + fr) * 128, boff = 32768 + (wn * (BN / 2) + fr) * 128;
    u32x4 ra[4];
    float asc[4];
    const int nk = K >> 6;
#define MS_ISSUE(kt, buf) do { \
    if (AMODE == 1) { \
        _Pragma("unroll") for (int i = 0; i < 4; ++i) ra[i] = *(const u32x4*)(ap + (size_t)(i * 32) * lda + (kt) * 64); \
        const int k_ = (kt) * 64 + sc * 8; \
        _Pragma("unroll") for (int i = 0; i < 4; ++i) asc[i] = (k_ >= 512) ? rsqrtf(gssrow[(srow + 32 * i) * 2 + ((k_ - 512) >> 8)] * (1.f / 256.f) + EPS) : 1.f; \
    } else { \
        _Pragma("unroll") for (int i = 0; i < 4; ++i) __builtin_amdgcn_global_load_lds((const unsigned*)(ap + (size_t)(i * 32) * lda + (kt) * 64), (LAS unsigned*)(lds + (buf) * 16384 + i * 4096 + gl), 16, 0, 0); \
    } \
    _Pragma("unroll") for (int i = 0; i < NI; ++i) __builtin_amdgcn_global_load_lds((const unsigned*)(bp + (size_t)(i * 32) * ldb + (kt) * 64), (LAS unsigned*)(lds + 32768 + (buf) * 16384 + i * 4096 + gl), 16, 0, 0); \
  } while (0)
#define MS_STORE(buf) do { if (AMODE == 1) { \
    _Pragma("unroll") for (int i = 0; i < 4; ++i) { *(LAS u32x4*)(lds + (buf) * 16384 + woff + i * 4096) = scale8(ra[i], asc[i]); } } \
  } while (0)
    __syncthreads();
    MS_ISSUE(0, 0);
    MS_STORE(0);
    asm volatile("s_waitcnt vmcnt(0)" ::: "memory");
    __syncthreads();
    for (int kt = 0; kt < nk; ++kt) {
        const int cur = kt & 1;
        if (kt + 1 < nk) MS_ISSUE(kt + 1, cur ^ 1);
#pragma unroll
        for (int kk = 0; kk < 2; ++kk) {
            const int co = (((kk * 4 + fq) ^ sw) << 4) + cur * 16384;
            bf16x8 af[4], bfv[NI];
#pragma unroll
            for (int mi = 0; mi < 4; ++mi) af[mi] = *(LAS bf16x8*)(lds + aoff + mi * 2048 + co);
#pragma unroll
            for (int ni = 0; ni < NI; ++ni) bfv[ni] = *(LAS bf16x8*)(lds + boff + ni * 2048 + co);
#pragma unroll
            for (int mi = 0; mi < 4; ++mi)
#pragma unroll
                for (int ni = 0; ni < NI; ++ni) acc[mi][ni] = __builtin_amdgcn_mfma_f32_16x16x32_bf16(bfv[ni], af[mi], acc[mi][ni], 0, 0, 0);
        }
        if (kt + 1 < nk) MS_STORE(cur ^ 1);
        asm volatile("s_waitcnt vmcnt(0)" ::: "memory");
        __syncthreads();
    }
#undef MS_ISSUE
#undef MS_STORE
}
template <int NI> __device__ __forceinline__ void zero_acc(f32x4 (&acc)[4][NI]) {
#pragma unroll
    for (int mi = 0; mi < 4; ++mi)
#pragma unroll
        for (int ni = 0; ni < NI; ++ni) acc[mi][ni] = (f32x4){0.f, 0.f, 0.f, 0.f};
}
__device__ __forceinline__ void mma256(f32x4 (&acc0)[4][4], f32x4 (&acc1)[4][4], const bf16_t* __restrict__ A, const int lda,
                                       const bf16_t* __restrict__ Bt, const int ldb, const int K, LAS char* lds) {
    const int tid = RTID, lane = tid & 63, w8 = __builtin_amdgcn_readfirstlane(tid >> 6), wm2 = w8 >> 2, wn4 = w8 & 3, fr = lane & 15, fq = lane >> 4;
    const int srow = tid >> 3, sc = tid & 7;
    const int csw = (sc ^ ((srow >> 1) & 7)) * 8;
    const bf16_t* ap = A + (size_t)srow * lda + csw;
    const bf16_t* bp = Bt + (size_t)srow * ldb + csw;
    const int gl = w8 * 1024;
    const int sw = (fr >> 1) & 7;
    const int aoff = (wm2 * 128 + fr) * 128, boff = 32768 + (wn4 * 64 + fr) * 128;
    const int nk = K >> 6;
#define M8_ISSUE(kt, buf) do { const int base_ = (buf) * 65536 + gl; \
    _Pragma("unroll") for (int i = 0; i < 4; ++i) __builtin_amdgcn_global_load_lds((const unsigned*)(ap + (size_t)(i * 64) * lda + (kt) * 64), (LAS unsigned*)(lds + base_ + i * 8192), 16, 0, 0); \
    _Pragma("unroll") for (int i = 0; i < 4; ++i) __builtin_amdgcn_global_load_lds((const unsigned*)(bp + (size_t)(i * 64) * ldb + (kt) * 64), (LAS unsigned*)(lds + base_ + 32768 + i * 8192), 16, 0, 0); \
  } while (0)
    __syncthreads();
    M8_ISSUE(0, 0);
    asm volatile("s_waitcnt vmcnt(0)" ::: "memory");
    __syncthreads();
    for (int kt = 0; kt < nk; ++kt) {
        const int cur = kt & 1;
        if (kt + 1 < nk) M8_ISSUE(kt + 1, cur ^ 1);
#pragma unroll 1
        for (int kk = 0; kk < 2; ++kk) {
            const int co = (((kk * 4 + fq) ^ sw) << 4) + cur * 65536;
            bf16x8 a0[4], a1[4], bfv[4];
#pragma unroll
            for (int ni = 0; ni < 4; ++ni) bfv[ni] = *(LAS bf16x8*)(lds + boff + ni * 2048 + co);
#pragma unroll
            for (int mi = 0; mi < 4; ++mi) a0[mi] = *(LAS bf16x8*)(lds + aoff + mi * 2048 + co);
#pragma unroll
            for (int mi = 0; mi < 4; ++mi) a1[mi] = *(LAS bf16x8*)(lds + aoff + 8192 + mi * 2048 + co);
            __builtin_amdgcn_s_setprio(1);
#pragma unroll
            for (int mi = 0; mi < 4; ++mi)
#pragma unroll
                for (int ni = 0; ni < 4; ++ni) acc0[mi][ni] = __builtin_amdgcn_mfma_f32_16x16x32_bf16(bfv[ni], a0[mi], acc0[mi][ni], 0, 0, 0);
#pragma unroll
            for (int mi = 0; mi < 4; ++mi)
#pragma unroll
                for (int ni = 0; ni < 4; ++ni) acc1[mi][ni] = __builtin_amdgcn_mfma_f32_16x16x32_bf16(bfv[ni], a1[mi], acc1[mi][ni], 0, 0, 0);
            __builtin_amdgcn_s_setprio(0);
        }
        asm volatile("s_waitcnt vmcnt(0)" ::: "memory");
        __syncthreads();
    }
#undef M8_ISSUE
}
namespace pg8 {
#define PG8_LAS __attribute__((address_space(3)))
constexpr int BM = 256, BK = 64, HALF = 128, HTB = HALF * BK * 2  , STAGE_BYTES = 8 * HTB, NXCD = 8, WGM = 8;
__device__ __forceinline__ int lds_byte(int r, int c) { const int st = (r >> 4) * 2 + (c >> 5), rr = r & 15, cc = c & 31, ob = rr * 64 + cc * 2; return st * 1024 + (ob ^ (((ob >> 9) & 1) << 5)); }
__device__ __forceinline__ void stage_rc(int b, int& R, int& C) { const int st = b / 1024, sb = b % 1024, swz = sb ^ (((sb >> 9) & 1) << 5); R = (st >> 1) * 16 + swz / 64; C = (st & 1) * 32 + (swz % 64) / 2; }
__device__ __forceinline__ int perm32(int rho) { const int n = rho >> 4, i = rho & 15; return 8 * (i >> 2) + 4 * n + (i & 3); }
struct Unit { int pm, pn; };
struct Gemm { const bf16_t* A; const bf16_t* Bt; int M, N, K; };
template <class Epi, class Sched, bool STAMP = false>
__device__ __forceinline__ void gemm_phase(PG8_LAS unsigned char* lds, const Gemm g, const Sched& S, const Epi& E, unsigned long long* stamps) {
    const int tid = threadIdx.x, wid = __builtin_amdgcn_readfirstlane(tid >> 6), lane = tid & 63, wr = wid >> 2, wc = wid & 3, fr = lane & 15, fq = lane >> 4;
    const int K = g.K, nt = K / BK;
    int ts_lo = 0, ts_hi = 0, nts = 0; const unsigned long long rt_entry = STAMP ? (unsigned long long)wall_clock64() : 0ull;
#define PG8_STAMP() do { if (STAMP && wid == 0 && nts < 64) { const unsigned long long _c = (unsigned long long)clock64(); \
        ts_lo = (lane == nts) ? (int)(unsigned)_c : ts_lo; ts_hi = (lane == nts) ? (int)(unsigned)(_c >> 32) : ts_hi; ++nts; } } while (0)
    PG8_STAMP();
    unsigned voffA[2], voffB[2];
#pragma unroll
    for (int i = 0; i < 2; ++i) { int R, C; stage_rc(tid * 16 + i * 8192, R, C); const int Rb = Epi::PERM ? ((R & ~31) + perm32(R & 31)) : R;
        voffA[i] = (unsigned)(R * K + C) * 2u; voffB[i] = (unsigned)(Rb * K + C) * 2u; }
    const size_t kstep = (size_t)(BK * 2);
    const size_t hstep = (size_t)HALF * K * 2;
    const size_t tstep = 2 * hstep;
    const unsigned ldsw = (unsigned)wid * 1024u;
    const int aoff = lds_byte(wr * 64 + fr, fq * 8), boff = lds_byte(wc * 32 + fr, fq * 8);
#define PG8_SA(b, h) (((b) * 2 + (h)) * HTB)
#define PG8_SB(b, h) ((4 + (b) * 2 + (h)) * HTB)
#define PG8_STAGE(bufoff, gbase, voff) do { _Pragma("unroll") for (int _i = 0; _i < 2; ++_i) \
        __builtin_amdgcn_global_load_lds((const unsigned*)((const char*)(gbase) + (voff)[_i]), (PG8_LAS unsigned*)(lds + (bufoff) + ldsw + _i * 8192), 16, 0, 0); } while (0)
#define PG8_LDA(dst, b, h) do { _Pragma("unroll") for (int m = 0; m < 4; ++m) _Pragma("unroll") for (int k = 0; k < 2; ++k) dst[m][k] = *(const PG8_LAS bf16x8*)(lds + PG8_SA(b, h) + aoff + m * 2048 + k * 1024); } while (0)
#define PG8_LDB(dst, b, h) do { _Pragma("unroll") for (int n = 0; n < 2; ++n) _Pragma("unroll") for (int k = 0; k < 2; ++k) dst[n][k] = *(const PG8_LAS bf16x8*)(lds + PG8_SB(b, h) + boff + n * 2048 + k * 1024); } while (0)
#define PG8_MMA(ai, bj, At, Bt) do { __builtin_amdgcn_s_setprio(1); _Pragma("unroll") for (int m = 0; m < 4; ++m) _Pragma("unroll") for (int n = 0; n < 2; ++n) _Pragma("unroll") for (int k = 0; k < 2; ++k) \
        acc[ai][bj][m][n] = __builtin_amdgcn_mfma_f32_16x16x32_bf16(Bt[n][k], At[m][k], acc[ai][bj][m][n], 0, 0, 0); __builtin_amdgcn_s_setprio(0); } while (0)
#define PG8_WAIT_V(n) asm volatile("s_waitcnt vmcnt(" #n ")" ::: "memory")
#define PG8_WAIT_L(n) asm volatile("s_waitcnt lgkmcnt(" #n ")" ::: "memory")
#define PG8_BAR __builtin_amdgcn_s_barrier()
#define PG8_SCHED __builtin_amdgcn_sched_barrier(0)
    Unit cur, nxt; int ui = 0;
    if (!S.next(0, cur)) return;
    f32x4 acc[2][2][4][2];
#pragma unroll
    for (int a = 0; a < 2; ++a)
#pragma unroll
        for (int b = 0; b < 2; ++b)
#pragma unroll
            for (int m = 0; m < 4; ++m)
#pragma unroll
                for (int n = 0; n < 2; ++n) acc[a][b][m][n] = (f32x4){0.f, 0.f, 0.f, 0.f};
    bf16x8 At[4][2], B0[2][2], B1[2][2];
    const char* cA = (const char*)g.A + (size_t)cur.pm * tstep; const char* cB = (const char*)g.Bt + (size_t)cur.pn * tstep;
    S.a_ready(cur);
    PG8_STAGE(PG8_SB(0, 0), cB, voffB); PG8_STAGE(PG8_SA(0, 0), cA, voffA); PG8_STAGE(PG8_SB(0, 1), cB + hstep, voffB); PG8_STAGE(PG8_SA(0, 1), cA + hstep, voffA);
    if (wr == 1) PG8_BAR;
    PG8_WAIT_V(4); PG8_BAR;
    PG8_STAGE(PG8_SB(1, 0), cB + kstep, voffB); PG8_STAGE(PG8_SA(1, 0), cA + kstep, voffA); PG8_STAGE(PG8_SB(1, 1), cB + hstep + kstep, voffB);
    PG8_WAIT_V(6); PG8_BAR;
    PG8_STAMP();
    for (;;) {
        const bool has_next = S.next(ui + 1, nxt);
        const char* nA = has_next ? (const char*)g.A + (size_t)nxt.pm * tstep : cA; const char* nB = has_next ? (const char*)g.Bt + (size_t)nxt.pn * tstep : cB;
        for (int t = 0; t < nt; t += 2) {
            const bool last = (t == nt - 2);
            const char* a1 = cA + (size_t)(t + 1) * kstep;
            const char* a2 = last ? nA : cA + (size_t)(t + 2) * kstep; const char* b2 = last ? nB : cB + (size_t)(t + 2) * kstep;
            const char* a3 = a2 + kstep; const char* b3 = b2 + kstep;
            if (last && has_next) S.a_ready(nxt);
            PG8_LDB(B0, 0, 0); PG8_SCHED; PG8_LDA(At, 0, 0); PG8_STAGE(PG8_SA(1, 1), a1 + hstep, voffA);
            PG8_WAIT_L(8); PG8_BAR; PG8_WAIT_L(0); PG8_MMA(0, 0, At, B0); PG8_BAR; PG8_SCHED;
            PG8_LDB(B1, 0, 1); PG8_STAGE(PG8_SB(0, 0), b2, voffB);
            PG8_BAR; PG8_WAIT_L(0); PG8_MMA(0, 1, At, B1); PG8_BAR;
            PG8_LDA(At, 0, 1); PG8_STAGE(PG8_SA(0, 0), a2, voffA);
            PG8_BAR; PG8_WAIT_L(0); PG8_MMA(1, 0, At, B0); PG8_BAR; PG8_SCHED;
            PG8_STAGE(PG8_SB(0, 1), b2 + hstep, voffB);
            PG8_WAIT_V(6); PG8_BAR; PG8_MMA(1, 1, At, B1); PG8_BAR;
            PG8_LDB(B0, 1, 0); PG8_SCHED; PG8_LDA(At, 1, 0); PG8_STAGE(PG8_SA(0, 1), a2 + hstep, voffA);
            PG8_WAIT_L(8); PG8_BAR; PG8_WAIT_L(0); PG8_MMA(0, 0, At, B0); PG8_BAR; PG8_SCHED;
            PG8_LDB(B1, 1, 1); PG8_STAGE(PG8_SB(1, 0), b3, voffB);
            PG8_BAR; PG8_WAIT_L(0); PG8_MMA(0, 1, At, B1); PG8_BAR;
            PG8_LDA(At, 1, 1); PG8_STAGE(PG8_SA(1, 0), a3, voffA);
            PG8_BAR; PG8_WAIT_L(0); PG8_MMA(1, 0, At, B0); PG8_BAR; PG8_SCHED;
            PG8_STAGE(PG8_SB(1, 1), b3 + hstep, voffB);
            PG8_WAIT_V(6); PG8_BAR; PG8_MMA(1, 1, At, B1); PG8_BAR;
        }
        PG8_STAMP();
        if constexpr (!Epi::AFTER_DRAIN) { E(acc, cur, wr, wc, fr, fq); S.done(cur); }
        PG8_STAMP();
        if (!has_next) break;
#pragma unroll
        for (int a = 0; a < 2; ++a)
#pragma unroll
            for (int b = 0; b < 2; ++b)
#pragma unroll
                for (int m = 0; m < 4; ++m)
#pragma unroll
                    for (int n = 0; n < 2; ++n) acc[a][b][m][n] = (f32x4){0.f, 0.f, 0.f, 0.f};
        cur = nxt; cA = nA; cB = nB; ++ui;
    }
    PG8_WAIT_V(0);
    if (wr == 0) PG8_BAR;
    PG8_BAR;
    if constexpr (Epi::AFTER_DRAIN) { E.fused(acc, cur, wr, wc, fr, fq, lds, wid, lane); S.done(cur); }
    PG8_STAMP();
    if (STAMP && wid == 0) { stamps[lane] = lane < nts ? (((unsigned long long)(unsigned)ts_hi << 32) | (unsigned)ts_lo) : 0ull;
        if (lane == 62) stamps[62] = rt_entry; if (lane == 63) stamps[63] = (unsigned long long)wall_clock64(); }
#undef PG8_STAMP
#undef PG8_SA
#undef PG8_SB
#undef PG8_STAGE
#undef PG8_LDA
#undef PG8_LDB
#undef PG8_MMA
#undef PG8_WAIT_V
#undef PG8_WAIT_L
#undef PG8_BAR
#undef PG8_SCHED
}
}

__device__ __forceinline__ int sched256(int i, int T) {
    const int x = RBID & 7, lb = RBID >> 3, nlb = RGRID >> 3;
    const int chunk = (T + 7) >> 3, local = lb + i * nlb;
    if (local >= chunk) return -1;
    const int t = x * chunk + local;
    return t < T ? t : -1;
}
#define W8V const int w8_ = __builtin_amdgcn_readfirstlane(RTID >> 6), wm2_ = w8_ >> 2, wn4_ = w8_ & 3; const int half_ = w8_ >> 2; (void)half_
__device__ __forceinline__ float fq_sum(float v) { v += __shfl_xor(v, 16); v += __shfl_xor(v, 32); return v; }
__device__ __forceinline__ float fq_max(float v) { v = fmaxf(v, __shfl_xor(v, 16)); v = fmaxf(v, __shfl_xor(v, 32)); return v; }

#define WSP(T, off) ((T*)(p.ws + (off)))
#define TIDV const int tid = VTID, lane = tid & 63, wid = __builtin_amdgcn_readfirstlane(tid >> 6), wm = wid >> 1, wn = wid & 1, fr = lane & 15, fq = lane >> 4; (void)wm; (void)wn; (void)fr; (void)fq; (void)lane; (void)wid

__device__ __forceinline__ void p0_transpose(const Params& p, int item, LAS char* lds) {
    TIDV;
    LAS float* tile = (LAS float*)lds;
    int r = item; const float* s0; const float* s1 = nullptr; const float* ksc = nullptr; bf16_t* dst; int K = 1024, NT, ld, mode = 0, kso = 0, nvalid; float mul = 1.f;
    if (r < 704) { s0 = p.in[8]; dst = WSP(bf16_t, W_WIN); NT = 44; ld = 2568; nvalid = 2568; }
    else if ((r -= 704) < 512) { s0 = p.in[23]; s1 = p.in[24]; dst = WSP(bf16_t, W_WKV); mode = 1; NT = 32; ld = 1024; nvalid = 2048; }
    else if ((r -= 512) < 256) { s0 = p.in[19]; dst = WSP(bf16_t, W_WOUT); ksc = p.in[18]; kso = 512; NT = 16; ld = 1024; nvalid = 1024; }
    else if ((r -= 256) < 256) { s0 = p.in[22]; dst = WSP(bf16_t, W_WQ); ksc = p.in[20]; mul = 0.0625f; NT = 16; ld = 1024; nvalid = 1024; }
    else if ((r -= 256) < 256) { s0 = p.in[25]; dst = WSP(bf16_t, W_WXO); NT = 16; ld = 1024; nvalid = 1024; }
    else if ((r -= 256) < 1408) { s0 = p.in[27]; s1 = p.in[28]; dst = WSP(bf16_t, W_WGU); mode = 2; ksc = p.in[26]; NT = 88; ld = 2816; nvalid = 5632; }
    else { r -= 1408; s0 = p.in[29]; dst = WSP(bf16_t, W_WD); K = 2816; NT = 16; ld = 1024; nvalid = 1024; }
    const int kt = r / NT, nt = r - kt * NT, k0 = kt * 64, n0 = nt * 64;
    {
        const int tn = (tid & 15) * 4, tk = tid >> 4, n = n0 + tn;
        const float* src = s0; size_t coff = 0; const bool valid = n < nvalid;
        if (mode == 0) coff = n;
        else if (mode == 1) { if (n >= 1024) { src = s1; coff = n - 1024; } else coff = n; }
        else { const int grp = n >> 5, w = n & 31; coff = grp * 16 + (w & 15); if (w >> 4) src = s1; }
        f32x4 v[4];
#pragma unroll
        for (int i = 0; i < 4; ++i) { const int k = k0 + tk + 16 * i; v[i] = valid ? *(const f32x4*)(src + (size_t)k * ld + coff) : (f32x4){0.f, 0.f, 0.f, 0.f}; }
#pragma unroll
        for (int i = 0; i < 4; ++i) {
            const int k = k0 + tk + 16 * i;
            float sc_ = mul; if (ksc && k >= kso) sc_ *= ksc[k - kso];
            LAS float* t_ = tile + (tk + 16 * i) * 65 + tn;
            t_[0] = v[i][0] * sc_; t_[1] = v[i][1] * sc_; t_[2] = v[i][2] * sc_; t_[3] = v[i][3] * sc_;
        }
    }
    __syncthreads();
    {
        const int c = tid & 7, nl = tid >> 3;
#pragma unroll
        for (int j = 0; j < 2; ++j) {
            const int n = nl + 32 * j;
            const LAS float* s = tile + (c * 8) * 65 + n;
            u32x4 o; o.x = pk2(s[0], s[65]); o.y = pk2(s[2 * 65], s[3 * 65]); o.z = pk2(s[4 * 65], s[5 * 65]); o.w = pk2(s[6 * 65], s[7 * 65]);
            *(u32x4*)(dst + (size_t)(n0 + n) * K + k0 + c * 8) = o;
        }
    }
    __syncthreads();
}
__device__ __forceinline__ void p0_rownorm(const Params& p, int ri) {
    TIDV;
    const int row = ri * 4 + wid;
    const float* src; const float* g; bf16_t* dst;
    if (row < MT) { src = row < MP ? p.in[0] + (size_t)row * 1024 : p.in[1] + (size_t)(row - MP) * 1024; g = p.in[7]; dst = WSP(bf16_t, W_XB) + (size_t)row * 1024; }
    else { const int r2 = row - MT; src = p.in[6] + (size_t)r2 * 1024; g = p.in[21]; dst = WSP(bf16_t, W_MEMB) + (size_t)r2 * 1024; }
    float4 v[4]; float ss = 0.f;
#pragma unroll
    for (int j = 0; j < 4; ++j) { v[j] = *(const float4*)(src + (j * 64 + lane) * 4); ss += v[j].x * v[j].x + v[j].y * v[j].y + v[j].z * v[j].z + v[j].w * v[j].w; }
    const float rstd = rsqrtf(wave_sum(ss) * (1.f / 1024.f) + EPS);
#pragma unroll
    for (int j = 0; j < 4; ++j) {
        const float4 gv = *(const float4*)(g + (j * 64 + lane) * 4);
        u32x2 o; o.x = pk2(v[j].x * rstd * gv.x, v[j].y * rstd * gv.y); o.y = pk2(v[j].z * rstd * gv.z, v[j].w * rstd * gv.w);
        *(u32x2*)(dst + (j * 64 + lane) * 4) = o;
    }
}
__device__ __forceinline__ void phase0(const Params& p, LAS char* lds) {
    const int gtid = VBID * 256 + VTID, gn = VGRID * 256;
    float* z = WSP(float, W_ZERO);
    for (int i = gtid; i < (int)ZERO_FLOATS; i += gn) z[i] = 0.f;
    bf16_t* wsb = WSP(bf16_t, W_WSB); const float* ws = p.in[11];
    for (int i = gtid; i < 4 * 128 * 128; i += gn) { const int s = i & 127, t = (i >> 7) & 127; wsb[i] = (s <= t) ? (bf16_t)(pk2(ws[i], 0.f) & 0xffffu) : (bf16_t)0; }
    for (int it = VBID; it < 4096 + 4640; it += VGRID) {
        if (it < 4096) p0_transpose(p, it, lds); else p0_rownorm(p, it - 4096);
    }
}

template <int NI>
__device__ __forceinline__ void p1_inproj_epi(const Params& p, f32x4 (&acc)[4][NI], const int rbw, const int cbw) {
    TIDV;
    const int n0 = cbw & ~127;
    const int rb = rbw + fr, cb = cbw + fq * 4;
    if (n0 < 512) {
        bf16_t* ub = WSP(bf16_t, W_UB);
#pragma unroll
        for (int mi = 0; mi < 4; ++mi)
#pragma unroll
            for (int ni = 0; ni < NI; ++ni) { const f32x4 a = acc[mi][ni]; u32x2 o; o.x = pk2(gelu_t(a[0]), gelu_t(a[1])); o.y = pk2(gelu_t(a[2]), gelu_t(a[3]));
                *(u32x2*)(ub + (size_t)(rb + mi * 16) * 512 + cb + ni * 16) = o; }
    } else if (n0 < 1024) {
        bf16_t* vg = WSP(bf16_t, W_VG); float* vstat = WSP(float, W_ZERO);
#pragma unroll
        for (int mi = 0; mi < 4; ++mi) {
            float s1 = 0.f, s2 = 0.f;
#pragma unroll
            for (int ni = 0; ni < NI; ++ni) { const f32x4 a = acc[mi][ni]; const float g0 = gelu_t(a[0]), g1 = gelu_t(a[1]), g2 = gelu_t(a[2]), g3 = gelu_t(a[3]);
                u32x2 o; o.x = pk2(g0, g1); o.y = pk2(g2, g3);
                const float r0 = bflo(o.x), r1 = bfhi(o.x), r2 = bflo(o.y), r3 = bfhi(o.y);
                s1 += (r0 + r1) + (r2 + r3); s2 += (r0 * r0 + r1 * r1) + (r2 * r2 + r3 * r3);
                *(u32x2*)(vg + (size_t)(rb + mi * 16) * 512 + (cb - 512) + ni * 16) = o; }
            s1 = fq_sum(s1); s2 = fq_sum(s2);
            if (fq == 0) { atomicAdd(vstat + (size_t)(rb + mi * 16) * 2, s1); atomicAdd(vstat + (size_t)(rb + mi * 16) * 2 + 1, s2); }
        }
    } else if (n0 < 1536) {
        bf16_t* zb = WSP(bf16_t, W_ZB);
#pragma unroll
        for (int mi = 0; mi < 4; ++mi)
#pragma unroll
            for (int ni = 0; ni < NI; ++ni) { const f32x4 a = acc[mi][ni]; u32x2 o; o.x = pk2(a[0], a[1]); o.y = pk2(a[2], a[3]);
                *(u32x2*)(zb + (size_t)(rb + mi * 16) * 512 + (cb - 1024) + ni * 16) = o; }
    } else if (n0 < 2560) {
        bf16_t* xb = WSP(bf16_t, W_XBCB);
#pragma unroll
        for (int mi = 0; mi < 4; ++mi) {
            const int row = rb + mi * 16;
            float* fo = nullptr;
            if (row < MP) { const int t = row & 2047; if (t >= 2045) fo = p.out + O_CONVP + ((size_t)(row >> 11) * 3 + (t - 2045)) * 1024; }
            else fo = p.out + O_CONVS + ((size_t)(row - MP) * 3 + 2) * 1024;
#pragma unroll
            for (int ni = 0; ni < NI; ++ni) { const f32x4 a = acc[mi][ni]; const int ch = cb - 1536 + ni * 16; u32x2 o; o.x = pk2(a[0], a[1]); o.y = pk2(a[2], a[3]);
                *(u32x2*)(xb + (size_t)row * 1024 + ch) = o;
                if (fo) *(f32x4*)(fo + ch) = a; }
        }
    } else {
        float* dtr = WSP(float, W_DTRAW);
        if (cbw == 2560 && fq < 2) {
#pragma unroll
            for (int mi = 0; mi < 4; ++mi) *(f32x4*)(dtr + (size_t)(rb + mi * 16) * 8 + fq * 4) = acc[mi][0];
        }
    }
}
template <int NI>
__device__ __forceinline__ void p1_memkv_epi(const Params& p, f32x4 (&acc)[4][NI], const int rbw, const int cbw) {
    TIDV;
    const int n0 = cbw & ~127;
    const int rb = rbw + fr, cb = cbw + fq * 4;
    if (n0 < 1024) {
        bf16_t* kb = WSP(bf16_t, W_KB);
#pragma unroll
        for (int mi = 0; mi < 4; ++mi)
#pragma unroll
            for (int ni = 0; ni < NI; ++ni) { const f32x4 a = acc[mi][ni]; const size_t o_ = (size_t)(rb + mi * 16) * 1024 + cb + ni * 16;
                *(f32x4*)(p.out + O_MK + o_) = a; u32x2 o; o.x = pk2(a[0], a[1]); o.y = pk2(a[2], a[3]); *(u32x2*)(kb + o_) = o; }
    } else {
        bf16_t* vT = WSP(bf16_t, W_VT);
#pragma unroll
        for (int mi = 0; mi < 4; ++mi)
#pragma unroll
            for (int ni = 0; ni < NI; ++ni) { const f32x4 a = acc[mi][ni]; const int row = rb + mi * 16, c = cb - 1024 + ni * 16;
                *(f32x4*)(p.out + O_MV + (size_t)row * 1024 + c) = a;
                const int b = row >> 8, m = row & 255, head = c >> 8, d = c & 255;
                bf16_t* vp = vT + ((size_t)(b * 4 + head) * 256 + d) * 256 + m;
                const unsigned q0 = pk2(a[0], a[1]), q1 = pk2(a[2], a[3]);
                vp[0] = (bf16_t)(q0 & 0xffffu); vp[256] = (bf16_t)(q0 >> 16); vp[512] = (bf16_t)(q1 & 0xffffu); vp[768] = (bf16_t)(q1 >> 16); }
    }
}
__device__ __forceinline__ void phase1(const Params& p, LAS char* lds, LAS char* ldsh) {
    W8V;
    constexpr int T1 = 64 * 11, T2 = 8 * 8;
    int t;
    for (int i = 0; (t = sched256(i, T1 + T2)) >= 0; ++i) {
        f32x4 acc0[4][4], acc1[4][4]; zero_acc<4>(acc0); zero_acc<4>(acc1);
        int mp, nt;
        if (t < T1) {
            tile_mn(t, 64, 11, mp, nt);
            mma256(acc0, acc1, WSP(bf16_t, W_XB) + (size_t)mp * 256 * 1024, 1024, WSP(bf16_t, W_WIN) + (size_t)nt * 256 * 1024, 1024, 1024, lds);
            const int rb0 = mp * 256 + wm2_ * 128, cbw = nt * 256 + wn4_ * 64;
            p1_inproj_epi<4>(p, acc0, rb0, cbw); p1_inproj_epi<4>(p, acc1, rb0 + 64, cbw);
        } else {
            tile_mn(t - T1, 8, 8, mp, nt);
            mma256(acc0, acc1, WSP(bf16_t, W_MEMB) + (size_t)mp * 256 * 1024, 1024, WSP(bf16_t, W_WKV) + (size_t)nt * 256 * 1024, 1024, 1024, lds);
            const int rb0 = mp * 256 + wm2_ * 128, cbw = nt * 256 + wn4_ * 64;
            p1_memkv_epi<4>(p, acc0, rb0, cbw); p1_memkv_epi<4>(p, acc1, rb0 + 64, cbw);
        }
    }
    if (RBID < 11) {
        const int j = RBID * 2 + half_, jj = j < 21 ? j : 20;
        const int wv_ = __builtin_amdgcn_readfirstlane(VTID >> 6), wmv = wv_ >> 1, wnv = wv_ & 1;
        f32x4 acc[4][4]; zero_acc<4>(acc);
        mma_seg<128, 0>(acc, WSP(bf16_t, W_XB) + (size_t)MP * 1024, 1024, WSP(bf16_t, W_WIN) + (size_t)jj * 128 * 1024, 1024, 1024, ldsh, nullptr);
        if (j < 21) p1_inproj_epi<4>(p, acc, MP + wmv * 64, jj * 128 + wnv * 64);
    }
}

__device__ __forceinline__ void p2_conv(const Params& p, int item, LAS char* lds) {
    TIDV;
    const int cc = item >> 4, slab = item & 15, c = cc & 15, tok0 = cc * 128, ch0 = slab * 64;
    const int cgp = tid & 7, r0 = tid >> 3;
    LAS float* s_acum = (LAS float*)(lds + 40960); LAS float* s_dt = s_acum + 128; LAS float* s_tot = s_acum + 256;
    if (slab < 8) {
        const int h = slab;
        float v = 0.f, dtv = 0.f;
        if (tid < 128) {
            dtv = softplus_f(WSP(float, W_DTRAW)[(size_t)(tok0 + tid) * 8 + h] + p.in[15][h]);
            v = dtv * (-expf(p.in[16][h]));
#pragma unroll
            for (int d = 1; d < 64; d <<= 1) { const float t = __shfl_up(v, d); if (lane >= d) v += t; }
            if (lane == 63) s_tot[wid] = v;
        }
        __syncthreads();
        if (tid < 128) {
            if (wid == 1) v += s_tot[0];
            s_acum[tid] = v; s_dt[tid] = dtv;
            WSP(float, W_ACUM)[(size_t)(cc * 8 + h) * 128 + tid] = v;
            WSP(float, W_DTV)[(size_t)(cc * 8 + h) * 128 + tid] = dtv;
        }
        __syncthreads();
    }
    const bf16_t* xin = WSP(bf16_t, W_XBCB);
    const int chb = ch0 + cgp * 8;
    u32x4 rin[7];
#pragma unroll
    for (int i = 0; i < 7; ++i) {
        const int rr = r0 * 4 - 3 + i;
        if (rr < 0 && c == 0) rin[i] = (u32x4){0u, 0u, 0u, 0u};
        else rin[i] = *(const u32x4*)(xin + (size_t)(tok0 + rr) * 1024 + chb);
    }
    const float* cw = p.in[13]; const float* cbp = p.in[14];
    float o[4][8];
#pragma unroll
    for (int e = 0; e < 8; ++e) {
        const float w0 = cw[chb + e], w1 = cw[1024 + chb + e], w2 = cw[2048 + chb + e], w3 = cw[3072 + chb + e], bb = cbp[chb + e];
        float xin_[7];
#pragma unroll
        for (int i = 0; i < 7; ++i) { const unsigned u = (e >> 1) == 0 ? rin[i].x : (e >> 1) == 1 ? rin[i].y : (e >> 1) == 2 ? rin[i].z : rin[i].w; xin_[i] = (e & 1) ? bfhi(u) : bflo(u); }
#pragma unroll
        for (int r = 0; r < 4; ++r) o[r][e] = silu_f(bb + xin_[r] * w0 + xin_[r + 1] * w1 + xin_[r + 2] * w2 + xin_[r + 3] * w3);
    }
    {
        bf16_t* dstn; int ldn, cofs;
        if (slab < 8) { dstn = WSP(bf16_t, W_XN); ldn = 512; cofs = chb; }
        else if (slab < 12) { dstn = WSP(bf16_t, W_BN); ldn = 256; cofs = chb - 512; }
        else { dstn = WSP(bf16_t, W_CN); ldn = 256; cofs = chb - 768; }
#pragma unroll
        for (int r = 0; r < 4; ++r) { u32x4 q; q.x = pk2(o[r][0], o[r][1]); q.y = pk2(o[r][2], o[r][3]); q.z = pk2(o[r][4], o[r][5]); q.w = pk2(o[r][6], o[r][7]);
            *(u32x4*)(dstn + (size_t)(tok0 + r0 * 4 + r) * ldn + cofs) = q; }
    }
    if (slab < 12) {
        float wv[4] = {1.f, 1.f, 1.f, 1.f};
        if (slab < 8) { const float al_ = s_acum[127];
#pragma unroll
            for (int r = 0; r < 4; ++r) wv[r] = __expf(al_ - s_acum[r0 * 4 + r]) * s_dt[r0 * 4 + r]; }
#pragma unroll
        for (int e = 0; e < 8; ++e) {
            u32x2 q; q.x = pk2(o[0][e], o[1][e]); q.y = pk2(o[2][e], o[3][e]);
            *(LAS u32x2*)(lds + (cgp * 8 + e) * 256 + r0 * 8) = q;
            if (slab < 8) { u32x2 q2; q2.x = pk2(o[0][e] * wv[0], o[1][e] * wv[1]); q2.y = pk2(o[2][e] * wv[2], o[3][e] * wv[3]);
                *(LAS u32x2*)(lds + 16384 + (cgp * 8 + e) * 256 + r0 * 8) = q2; }
        }
        __syncthreads();
        bf16_t* d1; bf16_t* d2 = nullptr; size_t rowbase;
        if (slab < 8) { d1 = WSP(bf16_t, W_XT); d2 = WSP(bf16_t, W_XWT); rowbase = (size_t)(cc * 8 + slab) * 64; }
        else { const int g = (slab - 8) >> 1, half = (slab - 8) & 1; d1 = WSP(bf16_t, W_BT); rowbase = (size_t)(cc * 2 + g) * 128 + half * 64; }
#pragma unroll
        for (int i = 0; i < 4; ++i) {
            const int id = tid + 256 * i, pr = id >> 4, scn = id & 15;
            *(u32x4*)(d1 + (rowbase + pr) * 128 + scn * 8) = *(LAS u32x4*)(lds + pr * 256 + scn * 16);
            if (slab < 8) *(u32x4*)(d2 + (rowbase + pr) * 128 + scn * 8) = *(LAS u32x4*)(lds + 16384 + pr * 256 + scn * 16);
        }
    }
    __syncthreads();
}
__device__ __forceinline__ void p2_vln(const Params& p, int item, LAS char* lds) {
    TIDV;
    const int cc = item >> 2, head = item & 3, c = cc & 15, b = cc >> 4, tok0 = cc * 128;
    const int cgp = tid & 15, r0 = tid >> 4;
    const int chb = head * 128 + cgp * 8;
    const bf16_t* vg = WSP(bf16_t, W_VG); const float* vstat = WSP(float, W_ZERO);
    float lg[8], lb[8];
#pragma unroll
    for (int e = 0; e < 8; ++e) { lg[e] = p.in[9][chb + e]; lb[e] = p.in[10][chb + e]; }
    float o[8][8];
#pragma unroll
    for (int r = 0; r < 8; ++r) {
        const int tok = tok0 + r0 * 8 + r;
        const u32x4 q = *(const u32x4*)(vg + (size_t)tok * 512 + chb);
        const float mean = vstat[(size_t)tok * 2] * (1.f / 512.f);
        const float var = vstat[(size_t)tok * 2 + 1] * (1.f / 512.f) - mean * mean;
        const float rstd = rsqrtf(fmaxf(var, 0.f) + EPS);
        const float xv[8] = {bflo(q.x), bfhi(q.x), bflo(q.y), bfhi(q.y), bflo(q.z), bfhi(q.z), bflo(q.w), bfhi(q.w)};
#pragma unroll
        for (int e = 0; e < 8; ++e) o[r][e] = (xv[e] - mean) * rstd * lg[e] + lb[e];
        if (c == 15) {
            float* go = p.out + O_GVP + ((size_t)(b * 128 + r0 * 8 + r)) * 512 + chb;
            *(f32x4*)go = (f32x4){o[r][0], o[r][1], o[r][2], o[r][3]}; *(f32x4*)(go + 4) = (f32x4){o[r][4], o[r][5], o[r][6], o[r][7]};
        }
    }
#pragma unroll
    for (int e = 0; e < 8; ++e) {
        u32x4 q; q.x = pk2(o[0][e], o[1][e]); q.y = pk2(o[2][e], o[3][e]); q.z = pk2(o[4][e], o[5][e]); q.w = pk2(o[6][e], o[7][e]);
        *(LAS u32x4*)(lds + (cgp * 8 + e) * 256 + r0 * 16) = q;
    }
    __syncthreads();
    bf16_t* dst = WSP(bf16_t, W_VLNT) + (size_t)(cc * 4 + head) * 128 * 128;
#pragma unroll
    for (int i = 0; i < 8; ++i) { const int id = tid + 256 * i, pr = id >> 4, scn = id & 15;
        *(u32x4*)(dst + (size_t)pr * 128 + scn * 8) = *(LAS u32x4*)(lds + pr * 256 + scn * 16); }
    __syncthreads();
}
__device__ __forceinline__ void p2_sample_ssd(const Params& p, int item, LAS char* lds) {
    TIDV;
    const int bs = item >> 3, h = item & 7, g = h >> 2;
    LAS float* s_x = (LAS float*)lds; LAS float* s_B = s_x + 64; LAS float* s_C = s_B + 128; LAS float* s_y = s_C + 128;
    const float* scv = p.in[3] + (size_t)bs * 3 * 1024;
    const float* xrow = p.out + O_CONVS + ((size_t)bs * 3 + 2) * 1024;
    const float* cw = p.in[13]; const float* cbp = p.in[14];
    for (int idx = tid; idx < 320; idx += 256) {
        int ch; if (idx < 64) ch = h * 64 + idx; else if (idx < 192) ch = 512 + g * 128 + (idx - 64); else ch = 768 + g * 128 + (idx - 192);
        const float v = cbp[ch] + scv[ch] * cw[ch] + scv[1024 + ch] * cw[1024 + ch] + scv[2048 + ch] * cw[2048 + ch] + xrow[ch] * cw[3072 + ch];
        s_x[idx] = silu_f(v);
    }
    __syncthreads();
    const float dt = softplus_f(WSP(float, W_DTRAW)[(size_t)(MP + bs) * 8 + h] + p.in[15][h]);
    const float dA = expf(dt * (-expf(p.in[16][h])));
    const int l = tid & 31, rg = tid >> 5;
    const f32x4 Bv = *(LAS f32x4*)(s_B + l * 4), Cv = *(LAS f32x4*)(s_C + l * 4);
    const float* h0 = p.in[2] + ((size_t)(bs * 8 + h) * 64) * 128;
    float* ho = p.out + O_SSMS + ((size_t)(bs * 8 + h) * 64) * 128;
    f32x4 hv[8];
#pragma unroll
    for (int i = 0; i < 8; ++i) hv[i] = __builtin_nontemporal_load((const f32x4*)(h0 + (size_t)(rg + 8 * i) * 128 + l * 4));
#pragma unroll
    for (int i = 0; i < 8; ++i) {
        const int pp = rg + 8 * i;
        const float dx = dt * s_x[pp];
        f32x4 hn = hv[i] * dA + Bv * dx;
        __builtin_nontemporal_store(hn, (f32x4*)(ho + (size_t)pp * 128 + l * 4));
        float y = hn[0] * Cv[0] + hn[1] * Cv[1] + hn[2] * Cv[2] + hn[3] * Cv[3];
        y += __shfl_xor(y, 16); y += __shfl_xor(y, 8); y += __shfl_xor(y, 4); y += __shfl_xor(y, 2); y += __shfl_xor(y, 1);
        if (l == 0) s_y[pp] = y;
    }
    __syncthreads();
    if (tid < 64) {
        const float xv = s_x[tid];
        const float y = s_y[tid] + p.in[17][h] * xv;
        const float z = bf2f(WSP(bf16_t, W_ZB)[(size_t)(MP + bs) * 512 + h * 64 + tid]);
        const float yz = y * silu_f(z);
        const unsigned q = pk2(yz, 0.f) & 0xffffu;
        WSP(bf16_t, W_CONCAT)[(size_t)(MP + bs) * 1024 + 512 + h * 64 + tid] = (bf16_t)q;
        const float yr = bflo(q);
        const float ssq = wave_sum(yr * yr);
        if (tid == 0) atomicAdd(WSP(float, W_ZERO) + (size_t)MT * 2 + (size_t)(MP + bs) * 2 + g, ssq);
    }
    __syncthreads();
}
__device__ __forceinline__ void p2_sample_misc(const Params& p, int bs) {
    TIDV;
    const float* vstat = WSP(float, W_ZERO);
    const int tok = MP + bs;
    const float mean = vstat[(size_t)tok * 2] * (1.f / 512.f);
    const float var = vstat[(size_t)tok * 2 + 1] * (1.f / 512.f) - mean * mean;
    const float rstd = rsqrtf(fmaxf(var, 0.f) + EPS);
    for (int ch = tid; ch < 512; ch += 256) {
        const int hd = ch >> 7;
        const float v = bf2f(WSP(bf16_t, W_VG)[(size_t)tok * 512 + ch]);
        const float vl = (v - mean) * rstd * p.in[9][ch] + p.in[10][ch];
        p.out[O_GVS + (size_t)bs * 512 + ch] = vl;
        const float u = bf2f(WSP(bf16_t, W_UB)[(size_t)tok * 512 + ch]);
        const float gout = u * (p.in[11][hd * 128 * 128] * vl + p.in[12][hd * 128]);
        WSP(bf16_t, W_CONCAT)[(size_t)tok * 1024 + ch] = (bf16_t)(pk2(gout, 0.f) & 0xffffu);
    }
    const float* scv = p.in[3] + (size_t)bs * 3 * 1024;
    float* co = p.out + O_CONVS + (size_t)bs * 3 * 1024;
    for (int i = tid; i < 2048; i += 256) co[i] = scv[1024 + i];
}
__device__ __forceinline__ void phase2(const Params& p, LAS char* lds) {
    constexpr int N1 = 1024, N2 = 2048, N3 = 512, N4 = 128;
    for (int it = VBID; it < N1 + N2 + N3 + N4; it += VGRID) {
        if (it < N1) p2_sample_ssd(p, it, lds);
        else if (it < N1 + N2) p2_conv(p, it - N1, lds);
        else if (it < N1 + N2 + N3) p2_vln(p, it - N1 - N2, lds);
        else p2_sample_misc(p, it - N1 - N2 - N3);
    }
}

__device__ __forceinline__ void p3_cb(const Params& p, int item, LAS char* lds) {
    TIDV;
    const int cc = item >> 1, g = item & 1, tok0 = cc * 128;
    f32x4 acc[4][4]; zero_acc<4>(acc);
    mma_seg<128, 0>(acc, WSP(bf16_t, W_CN) + (size_t)tok0 * 256 + g * 128, 256, WSP(bf16_t, W_BN) + (size_t)tok0 * 256 + g * 128, 256, 128, lds, nullptr);
    const int tb = wm * 64 + fr, sb = wn * 64 + fq * 4;
#pragma unroll 1
    for (int jh = 0; jh < 4; ++jh) {
        const int h = g * 4 + jh;
        const float* ac = WSP(float, W_ACUM) + (size_t)(cc * 8 + h) * 128;
        const float* dv = WSP(float, W_DTV) + (size_t)(cc * 8 + h) * 128;
        bf16_t* mt_ = WSP(bf16_t, W_MT) + (size_t)(cc * 8 + h) * 128 * 128;
        float at[4];
#pragma unroll
        for (int mi = 0; mi < 4; ++mi) at[mi] = ac[tb + mi * 16];
#pragma unroll
        for (int ni = 0; ni < 4; ++ni) {
            const f32x4 as = *(const f32x4*)(ac + sb + ni * 16), ds = *(const f32x4*)(dv + sb + ni * 16);
#pragma unroll
            for (int mi = 0; mi < 4; ++mi) {
                const int t = tb + mi * 16, s0 = sb + ni * 16;
                float v[4];
#pragma unroll
                for (int j = 0; j < 4; ++j) v[j] = (s0 + j <= t) ? acc[mi][ni][j] * __expf(at[mi] - as[j]) * ds[j] : 0.f;
                u32x2 o; o.x = pk2(v[0], v[1]); o.y = pk2(v[2], v[3]);
                *(u32x2*)(mt_ + (size_t)t * 128 + s0) = o;
            }
        }
    }
}
__device__ __forceinline__ void p3_gmlp(const Params& p, int item, LAS char* lds) {
    TIDV;
    const int cc = item >> 2, head = item & 3, tok0 = cc * 128;
    f32x4 acc[4][4]; zero_acc<4>(acc);
    mma_seg<128, 0>(acc, WSP(bf16_t, W_WSB) + (size_t)head * 128 * 128, 128, WSP(bf16_t, W_VLNT) + (size_t)(cc * 4 + head) * 128 * 128, 128, 128, lds, nullptr);
    const int tb = wm * 64 + fr, db = wn * 64 + fq * 4;
    const bf16_t* ub = WSP(bf16_t, W_UB); bf16_t* cat = WSP(bf16_t, W_CONCAT);
#pragma unroll
    for (int mi = 0; mi < 4; ++mi) {
        const int t = tb + mi * 16;
        const float bias = p.in[12][head * 128 + t];
#pragma unroll
        for (int ni = 0; ni < 4; ++ni) {
            const int d = db + ni * 16;
            const u32x2 uq = *(const u32x2*)(ub + (size_t)(tok0 + t) * 512 + head * 128 + d);
            const f32x4 a = acc[mi][ni];
            u32x2 o; o.x = pk2((a[0] + bias) * bflo(uq.x), (a[1] + bias) * bfhi(uq.x)); o.y = pk2((a[2] + bias) * bflo(uq.y), (a[3] + bias) * bfhi(uq.y));
            *(u32x2*)(cat + (size_t)(tok0 + t) * 1024 + head * 128 + d) = o;
        }
    }
}
__device__ __forceinline__ void p3_states(const Params& p, int item, LAS char* lds) {
    TIDV;
    const int cc = item >> 3, h = item & 7, g = h >> 2;
    f32x4 acc[4][2]; zero_acc<2>(acc);
    mma_seg<64, 0>(acc, WSP(bf16_t, W_BT) + (size_t)(cc * 2 + g) * 128 * 128, 128, WSP(bf16_t, W_XWT) + (size_t)(cc * 8 + h) * 64 * 128, 128, 128, lds, nullptr);
    float* sc = WSP(float, W_SC) + (size_t)(cc * 8 + h) * 64 * 128;
    const int nb = wm * 64 + fr, pb = wn * 32 + fq * 4;
#pragma unroll
    for (int mi = 0; mi < 4; ++mi)
#pragma unroll
        for (int ni = 0; ni < 2; ++ni)
#pragma unroll
            for (int j = 0; j < 4; ++j) sc[(size_t)(pb + ni * 16 + j) * 128 + nb + mi * 16] = acc[mi][ni][j];
}
__device__ __forceinline__ void phase3(const Params& p, LAS char* lds) {
    constexpr int N1 = 256, N2 = 512, N3 = 1024;
    for (int it = VBID; it < N1 + N2 + N3; it += VGRID) {
        if (it < N1) p3_cb(p, it, lds);
        else if (it < N1 + N2) p3_gmlp(p, it - N1, lds);
        else p3_states(p, it - N1 - N2, lds);
    }
}

__device__ __forceinline__ void phase4(const Params& p) {
    for (int it = VBID; it < 512; it += VGRID) {
        const int idx4 = it * 256 + VTID;
        const int bh = idx4 >> 11, rem = (idx4 & 2047) * 4, b = bh >> 3, h = bh & 7;
        const float* sc = WSP(float, W_SC); bf16_t* hp_ = WSP(bf16_t, W_HPREV); const float* ac = WSP(float, W_ACUM);
        f32x4 sv[16]; float dec[16];
#pragma unroll
        for (int c = 0; c < 16; ++c) {
            sv[c] = *(const f32x4*)(sc + ((size_t)((b * 16 + c) * 8 + h)) * 8192 + rem);
            dec[c] = ac[(size_t)((b * 16 + c) * 8 + h) * 128 + 127];
        }
        f32x4 st = {0.f, 0.f, 0.f, 0.f};
#pragma unroll
        for (int c = 0; c < 16; ++c) {
            const size_t base = ((size_t)((b * 16 + c) * 8 + h)) * 8192 + rem;
            u32x2 o; o.x = pk2(st[0], st[1]); o.y = pk2(st[2], st[3]);
            *(u32x2*)(hp_ + base) = o;
            st = st * __expf(dec[c]) + sv[c];
        }
        *(f32x4*)(p.out + O_SSMP + (size_t)idx4 * 4) = st;
    }
}

__device__ __forceinline__ void p5_y(const Params& p, int item, LAS char* lds) {
    TIDV;
    const int cc = item >> 3, h = item & 7, g = h >> 2, tok0 = cc * 128;
    f32x4 acc[4][2]; zero_acc<2>(acc);
    mma_seg<64, 0>(acc, WSP(bf16_t, W_CN) + (size_t)tok0 * 256 + g * 128, 256, WSP(bf16_t, W_HPREV) + (size_t)(cc * 8 + h) * 64 * 128, 128, 128, lds, nullptr);
    const float* ac = WSP(float, W_ACUM) + (size_t)(cc * 8 + h) * 128;
    const int tb = wm * 64 + fr, pb = wn * 32 + fq * 4;
#pragma unroll
    for (int mi = 0; mi < 4; ++mi) { const float e = __expf(ac[tb + mi * 16]);
#pragma unroll
        for (int ni = 0; ni < 2; ++ni) acc[mi][ni] = acc[mi][ni] * e; }
    mma_seg<64, 0>(acc, WSP(bf16_t, W_MT) + (size_t)(cc * 8 + h) * 128 * 128, 128, WSP(bf16_t, W_XT) + (size_t)(cc * 8 + h) * 64 * 128, 128, 128, lds, nullptr);
    const float dsk = p.in[17][h];
    const bf16_t* xn = WSP(bf16_t, W_XN); const bf16_t* zb = WSP(bf16_t, W_ZB); bf16_t* cat = WSP(bf16_t, W_CONCAT);
    float* gss = WSP(float, W_ZERO) + (size_t)MT * 2;
#pragma unroll
    for (int mi = 0; mi < 4; ++mi) {
        const int tok = tok0 + tb + mi * 16;
        float ssq = 0.f;
#pragma unroll
        for (int ni = 0; ni < 2; ++ni) {
            const int pc = h * 64 + pb + ni * 16;
            const u32x2 xq = *(const u32x2*)(xn + (size_t)tok * 512 + pc), zq = *(const u32x2*)(zb + (size_t)tok * 512 + pc);
            const f32x4 a = acc[mi][ni];
            const float y0 = (a[0] + dsk * bflo(xq.x)) * silu_f(bflo(zq.x)), y1 = (a[1] + dsk * bfhi(xq.x)) * silu_f(bfhi(zq.x));
            const float y2 = (a[2] + dsk * bflo(xq.y)) * silu_f(bflo(zq.y)), y3 = (a[3] + dsk * bfhi(xq.y)) * silu_f(bfhi(zq.y));
            u32x2 o; o.x = pk2(y0, y1); o.y = pk2(y2, y3);
            const float r0 = bflo(o.x), r1 = bfhi(o.x), r2 = bflo(o.y), r3 = bfhi(o.y);
            ssq += (r0 * r0 + r1 * r1) + (r2 * r2 + r3 * r3);
            *(u32x2*)(cat + (size_t)tok * 1024 + 512 + pc) = o;
        }
        ssq = fq_sum(ssq);
        if (fq == 0) atomicAdd(gss + (size_t)tok * 2 + g, ssq);
    }
}
__device__ __forceinline__ void phase5(const Params& p, LAS char* lds) {
    for (int it = VBID; it < 1024; it += VGRID) p5_y(p, it, lds);
}

template <int MODE, int NI>
__device__ __forceinline__ void res_epi(const Params& p, f32x4 (&acc)[4][NI], const int rbw, const int cbw) {
    TIDV;
    const int rb = rbw + fr, cb = cbw + fq * 4;
    float* hp = WSP(float, W_HP); bf16_t* hpb = WSP(bf16_t, W_HPB);
    float* ssq_ = WSP(float, W_ZERO) + (size_t)MT * 4 + (size_t)MT * MODE;
#pragma unroll
    for (int mi = 0; mi < 4; ++mi) {
        const int row = rb + mi * 16;
        const float* rsrc;
        if (MODE == 0) rsrc = row < MP ? p.in[0] + (size_t)row * 1024 : p.in[1] + (size_t)(row - MP) * 1024;
        else rsrc = hp + (size_t)row * 1024;
        float ssq = 0.f;
#pragma unroll
        for (int ni = 0; ni < NI; ++ni) {
            const int col = cb + ni * 16;
            const f32x4 r = *(const f32x4*)(rsrc + col);
            const f32x4 v = acc[mi][ni] + r;
            *(f32x4*)(hp + (size_t)row * 1024 + col) = v;
            ssq += (v[0] * v[0] + v[1] * v[1]) + (v[2] * v[2] + v[3] * v[3]);
            if (MODE != 2) { u32x2 o; o.x = pk2(v[0], v[1]); o.y = pk2(v[2], v[3]); *(u32x2*)(hpb + (size_t)row * 1024 + col) = o; }
        }
        if (MODE != 2) { ssq = fq_sum(ssq); if (fq == 0) atomicAdd(ssq_ + row, ssq); }
    }
}
template <int MODE>
__device__ __forceinline__ void phase_res(const Params& p, LAS char* lds, LAS char* ldsh) {
    W8V;
    const int lane_ = RTID & 63, fr_ = lane_ & 15;
    int t;
    for (int i = 0; (t = sched256(i, 64 * 4)) >= 0; ++i) {
        int mp, nt; tile_mn(t, 64, 4, mp, nt);
        f32x4 acc0[4][4], acc1[4][4]; zero_acc<4>(acc0); zero_acc<4>(acc1);
        const int rb0 = mp * 256 + wm2_ * 128, cbw = nt * 256 + wn4_ * 64;
        if (MODE == 0) {
            const bf16_t* Ab = WSP(bf16_t, W_CONCAT) + (size_t)mp * 256 * 1024; const bf16_t* Wb = WSP(bf16_t, W_WOUT) + (size_t)nt * 256 * 1024;
            const float* gss = WSP(float, W_ZERO) + (size_t)MT * 2;
            mma256(acc0, acc1, Ab + 512, 1024, Wb + 512, 1024, 256, lds);
#pragma unroll
            for (int mi = 0; mi < 4; ++mi) { const int ra = rb0 + mi * 16 + fr_, rbb = ra + 64;
                const float fa = rsqrtf(gss[(size_t)ra * 2] * (1.f / 256.f) + EPS) / rsqrtf(gss[(size_t)ra * 2 + 1] * (1.f / 256.f) + EPS);
                const float fb = rsqrtf(gss[(size_t)rbb * 2] * (1.f / 256.f) + EPS) / rsqrtf(gss[(size_t)rbb * 2 + 1] * (1.f / 256.f) + EPS);
#pragma unroll
                for (int ni = 0; ni < 4; ++ni) { acc0[mi][ni] = acc0[mi][ni] * fa; acc1[mi][ni] = acc1[mi][ni] * fb; } }
            mma256(acc0, acc1, Ab + 768, 1024, Wb + 768, 1024, 256, lds);
#pragma unroll
            for (int mi = 0; mi < 4; ++mi) { const int ra = rb0 + mi * 16 + fr_, rbb = ra + 64;
                const float r1a = rsqrtf(gss[(size_t)ra * 2 + 1] * (1.f / 256.f) + EPS), r1b = rsqrtf(gss[(size_t)rbb * 2 + 1] * (1.f / 256.f) + EPS);
#pragma unroll
                for (int ni = 0; ni < 4; ++ni) { acc0[mi][ni] = acc0[mi][ni] * r1a; acc1[mi][ni] = acc1[mi][ni] * r1b; } }
            mma256(acc0, acc1, Ab, 1024, Wb, 1024, 512, lds);
        } else if (MODE == 1) {
            mma256(acc0, acc1, WSP(bf16_t, W_OB) + (size_t)mp * 256 * 1024, 1024, WSP(bf16_t, W_WXO) + (size_t)nt * 256 * 1024, 1024, 1024, lds);
        } else {
            mma256(acc0, acc1, WSP(bf16_t, W_ACT) + (size_t)mp * 256 * 2816, 2816, WSP(bf16_t, W_WD) + (size_t)nt * 256 * 2816, 2816, 2816, lds);
        }
        res_epi<MODE, 4>(p, acc0, rb0, cbw); res_epi<MODE, 4>(p, acc1, rb0 + 64, cbw);
    }
    const int wv_ = __builtin_amdgcn_readfirstlane(VTID >> 6), wmv = wv_ >> 1, wnv = wv_ & 1, lanev = VTID & 63, frv = lanev & 15, fqv = lanev >> 4;
    if (MODE != 2) {
        if (RBID < 4) {
            const int j = RBID * 2 + half_, n0 = j * 128;
            f32x4 acc[4][4]; zero_acc<4>(acc);
            if (MODE == 0) {
                const bf16_t* Ab = WSP(bf16_t, W_CONCAT) + (size_t)MP * 1024; const bf16_t* Wb = WSP(bf16_t, W_WOUT) + (size_t)n0 * 1024;
                const float* gss = WSP(float, W_ZERO) + (size_t)MT * 2;
                float r0[4], r1[4];
#pragma unroll
                for (int mi = 0; mi < 4; ++mi) { const int row = MP + wmv * 64 + mi * 16 + frv;
                    r0[mi] = rsqrtf(gss[(size_t)row * 2] * (1.f / 256.f) + EPS); r1[mi] = rsqrtf(gss[(size_t)row * 2 + 1] * (1.f / 256.f) + EPS); }
                mma_seg<128, 0>(acc, Ab + 512, 1024, Wb + 512, 1024, 256, ldsh, nullptr);
#pragma unroll
                for (int mi = 0; mi < 4; ++mi) { const float f = r0[mi] / r1[mi];
#pragma unroll
                    for (int ni = 0; ni < 4; ++ni) acc[mi][ni] = acc[mi][ni] * f; }
                mma_seg<128, 0>(acc, Ab + 768, 1024, Wb + 768, 1024, 256, ldsh, nullptr);
#pragma unroll
                for (int mi = 0; mi < 4; ++mi)
#pragma unroll
                    for (int ni = 0; ni < 4; ++ni) acc[mi][ni] = acc[mi][ni] * r1[mi];
                mma_seg<128, 0>(acc, Ab, 1024, Wb, 1024, 512, ldsh, nullptr);
            } else {
                mma_seg<128, 0>(acc, WSP(bf16_t, W_OB) + (size_t)MP * 1024, 1024, WSP(bf16_t, W_WXO) + (size_t)n0 * 1024, 1024, 1024, ldsh, nullptr);
            }
            res_epi<MODE, 4>(p, acc, MP + wmv * 64, n0 + wnv * 64);
        }
    } else {
        if (RBID < 16) {
            const int j = RBID * 2 + half_, nt = j & 7, ks = j >> 3, n0 = nt * 128;
            f32x4 acc[4][4]; zero_acc<4>(acc);
            mma_seg<128, 0>(acc, WSP(bf16_t, W_ACT) + (size_t)MP * 2816 + ks * 704, 2816, WSP(bf16_t, W_WD) + (size_t)n0 * 2816 + ks * 704, 2816, 704, ldsh, nullptr);
            float* hp = WSP(float, W_HP);
            const int rb = MP + wmv * 64 + frv, cb = n0 + wnv * 64 + fqv * 4;
#pragma unroll
            for (int mi = 0; mi < 4; ++mi)
#pragma unroll
                for (int ni = 0; ni < 4; ++ni)
#pragma unroll
                    for (int jj = 0; jj < 4; ++jj) atomicAdd(hp + (size_t)(rb + mi * 16) * 1024 + cb + ni * 16 + jj, acc[mi][ni][jj]);
        }
    }
}

template <int NI>
__device__ __forceinline__ void p7_epi(const Params& p, f32x4 (&acc)[4][NI], const int rbw, const int cbw) {
    TIDV;
    const int rb = rbw + fr, cb = cbw + fq * 4;
    const float* ss1 = WSP(float, W_ZERO) + (size_t)MT * 4;
    bf16_t* qb = WSP(bf16_t, W_QB);
#pragma unroll
    for (int mi = 0; mi < 4; ++mi) {
        const int row = rb + mi * 16;
        const float rs = rsqrtf(ss1[row] * (1.f / 1024.f) + EPS);
#pragma unroll
        for (int ni = 0; ni < NI; ++ni) { const f32x4 a = acc[mi][ni] * rs; u32x2 o; o.x = pk2(a[0], a[1]); o.y = pk2(a[2], a[3]);
            *(u32x2*)(qb + (size_t)row * 1024 + cb + ni * 16) = o; }
    }
}
__device__ __forceinline__ void phase7(const Params& p, LAS char* lds, LAS char* ldsh) {
    W8V;
    int t;
    for (int i = 0; (t = sched256(i, 64 * 4)) >= 0; ++i) {
        int mp, nt; tile_mn(t, 64, 4, mp, nt);
        f32x4 acc0[4][4], acc1[4][4]; zero_acc<4>(acc0); zero_acc<4>(acc1);
        mma256(acc0, acc1, WSP(bf16_t, W_HPB) + (size_t)mp * 256 * 1024, 1024, WSP(bf16_t, W_WQ) + (size_t)nt * 256 * 1024, 1024, 1024, lds);
        const int rb0 = mp * 256 + wm2_ * 128, cbw = nt * 256 + wn4_ * 64;
        p7_epi<4>(p, acc0, rb0, cbw); p7_epi<4>(p, acc1, rb0 + 64, cbw);
    }
    if (RBID < 4) {
        const int j = RBID * 2 + half_, n0 = j * 128;
        const int wv_ = __builtin_amdgcn_readfirstlane(VTID >> 6), wmv = wv_ >> 1, wnv = wv_ & 1;
        f32x4 acc[4][4]; zero_acc<4>(acc);
        mma_seg<128, 0>(acc, WSP(bf16_t, W_HPB) + (size_t)MP * 1024, 1024, WSP(bf16_t, W_WQ) + (size_t)n0 * 1024, 1024, 1024, ldsh, nullptr);
        p7_epi<4>(p, acc, MP + wmv * 64, n0 + wnv * 64);
    }
}

__device__ __forceinline__ void p8_prompt(const Params& p, int item, LAS char* lds) {
    TIDV;
    const int qt = item & 15, head = (item >> 4) & 3, b = item >> 6;
    const int tokq = b * 2048 + qt * 128;
    const bf16_t* qa = WSP(bf16_t, W_QB) + (size_t)tokq * 1024 + head * 256;
    const bf16_t* kbp = WSP(bf16_t, W_KB) + (size_t)(b * 256) * 1024 + head * 256;
    f32x4 s0[4][4], s1[4][4]; zero_acc<4>(s0); zero_acc<4>(s1);
    mma_seg<128, 0>(s0, qa, 1024, kbp, 1024, 256, lds, nullptr);
    mma_seg<128, 0>(s1, qa, 1024, kbp + (size_t)128 * 1024, 1024, 256, lds, nullptr);
    LAS float* red = (LAS float*)(lds + (LDS_MISC + 64) - __builtin_amdgcn_readfirstlane(RTID >> 8) * 61440);
    float rinv[4];
    float mx[4];
#pragma unroll
    for (int mi = 0; mi < 4; ++mi) {
        float m = -3.0e38f;
#pragma unroll
        for (int ni = 0; ni < 4; ++ni)
#pragma unroll
            for (int j = 0; j < 4; ++j) m = fmaxf(m, fmaxf(s0[mi][ni][j], s1[mi][ni][j]));
        m = fq_max(m);
        if (fq == 0) red[wn * 128 + wm * 64 + mi * 16 + fr] = m;
        mx[mi] = m;
    }
    __syncthreads();
#pragma unroll
    for (int mi = 0; mi < 4; ++mi) mx[mi] = fmaxf(mx[mi], red[(wn ^ 1) * 128 + wm * 64 + mi * 16 + fr]);
#pragma unroll
    for (int mi = 0; mi < 4; ++mi) {
        float sum = 0.f;
        const int t = wm * 64 + mi * 16 + fr;
#pragma unroll
        for (int ni = 0; ni < 4; ++ni) {
            const int mcol = wn * 64 + ni * 16 + fq * 4;
            u32x2 o0, o1;
            o0.x = pk2(__expf(s0[mi][ni][0] - mx[mi]), __expf(s0[mi][ni][1] - mx[mi])); o0.y = pk2(__expf(s0[mi][ni][2] - mx[mi]), __expf(s0[mi][ni][3] - mx[mi]));
            o1.x = pk2(__expf(s1[mi][ni][0] - mx[mi]), __expf(s1[mi][ni][1] - mx[mi])); o1.y = pk2(__expf(s1[mi][ni][2] - mx[mi]), __expf(s1[mi][ni][3] - mx[mi]));
            sum += (bflo(o0.x) + bfhi(o0.x)) + (bflo(o0.y) + bfhi(o0.y)) + (bflo(o1.x) + bfhi(o1.x)) + (bflo(o1.y) + bfhi(o1.y));
            const int c0 = mcol >> 3, c1 = (mcol + 128) >> 3, sub = (mcol & 7) * 2;
            *(LAS u32x2*)(lds + t * 512 + ((c0 ^ (t & 15)) << 4) + sub) = o0;
            *(LAS u32x2*)(lds + t * 512 + ((c1 ^ (t & 15)) << 4) + sub) = o1;
        }
        sum = fq_sum(sum);
        if (fq == 0) red[256 + wn * 128 + t] = sum;
        rinv[mi] = sum;
        __builtin_amdgcn_sched_barrier(0);
    }
    __syncthreads();
#pragma unroll
    for (int mi = 0; mi < 4; ++mi) rinv[mi] = 1.f / (rinv[mi] + red[256 + (wn ^ 1) * 128 + wm * 64 + mi * 16 + fr]);
    const bf16_t* vtp = WSP(bf16_t, W_VT) + (size_t)(b * 4 + head) * 256 * 256;
    bf16_t* ob = WSP(bf16_t, W_OB);
#pragma unroll 1
    for (int nn = 0; nn < 2; ++nn) {
        f32x4 acc[4][4]; zero_acc<4>(acc);
        const bf16_t* vb = vtp + (size_t)(nn * 128 + wn * 64 + fr) * 256 + fq * 8;
        bf16x8 bcur[4], bnxt[4];
#pragma unroll
        for (int ni = 0; ni < 4; ++ni) bcur[ni] = *(const bf16x8*)(vb + (size_t)(ni * 16) * 256);
#pragma unroll 1
        for (int kk = 0; kk < 8; ++kk) {
            if (kk + 1 < 8) {
#pragma unroll
                for (int ni = 0; ni < 4; ++ni) bnxt[ni] = *(const bf16x8*)(vb + (size_t)(ni * 16) * 256 + (kk + 1) * 32);
            }
            bf16x8 af[4];
#pragma unroll
            for (int mi = 0; mi < 4; ++mi) { const int t = wm * 64 + mi * 16 + fr; af[mi] = *(LAS bf16x8*)(lds + t * 512 + (((kk * 4 + fq) ^ (t & 15)) << 4)); }
#pragma unroll
            for (int mi = 0; mi < 4; ++mi)
#pragma unroll
                for (int ni = 0; ni < 4; ++ni) acc[mi][ni] = __builtin_amdgcn_mfma_f32_16x16x32_bf16(bcur[ni], af[mi], acc[mi][ni], 0, 0, 0);
            if (kk + 1 < 8) {
#pragma unroll
                for (int ni = 0; ni < 4; ++ni) bcur[ni] = bnxt[ni];
            }
        }
#pragma unroll
        for (int mi = 0; mi < 4; ++mi)
#pragma unroll
            for (int ni = 0; ni < 4; ++ni) { const f32x4 a = acc[mi][ni] * rinv[mi]; u32x2 o; o.x = pk2(a[0], a[1]); o.y = pk2(a[2], a[3]);
                *(u32x2*)(ob + (size_t)(tokq + wm * 64 + mi * 16 + fr) * 1024 + head * 256 + nn * 128 + wn * 64 + ni * 16 + fq * 4) = o; }
    }
    __syncthreads();
}
__device__ __forceinline__ void p8_sample(const Params& p, int item, LAS char* lds) {
    TIDV;
    const int bs = item >> 2, head = item & 3;
    LAS float* s_q = (LAS float*)lds; LAS float* s_sc = s_q + 256; LAS float* s_red = s_sc + 256; LAS float* s_part = s_red + 16;
    s_q[tid] = bf2f(WSP(bf16_t, W_QB)[(size_t)(MP + bs) * 1024 + head * 256 + tid]);
    __syncthreads();
    const f32x4 qv = *(LAS f32x4*)(s_q + lane * 4);
    const float* kc = p.in[4] + ((size_t)(bs * 256) * 4 + head) * 256 + lane * 4;
    const float* vc = p.in[5] + ((size_t)(bs * 256) * 4 + head) * 256 + lane * 4;
#pragma unroll 1
    for (int i = 0; i < 64; i += 16) {
        f32x4 kv[16];
#pragma unroll
        for (int u = 0; u < 16; ++u) kv[u] = __builtin_nontemporal_load((const f32x4*)(kc + (size_t)(wid * 64 + i + u) * 1024));
#pragma unroll
        for (int u = 0; u < 16; ++u) { float d = kv[u][0] * qv[0] + kv[u][1] * qv[1] + kv[u][2] * qv[2] + kv[u][3] * qv[3]; d = wave_sum(d); if (lane == 0) s_sc[wid * 64 + i + u] = d; }
    }
    __syncthreads();
    const float sv = s_sc[tid];
    float m = wave_max(sv);
    if (lane == 0) s_red[wid] = m;
    __syncthreads();
    m = fmaxf(fmaxf(s_red[0], s_red[1]), fmaxf(s_red[2], s_red[3]));
    const float e = __expf(sv - m);
    float sm = wave_sum(e);
    if (lane == 0) s_red[4 + wid] = sm;
    s_sc[tid] = e;
    __syncthreads();
    const float inv = 1.f / ((s_red[4] + s_red[5]) + (s_red[6] + s_red[7]));
    f32x4 o = {0.f, 0.f, 0.f, 0.f};
#pragma unroll 1
    for (int i = 0; i < 64; i += 16) {
        f32x4 vv[16];
#pragma unroll
        for (int u = 0; u < 16; ++u) vv[u] = __builtin_nontemporal_load((const f32x4*)(vc + (size_t)(wid * 64 + i + u) * 1024));
#pragma unroll
        for (int u = 0; u < 16; ++u) o = o + vv[u] * s_sc[wid * 64 + i + u];
    }
    *(LAS f32x4*)(s_part + wid * 256 + lane * 4) = o;
    __syncthreads();
    const float r = ((s_part[tid] + s_part[256 + tid]) + (s_part[512 + tid] + s_part[768 + tid])) * inv;
    WSP(bf16_t, W_OB)[(size_t)(MP + bs) * 1024 + head * 256 + tid] = (bf16_t)(pk2(r, 0.f) & 0xffffu);
    __syncthreads();
}
__device__ __forceinline__ void phase8(const Params& p, LAS char* lds) {
    const int flip = (RBID ^ (RBID >> 7)) & 1;
    for (int j = 0; j < 2; ++j) {
        for (int it = VBID + ((j ^ flip) ? 512 : 0); it < ((j ^ flip) ? 1024 : 512); it += VGRID) {
            if (it < 512) p8_sample(p, it, lds); else p8_prompt(p, it - 512, lds);
        }
    }
}

template <int NI>
__device__ __forceinline__ void p10_epi(const Params& p, f32x4 (&acc)[4][NI], const int rbw, const int cbw) {
    TIDV;
    const int rb = rbw + fr, cb = cbw / 2 + fq * 4;
    const float* ss2 = WSP(float, W_ZERO) + (size_t)MT * 5;
    bf16_t* act = WSP(bf16_t, W_ACT);
#pragma unroll
    for (int mi = 0; mi < 4; ++mi) {
        const int row = rb + mi * 16;
        const float rs = rsqrtf(ss2[row] * (1.f / 1024.f) + EPS);
#pragma unroll
        for (int q = 0; q < NI / 2; ++q) {
            const f32x4 g = acc[mi][2 * q] * rs, u = acc[mi][2 * q + 1] * rs;
            u32x2 o; o.x = pk2(silu_f(g[0]) * u[0], silu_f(g[1]) * u[1]); o.y = pk2(silu_f(g[2]) * u[2], silu_f(g[3]) * u[3]);
            *(u32x2*)(act + (size_t)row * 2816 + cb + q * 16) = o;
        }
    }
}
__device__ __forceinline__ void phase10(const Params& p, LAS char* lds, LAS char* ldsh) {
    W8V;
    int t;
    for (int i = 0; (t = sched256(i, 64 * 22)) >= 0; ++i) {
        int mp, nt; tile_mn(t, 64, 22, mp, nt);
        f32x4 acc0[4][4], acc1[4][4]; zero_acc<4>(acc0); zero_acc<4>(acc1);
        mma256(acc0, acc1, WSP(bf16_t, W_HPB) + (size_t)mp * 256 * 1024, 1024, WSP(bf16_t, W_WGU) + (size_t)nt * 256 * 1024, 1024, 1024, lds);
        const int rb0 = mp * 256 + wm2_ * 128, cbw = nt * 256 + wn4_ * 64;
        p10_epi<4>(p, acc0, rb0, cbw); p10_epi<4>(p, acc1, rb0 + 64, cbw);
    }
    if (RBID >= 128 && RBID < 150) {
        const int j = (RBID - 128) * 2 + half_, n0 = j * 128;
        const int wv_ = __builtin_amdgcn_readfirstlane(VTID >> 6), wmv = wv_ >> 1, wnv = wv_ & 1;
        f32x4 acc[4][4]; zero_acc<4>(acc);
        mma_seg<128, 0>(acc, WSP(bf16_t, W_HPB) + (size_t)MP * 1024, 1024, WSP(bf16_t, W_WGU) + (size_t)n0 * 1024, 1024, 1024, ldsh, nullptr);
        p10_epi<4>(p, acc, MP + wmv * 64, n0 + wnv * 64);
    }
}

__device__ __forceinline__ void phase12(const Params& p) {
    const float* hp = WSP(float, W_HP); const float* g = p.in[30];
    const int lane = VTID & 63, wid = VTID >> 6;
    for (int it = VBID; it < MT / 4; it += VGRID) {
        const int row = it * 4 + wid;
        const float* src = hp + (size_t)row * 1024;
        f32x4 v[4]; float ss = 0.f;
#pragma unroll
        for (int j = 0; j < 4; ++j) { v[j] = __builtin_nontemporal_load((const f32x4*)(src + (j * 64 + lane) * 4)); ss += (v[j][0] * v[j][0] + v[j][1] * v[j][1]) + (v[j][2] * v[j][2] + v[j][3] * v[j][3]); }
        const float rs = rsqrtf(wave_sum(ss) * (1.f / 1024.f) + EPS);
#pragma unroll
        for (int j = 0; j < 4; ++j) { const f32x4 gv = *(const f32x4*)(g + (j * 64 + lane) * 4);
            __builtin_nontemporal_store(v[j] * rs * gv, (f32x4*)(p.out + (size_t)row * 1024 + (j * 64 + lane) * 4)); }
    }
}

#ifndef DUMP_SEL
#define DUMP_SEL 0
#endif
__device__ __forceinline__ void phase_dump(const Params& p) {
    const int n = MT * 1024;
    for (int i = VBID * 256 + VTID; i < n; i += VGRID * 256) {
        float v = 0.f;
        if (DUMP_SEL == 1) v = bf2f(WSP(bf16_t, W_CONCAT)[i]);
        else if (DUMP_SEL == 2) v = WSP(float, W_HP)[i];
        else if (DUMP_SEL == 3) v = bf2f(WSP(bf16_t, W_QB)[i]);
        else if (DUMP_SEL == 4) v = bf2f(WSP(bf16_t, W_OB)[i]);
        else if (DUMP_SEL == 5) v = bf2f(WSP(bf16_t, W_HPB)[i]);
        else if (DUMP_SEL == 6) v = bf2f(WSP(bf16_t, W_ACT)[(size_t)(i >> 10) * 2816 + (i & 1023)]);
        p.out[i] = v;
    }
}
__device__ __forceinline__ bool single64_splitk(f32x4 (&acc)[4][2], const bf16_t* A, const int lda, const bf16_t* Bt, const int ldb, const int K, LAS char* lds, LAS char* ldsh, const int half) {
    zero_acc<2>(acc);
    const int kh = K >> 1;
    mma_seg<64, 0>(acc, A + half * kh, lda, Bt + half * kh, ldb, kh, ldsh, nullptr);
    LAS f32x4* xch = (LAS f32x4*)(lds + 65536);
    if (half == 1) {
#pragma unroll
        for (int mi = 0; mi < 4; ++mi)
#pragma unroll
            for (int ni = 0; ni < 2; ++ni) xch[(mi * 2 + ni) * 256 + VTID] = acc[mi][ni];
    }
    __syncthreads();
    if (half == 0) {
#pragma unroll
        for (int mi = 0; mi < 4; ++mi)
#pragma unroll
            for (int ni = 0; ni < 2; ++ni) acc[mi][ni] = acc[mi][ni] + xch[(mi * 2 + ni) * 256 + VTID];
    }
    return half == 0;
}
struct Sched256 {
    int T, NMt, NNt;
    __device__ __forceinline__ bool next(int i, pg8::Unit& u) const { const int t = sched256(i, T); if (t < 0) return false; int mp, nt; tile_mn(t, NMt, NNt, mp, nt); u.pm = mp; u.pn = nt; return true; }
    __device__ __forceinline__ void a_ready(const pg8::Unit&) const {}
    __device__ __forceinline__ void done(const pg8::Unit&) const {}
};
struct SchedMemkv {
    __device__ __forceinline__ bool next(int i, pg8::Unit& u) const { const int idx = RBID - (RGRID - 64); if (i != 0 || idx < 0) return false; u.pm = idx & 7; u.pn = idx >> 3; return true; }
    __device__ __forceinline__ void a_ready(const pg8::Unit&) const {}
    __device__ __forceinline__ void done(const pg8::Unit&) const {}
};
#define PG8_EPI_LOOP(CALL) _Pragma("unroll") for (int ai = 0; ai < 2; ++ai) _Pragma("unroll") for (int bj = 0; bj < 2; ++bj) { const int rbw = u.pm * 256 + ai * 128 + wr * 64, cbw = u.pn * 256 + bj * 128 + wc * 32; CALL; }
struct EpiInproj { static constexpr bool PERM = false, AFTER_DRAIN = false; const Params* pp;
    __device__ __forceinline__ void operator()(f32x4 (&acc)[2][2][4][2], const pg8::Unit& u, int wr, int wc, int, int) const { const Params& p = *pp; PG8_EPI_LOOP(p1_inproj_epi<2>(p, acc[ai][bj], rbw, cbw)) } };
struct EpiMemkv { static constexpr bool PERM = false, AFTER_DRAIN = false; const Params* pp;
    __device__ __forceinline__ void operator()(f32x4 (&acc)[2][2][4][2], const pg8::Unit& u, int wr, int wc, int, int) const { const Params& p = *pp; PG8_EPI_LOOP(p1_memkv_epi<2>(p, acc[ai][bj], rbw, cbw)) } };
struct EpiQ { static constexpr bool PERM = false, AFTER_DRAIN = false; const Params* pp;
    __device__ __forceinline__ void operator()(f32x4 (&acc)[2][2][4][2], const pg8::Unit& u, int wr, int wc, int, int) const { const Params& p = *pp; PG8_EPI_LOOP(p7_epi<2>(p, acc[ai][bj], rbw, cbw)) } };
struct EpiGU { static constexpr bool PERM = false, AFTER_DRAIN = false; const Params* pp;
    __device__ __forceinline__ void operator()(f32x4 (&acc)[2][2][4][2], const pg8::Unit& u, int wr, int wc, int, int) const { const Params& p = *pp; PG8_EPI_LOOP(p10_epi<2>(p, acc[ai][bj], rbw, cbw)) } };
template <int MODE> struct EpiRes { static constexpr bool PERM = false, AFTER_DRAIN = false; const Params* pp;
    __device__ __forceinline__ void operator()(f32x4 (&acc)[2][2][4][2], const pg8::Unit& u, int wr, int wc, int, int) const { const Params& p = *pp; PG8_EPI_LOOP((res_epi<MODE, 2>(p, acc[ai][bj], rbw, cbw))) } };

__device__ __forceinline__ void phase1_g8(const Params& p, LAS char* lds, LAS char* ldsh) {
    W8V;
    pg8::Gemm g1{WSP(bf16_t, W_XB), WSP(bf16_t, W_WIN), MP, 2816, 1024};
    pg8::gemm_phase<EpiInproj, Sched256, false>((PG8_LAS unsigned char*)lds, g1, Sched256{64 * 11, 64, 11}, EpiInproj{&p}, nullptr);
    pg8::Gemm g2{WSP(bf16_t, W_MEMB), WSP(bf16_t, W_WKV), 2048, 2048, 1024};
    pg8::gemm_phase<EpiMemkv, SchedMemkv, false>((PG8_LAS unsigned char*)lds, g2, SchedMemkv{}, EpiMemkv{&p}, nullptr);
    if (RBID < 42) {
        const int n0 = RBID * 64;
        const int wv_ = __builtin_amdgcn_readfirstlane(VTID >> 6), wmv = wv_ >> 1, wnv = wv_ & 1;
        f32x4 acc[4][2];
        if (single64_splitk(acc, WSP(bf16_t, W_XB) + (size_t)MP * 1024, 1024, WSP(bf16_t, W_WIN) + (size_t)n0 * 1024, 1024, 1024, lds, ldsh, half_)) p1_inproj_epi<2>(p, acc, MP + wmv * 64, n0 + wnv * 32);
    }
}
__device__ __forceinline__ void phase5b(const Params& p) {
    const int lane = VTID & 63, wid = __builtin_amdgcn_readfirstlane(VTID >> 6);
    const float* gss = WSP(float, W_ZERO) + (size_t)MT * 2;
    bf16_t* cat = WSP(bf16_t, W_CONCAT);
    for (int it = VBID; it < MT / 4; it += VGRID) {
        const int row = it * 4 + wid;
        const float rs = rsqrtf(gss[(size_t)row * 2 + (lane >> 5)] * (1.f / 256.f) + EPS);
        u32x4* ptr = (u32x4*)(cat + (size_t)row * 1024 + 512 + lane * 8);
        *ptr = scale8(*ptr, rs);
    }
}
__device__ __forceinline__ void phase6_g8(const Params& p, LAS char* lds, LAS char* ldsh) {
    W8V;
    pg8::Gemm g{WSP(bf16_t, W_CONCAT), WSP(bf16_t, W_WOUT), MP, 1024, 1024};
    pg8::gemm_phase<EpiRes<0>, Sched256, false>((PG8_LAS unsigned char*)lds, g, Sched256{64 * 4, 64, 4}, EpiRes<0>{&p}, nullptr);
    if (RBID < 16) {
        const int n0 = RBID * 64;
        const int wv_ = __builtin_amdgcn_readfirstlane(VTID >> 6), wmv = wv_ >> 1, wnv = wv_ & 1;
        f32x4 acc[4][2];
        if (single64_splitk(acc, WSP(bf16_t, W_CONCAT) + (size_t)MP * 1024, 1024, WSP(bf16_t, W_WOUT) + (size_t)n0 * 1024, 1024, 1024, lds, ldsh, half_)) res_epi<0, 2>(p, acc, MP + wmv * 64, n0 + wnv * 32);
    }
}
__device__ __forceinline__ void phase7_g8(const Params& p, LAS char* lds, LAS char* ldsh) {
    W8V;
    pg8::Gemm g{WSP(bf16_t, W_HPB), WSP(bf16_t, W_WQ), MP, 1024, 1024};
    pg8::gemm_phase<EpiQ, Sched256, false>((PG8_LAS unsigned char*)lds, g, Sched256{64 * 4, 64, 4}, EpiQ{&p}, nullptr);
    if (RBID < 16) {
        const int n0 = RBID * 64;
        const int wv_ = __builtin_amdgcn_readfirstlane(VTID >> 6), wmv = wv_ >> 1, wnv = wv_ & 1;
        f32x4 acc[4][2];
        if (single64_splitk(acc, WSP(bf16_t, W_HPB) + (size_t)MP * 1024, 1024, WSP(bf16_t, W_WQ) + (size_t)n0 * 1024, 1024, 1024, lds, ldsh, half_)) p7_epi<2>(p, acc, MP + wmv * 64, n0 + wnv * 32);
    }
}
__device__ __forceinline__ void phase9_g8(const Params& p, LAS char* lds, LAS char* ldsh) {
    W8V;
    pg8::Gemm g{WSP(bf16_t, W_OB), WSP(bf16_t, W_WXO), MP, 1024, 1024};
    pg8::gemm_phase<EpiRes<1>, Sched256, false>((PG8_LAS unsigned char*)lds, g, Sched256{64 * 4, 64, 4}, EpiRes<1>{&p}, nullptr);
    if (RBID < 16) {
        const int n0 = RBID * 64;
        const int wv_ = __builtin_amdgcn_readfirstlane(VTID >> 6), wmv = wv_ >> 1, wnv = wv_ & 1;
        f32x4 acc[4][2];
        if (single64_splitk(acc, WSP(bf16_t, W_OB) + (size_t)MP * 1024, 1024, WSP(bf16_t, W_WXO) + (size_t)n0 * 1024, 1024, 1024, lds, ldsh, half_)) res_epi<1, 2>(p, acc, MP + wmv * 64, n0 + wnv * 32);
    }
}
__device__ __forceinline__ void phase10_g8(const Params& p, LAS char* lds, LAS char* ldsh) {
    W8V;
    pg8::Gemm g{WSP(bf16_t, W_HPB), WSP(bf16_t, W_WGU), MP, 5632, 1024};
    pg8::gemm_phase<EpiGU, Sched256, false>((PG8_LAS unsigned char*)lds, g, Sched256{1280, 64, 22}, EpiGU{&p}, nullptr);
    const int wv_ = __builtin_amdgcn_readfirstlane(VTID >> 6), wmv = wv_ >> 1, wnv = wv_ & 1;
    for (int q = RBID * 2 + half_; q < 512; q += RGRID * 2) {
        const int m0 = 56 * 256 + (q & 15) * 128, n0 = 6 * 256 + (q >> 4) * 128;
        f32x4 acc[4][4]; zero_acc<4>(acc);
        mma_seg<128, 0>(acc, WSP(bf16_t, W_HPB) + (size_t)m0 * 1024, 1024, WSP(bf16_t, W_WGU) + (size_t)n0 * 1024, 1024, 1024, ldsh, nullptr);
        p10_epi<4>(p, acc, m0 + wmv * 64, n0 + wnv * 64);
    }
    if (RBID < 88) {
        const int n0 = RBID * 64;
        f32x4 acc[4][2];
        if (single64_splitk(acc, WSP(bf16_t, W_HPB) + (size_t)MP * 1024, 1024, WSP(bf16_t, W_WGU) + (size_t)n0 * 1024, 1024, 1024, lds, ldsh, half_)) p10_epi<2>(p, acc, MP + wmv * 64, n0 + wnv * 32);
    }
}
__device__ __forceinline__ void phase11_g8(const Params& p, LAS char* lds, LAS char* ldsh) {
    W8V;
    pg8::Gemm g{WSP(bf16_t, W_ACT), WSP(bf16_t, W_WD), MP, 1024, 2816};
    pg8::gemm_phase<EpiRes<2>, Sched256, false>((PG8_LAS unsigned char*)lds, g, Sched256{64 * 4, 64, 4}, EpiRes<2>{&p}, nullptr);
    if (RBID < 88) {
        const int j = RBID * 2 + half_, nt = j & 15, ks = j >> 4, n0 = nt * 64;
        const int wv_ = __builtin_amdgcn_readfirstlane(VTID >> 6), wmv = wv_ >> 1, wnv = wv_ & 1, lanev = VTID & 63, frv = lanev & 15, fqv = lanev >> 4;
        f32x4 acc[4][2]; zero_acc<2>(acc);
        mma_seg<64, 0>(acc, WSP(bf16_t, W_ACT) + (size_t)MP * 2816 + ks * 256, 2816, WSP(bf16_t, W_WD) + (size_t)n0 * 2816 + ks * 256, 2816, 256, ldsh, nullptr);
        float* hp = WSP(float, W_HP);
        const int rb = MP + wmv * 64 + frv, cb = n0 + wnv * 32 + fqv * 4;
#pragma unroll
        for (int mi = 0; mi < 4; ++mi)
#pragma unroll
            for (int ni = 0; ni < 2; ++ni)
#pragma unroll
                for (int jj = 0; jj < 4; ++jj) atomicAdd(hp + (size_t)(rb + mi * 16) * 1024 + cb + ni * 16 + jj, acc[mi][ni][jj]);
    }
}

#ifndef SKIP_PH
#define SKIP_PH 99
#endif
#define PH_ON(n) ((!defined(ONLY_PH) || ONLY_PH == n) && (SKIP_PH != n))
__global__ void __launch_bounds__(512) hymba_fwd(Params p) {
    extern __shared__ __attribute__((aligned(16))) char smem_dyn[];
    LAS char* lds = (LAS char*)smem_dyn;
    LAS char* ldsh = lds + __builtin_amdgcn_readfirstlane(RTID >> 8) * 65536;
    if (p.never) cg::this_grid().sync();
    volatile LAS unsigned* st = (volatile LAS unsigned*)(lds + LDS_MISC);
    if (RTID < 4) st[RTID] = 0u;
    __syncthreads();
    XcdBarrier xb = xcd_barrier_post(WSP(unsigned, W_BAR), st);
#if PH_ON(0)
    if (p.ph_lo <= 0 && 0 < p.ph_hi) { phase0(p, ldsh); }
#if (DUPM >> 0) & 1
    xcd_barrier(xb); { phase0(p, ldsh); }
#endif
#endif
                    xcd_barrier(xb);
#if PH_ON(1)
    if (p.ph_lo <= 1 && 1 < p.ph_hi) { phase1_g8(p, lds, ldsh); }
#if (DUPM >> 1) & 1
    xcd_barrier(xb); { phase1_g8(p, lds, ldsh); }
#endif
#endif
               xcd_barrier(xb);
#if PH_ON(2)
    if (p.ph_lo <= 2 && 2 < p.ph_hi) { phase2(p, ldsh); }
#if (DUPM >> 2) & 1
    xcd_barrier(xb); { phase2(p, ldsh); }
#endif
#endif
                    xcd_barrier(xb);
#if PH_ON(3)
    if (p.ph_lo <= 3 && 3 < p.ph_hi) { phase3(p, ldsh); }
#if (DUPM >> 3) & 1
    xcd_barrier(xb); { phase3(p, ldsh); }
#endif
#endif
                    xcd_barrier(xb);
#if PH_ON(4)
    if (p.ph_lo <= 4 && 4 < p.ph_hi) { phase4(p); }
#if (DUPM >> 4) & 1
    xcd_barrier(xb); { phase4(p); }
#endif
#endif
                          xcd_barrier(xb);
#if PH_ON(5)
    if (p.ph_lo <= 5 && 5 < p.ph_hi) { phase5(p, ldsh); }
#if (DUPM >> 5) & 1
    xcd_barrier(xb); { phase5(p, ldsh); }
#endif
#endif
                    xcd_barrier(xb);
#if PH_ON(6)
    if (p.ph_lo <= 6 && 6 < p.ph_hi) { phase5b(p); xcd_barrier(xb); phase6_g8(p, lds, ldsh); }
#if (DUPM >> 6) & 1
    xcd_barrier(xb); { phase5b(p); xcd_barrier(xb); phase6_g8(p, lds, ldsh); }
#endif
#endif
         xcd_barrier(xb);
#if PH_ON(7)
    if (p.ph_lo <= 7 && 7 < p.ph_hi) { phase7_g8(p, lds, ldsh); }
#if (DUPM >> 7) & 1
    xcd_barrier(xb); { phase7_g8(p, lds, ldsh); }
#endif
#endif
               xcd_barrier(xb);
#if PH_ON(8)
    if (p.ph_lo <= 8 && 8 < p.ph_hi) { phase8(p, ldsh); }
#if (DUPM >> 8) & 1
    xcd_barrier(xb); { phase8(p, ldsh); }
#endif
#endif
                    xcd_barrier(xb);
#if PH_ON(9)
    if (p.ph_lo <= 9 && 9 < p.ph_hi) { phase9_g8(p, lds, ldsh); }
#if (DUPM >> 9) & 1
    xcd_barrier(xb); { phase9_g8(p, lds, ldsh); }
#endif
#endif
         xcd_barrier(xb);
#if PH_ON(10)
    if (p.ph_lo <= 10 && 10 < p.ph_hi) { phase10_g8(p, lds, ldsh); }
#if (DUPM >> 10) & 1
    xcd_barrier(xb); { phase10_g8(p, lds, ldsh); }
#endif
#endif
              xcd_barrier(xb);
#if PH_ON(11)
    if (p.ph_lo <= 11 && 11 < p.ph_hi) { phase11_g8(p, lds, ldsh); }
#if (DUPM >> 11) & 1
    xcd_barrier(xb); { phase11_g8(p, lds, ldsh); }
#endif
#endif
         xcd_barrier(xb);
#if PH_ON(12)
    if (p.ph_lo <= 12 && 12 < p.ph_hi) { phase12(p); }
#if (DUPM >> 12) & 1
    xcd_barrier(xb); { phase12(p); }
#endif
#endif
}

extern "C" void kernel_launch(void* const* d_in, const int* in_sizes, int n_in, void* d_out, int out_size, void* d_ws, size_t ws_size, hipStream_t stream) {
    static int grid = 0;
    if (grid == 0) {
        int dev = 0, cus = 0, per_cu = 0;
        (void)hipGetDevice(&dev);
        (void)hipDeviceGetAttribute(&cus, hipDeviceAttributeMultiprocessorCount, dev);
        (void)hipFuncSetAttribute((const void*)hymba_fwd, hipFuncAttributeMaxDynamicSharedMemorySize, LDS_BYTES);
        (void)hipOccupancyMaxActiveBlocksPerMultiprocessor(&per_cu, (const void*)hymba_fwd, 512, LDS_BYTES);
        grid = cus; grid = (grid / 8) * 8;
        if (per_cu < 1) fprintf(stderr, "kernel_launch: occupancy query reports %d blocks per CU\n", per_cu);
        if (ws_size < W_END) fprintf(stderr, "kernel_launch: workspace too small: %zu < %zu\n", ws_size, (size_t)W_END);
    }
    Params p{};
    for (int i = 0; i < 31; ++i) p.in[i] = (const float*)d_in[i];
    p.out = (float*)d_out; p.ws = (char*)d_ws; p.never = 0;
    (void)hipMemsetAsync((char*)d_ws + W_BAR, 0, XCD_BAR_WORDS * 4, stream);
    p.ph_lo = 0; p.ph_hi = NPH; p.fused = 1;
    void* args[] = {&p};
    hipError_t e = hipLaunchCooperativeKernel((const void*)hymba_fwd, dim3(grid), dim3(512), args, LDS_BYTES, stream);
    if (e != hipSuccess) fprintf(stderr, "cooperative launch failed: %s (grid %d)\n", hipGetErrorString(e), grid);
}
```

```cpp
#include <hip/hip_runtime.h>
#include <hip/hip_cooperative_groups.h>
#include <stdint.h>
#include <cstdio>
namespace cg = cooperative_groups;

#ifndef FUSED
#define FUSED 1
#ifndef DUPM
#define DUPM 0
#endif
#endif
#define DUP_MASK 0
#define PRE_MASK 0
#ifndef RUN_PHASES
#define RUN_PHASES 13
#define DUMP_SEL 0
#endif

#define LAS __attribute__((address_space(3)))
typedef unsigned short bf16_t;
typedef short bf16x8 __attribute__((ext_vector_type(8)));
typedef float f32x4 __attribute__((ext_vector_type(4)));
typedef unsigned u32x4 __attribute__((ext_vector_type(4)));
typedef unsigned u32x2 __attribute__((ext_vector_type(2)));

constexpr int MP = 16384, MS = 128, MT = MP + MS;
constexpr int NCH = 128;
constexpr float EPS = 1e-6f;
constexpr int NPH = 13;

constexpr size_t O_YP = 0, O_YS = 16777216, O_SSMP = 16908288, O_CONVP = 17432576, O_GVP = 17457152,
                 O_MK = 17981440, O_MV = 20078592, O_SSMS = 22175744, O_CONVS = 30564352, O_GVS = 30957568;

constexpr size_t al(size_t x) { return (x + 255) & ~(size_t)255; }
constexpr size_t W_BAR = 0;
constexpr size_t W_ZERO = al(W_BAR + 3456 * 4);
constexpr size_t ZERO_FLOATS = (size_t)MT * 7;
constexpr size_t W_WIN = al(W_ZERO + ZERO_FLOATS * 4);
constexpr size_t W_WKV = al(W_WIN + (size_t)2816 * 1024 * 2);
constexpr size_t W_WOUT = al(W_WKV + (size_t)2048 * 1024 * 2);
constexpr size_t W_WQ = al(W_WOUT + (size_t)1024 * 1024 * 2);
constexpr size_t W_WXO = al(W_WQ + (size_t)1024 * 1024 * 2);
constexpr size_t W_WGU = al(W_WXO + (size_t)1024 * 1024 * 2);
constexpr size_t W_WD = al(W_WGU + (size_t)5632 * 1024 * 2);
constexpr size_t W_WSB = al(W_WD + (size_t)1024 * 2816 * 2);
constexpr size_t W_MEMB = al(W_WSB + (size_t)4 * 128 * 128 * 2);
constexpr size_t W_DTRAW = al(W_MEMB + (size_t)2048 * 1024 * 2);
constexpr size_t W_KB = al(W_DTRAW + (size_t)MT * 8 * 4);
constexpr size_t W_VT = al(W_KB + (size_t)2048 * 1024 * 2);
constexpr size_t W_VLNT = al(W_VT + (size_t)2048 * 1024 * 2);
constexpr size_t W_ACUM = al(W_VLNT + (size_t)MP * 512 * 2);
constexpr size_t W_DTV = al(W_ACUM + (size_t)NCH * 8 * 128 * 4);
constexpr size_t W_CONCAT = al(W_DTV + (size_t)NCH * 8 * 128 * 4);
constexpr size_t W_HP = al(W_CONCAT + (size_t)MT * 1024 * 2);
constexpr size_t W_HPB = al(W_HP + (size_t)MT * 1024 * 4);
constexpr size_t W_XB = al(W_HPB + (size_t)MT * 1024 * 2);
constexpr size_t W_UB = al(W_XB + (size_t)MT * 1024 * 2);
constexpr size_t W_VG = al(W_UB + (size_t)MT * 512 * 2);
constexpr size_t W_ZB = al(W_VG + (size_t)MT * 512 * 2);
constexpr size_t W_XBCB = al(W_ZB + (size_t)MT * 512 * 2);
constexpr size_t W_R1END = al(W_XBCB + (size_t)MT * 1024 * 2);
constexpr size_t W_ACT = W_XB;
static_assert((size_t)MT * 2816 * 2 <= W_R1END - W_XB, "act alias");
constexpr size_t W_XN = W_R1END;
constexpr size_t W_XWT = al(W_XN + (size_t)MP * 512 * 2);
constexpr size_t W_XT = al(W_XWT + (size_t)MP * 512 * 2);
constexpr size_t W_BN = al(W_XT + (size_t)MP * 512 * 2);
constexpr size_t W_BT = al(W_BN + (size_t)MP * 256 * 2);
constexpr size_t W_CN = al(W_BT + (size_t)MP * 256 * 2);
constexpr size_t W_R2END = al(W_CN + (size_t)MP * 256 * 2);
constexpr size_t W_QB = W_XN;
static_assert((size_t)MT * 1024 * 2 <= W_BN - W_XN, "qb alias");
constexpr size_t W_SC = W_R2END;
constexpr size_t W_HPREV = al(W_SC + (size_t)NCH * 8 * 64 * 128 * 4);
constexpr size_t W_MT = al(W_HPREV + (size_t)NCH * 8 * 64 * 128 * 2);
constexpr size_t W_END = al(W_MT + (size_t)NCH * 8 * 128 * 128 * 2);
constexpr size_t W_PBUF = W_SC;
constexpr size_t W_OB = W_HPREV;
static_assert((size_t)MT * 1024 * 2 <= W_END - W_HPREV, "ob alias");
static_assert(W_END < (size_t)530 * 1000 * 1000, "workspace too large");

constexpr int LDS_MISC = 131072;
constexpr int LDS_BYTES = 131072 + 8192;
#define RTID ((int)threadIdx.x)
#define RBID ((int)blockIdx.x)
#define RGRID ((int)gridDim.x)
#define VTID ((int)(threadIdx.x & 255u))
#define VBID ((int)(blockIdx.x * 2u + (unsigned)__builtin_amdgcn_readfirstlane((int)(threadIdx.x >> 8))))
#define VGRID ((int)(gridDim.x * 2u))

struct Params {
    const float* in[31];
    float* out;
    char* ws;
    int ph_lo, ph_hi, fused, never;
};

__device__ __forceinline__ float bf2f(unsigned h) { return __uint_as_float(h << 16); }
__device__ __forceinline__ unsigned pk2(float lo, float hi) { unsigned r; asm("v_cvt_pk_bf16_f32 %0, %1, %2" : "=v"(r) : "v"(lo), "v"(hi)); return r; }
__device__ __forceinline__ float bflo(unsigned u) { return __uint_as_float(u << 16); }
__device__ __forceinline__ float bfhi(unsigned u) { return __uint_as_float(u & 0xffff0000u); }
__device__ __forceinline__ float rbf(float x) { return bflo(pk2(x, 0.f) & 0xffffu); }
__device__ __forceinline__ float gelu_t(float x) { const float u = 1.5957691216f * (x + 0.044715f * x * x * x); return x * __builtin_amdgcn_rcpf(1.f + __expf(-u)); }
__device__ __forceinline__ float silu_f(float x) { return x * __builtin_amdgcn_rcpf(1.f + __expf(-x)); }
__device__ __forceinline__ float softplus_f(float x) { return x > 20.f ? x : log1pf(expf(x)); }
__device__ __forceinline__ float wave_sum(float v) {
#pragma unroll
    for (int o = 1; o < 64; o <<= 1) v += __shfl_xor(v, o);
    return v;
}
__device__ __forceinline__ float wave_max(float v) {
#pragma unroll
    for (int o = 1; o < 64; o <<= 1) v = fmaxf(v, __shfl_xor(v, o));
    return v;
}
__device__ __forceinline__ u32x4 scale8(u32x4 v, float s) {
    u32x4 o;
    o.x = pk2(bflo(v.x) * s, bfhi(v.x) * s); o.y = pk2(bflo(v.y) * s, bfhi(v.y) * s);
    o.z = pk2(bflo(v.z) * s, bfhi(v.z) * s); o.w = pk2(bflo(v.w) * s, bfhi(v.w) * s);
    return o;
}

#define XB_TMO      128
#define XB_XCNT(j)  (256  + 64 * (j))
#define XB_XSUB(j)  (1280 + 64 * (j))
#define XB_XGEN(j)  (2304 + 64 * (j))
#define XB_TOP      3328
#define XB_TOPGEN   3392
#define XCD_BAR_WORDS 3456
#define XB_SPIN_CAP (1u << 22)
__device__ __forceinline__ unsigned xb_ld(unsigned* p)              { return __hip_atomic_load(p, __ATOMIC_RELAXED, __HIP_MEMORY_SCOPE_AGENT); }
__device__ __forceinline__ unsigned xb_add(unsigned* p, unsigned v) { return __hip_atomic_fetch_add(p, v, __ATOMIC_RELAXED, __HIP_MEMORY_SCOPE_AGENT); }
__device__ __forceinline__ unsigned xb_xcc_id() { return (unsigned)__builtin_amdgcn_s_getreg((3 << 11) | 20) & 0xFu; }
#define XB_SPIN(cond, bar) do { unsigned _sp = 0; while (cond) { __builtin_amdgcn_s_sleep(1); \
    if ((++_sp & 255u) == 0u) { if (xb_ld(&(bar)[XB_TMO])) break; if (_sp > XB_SPIN_CAP) { atomicAdd(&(bar)[XB_TMO], 1u); break; } } } } while (0)
struct XcdBarrier { unsigned* bar; unsigned x; volatile LAS unsigned* st; };
__device__ __forceinline__ XcdBarrier xcd_barrier_post(unsigned* bar, volatile LAS unsigned* st) {
    XcdBarrier b; b.bar = bar; b.x = xb_xcc_id(); b.st = st;
    if (threadIdx.x == 0) (void)xb_add(&bar[XB_XCNT(b.x)], 1u);
    return b;
}
__device__ __forceinline__ void xcd_barrier_complete(unsigned* bar, unsigned x, unsigned& nloc, unsigned& nx) {
    const unsigned G = gridDim.x * gridDim.y * gridDim.z;
    unsigned sum, cnt, mine, sp = 0u;
    for (;;) {
        sum = 0u; cnt = 0u; mine = 0u;
#pragma unroll
        for (unsigned j = 0; j < 16; ++j) { const unsigned c = xb_ld(&bar[XB_XCNT(j)]); sum += c; cnt += (c > 0u) ? 1u : 0u; mine = (j == x) ? c : mine; }
        if (sum == G) break;
        __builtin_amdgcn_s_sleep(1);
        if ((++sp & 255u) == 0u) { if (xb_ld(&bar[XB_TMO])) break; if (sp > XB_SPIN_CAP) { atomicAdd(&bar[XB_TMO], 1u); break; } }
    }
    nloc = mine > 0u ? mine : 1u; nx = cnt > 0u ? cnt : 1u;
}
__device__ __forceinline__ void xcd_barrier(const XcdBarrier& b) {
    asm volatile("s_waitcnt vmcnt(0)" ::: "memory");
    __syncthreads();
    if (threadIdx.x == 0) {
        unsigned* bar = b.bar;
        __builtin_amdgcn_s_waitcnt(0);
        unsigned nloc = b.st[0], nx = b.st[1];
        if (nloc == 0u) { xcd_barrier_complete(bar, b.x, nloc, nx); b.st[0] = nloc; b.st[1] = nx; }
        const unsigned old = xb_add(&bar[XB_XSUB(b.x)], 1u);
        const unsigned gen = old / nloc;
        if (old + 1u == (gen + 1u) * nloc) {
            __builtin_amdgcn_fence(__ATOMIC_RELEASE, "agent");
            asm volatile("s_waitcnt vmcnt(0)" ::: "memory");
            const unsigned og = xb_add(&bar[XB_TOP], 1u);
            const unsigned tg = og / nx;
            if (og + 1u == (tg + 1u) * nx) xb_add(&bar[XB_TOPGEN], 1u);
            else XB_SPIN(xb_ld(&bar[XB_TOPGEN]) == tg, bar);
            __builtin_amdgcn_fence(__ATOMIC_ACQUIRE, "agent");
            xb_add(&bar[XB_XGEN(b.x)], 1u);
            asm volatile("s_waitcnt vmcnt(0)" ::: "memory");
        } else {
            XB_SPIN(xb_ld(&bar[XB_XGEN(b.x)]) == gen, bar);
            __builtin_amdgcn_fence(__ATOMIC_ACQUIRE, "agent");
            asm volatile("s_waitcnt vmcnt(0)" ::: "memory");
        }
    }
    __syncthreads();
}

__device__ __forceinline__ int sched(int i, int T) {
    const int x = VBID & 7, lb = VBID >> 3, nlb = VGRID >> 3;
    const int chunk = (T + 7) >> 3, local = lb + i * nlb;
    if (local >= chunk) return -1;
    const int t = x * chunk + local;
    return t < T ? t : -1;
}
__device__ __forceinline__ void tile_mn(int t, int NMt, int NNt, int& mt, int& nt) {
    const int per = 8 * NNt, gi = t / per, r = t - gi * per, fm = gi * 8;
    const int gsz = (NMt - fm) < 8 ? (NMt - fm) : 8;
    mt = fm + r % gsz; nt = r / gsz;
}

template <int BN, int AMODE>
__device__ __forceinline__ void mma_seg(f32x4 (&acc)[4][BN / 32], const bf16_t* __restrict__ A, const int lda,
                                        const bf16_t* __restrict__ Bt, const int ldb, const int K, LAS char* lds,
                                        const float* __restrict__ gssrow) {
    constexpr int NI = BN / 32;
    const int tid = VTID, lane = tid & 63, wid = __builtin_amdgcn_readfirstlane(tid >> 6), wm = wid >> 1, wn = wid & 1, fr = lane & 15, fq = lane >> 4;
    const int srow = tid >> 3, sc = tid & 7;
    const int csw = (sc ^ ((srow >> 1) & 7)) * 8;
    const bf16_t* ap = A + (size_t)srow * lda + (AMODE == 1 ? sc * 8 : csw);
    const bf16_t* bp = Bt + (size_t)srow * ldb + csw;
    const int woff = srow * 128 + ((sc ^ ((srow >> 1) & 7)) << 4);
    const int gl = wid * 1024;
    const int sw = (fr >> 1) & 7;
    const int aoff = (wm * 64 + fr) * 128, boff = 32768 + (wn * (BN / 2) + fr) * 128;
    u32x4 ra[4];
    float asc[4];
    const int nk = K >> 6;
#define MS_ISSUE(kt, buf) do { \
    if (AMODE == 1) { \
        _Pragma("unroll") for (int i = 0; i < 4; ++i) ra[i] = *(const u32x4*)(ap + (size_t)(i * 32) * lda + (kt) * 64); \
        const int k_ = (kt) * 64 + sc * 8; \
        _Pragma("unroll") for (int i = 0; i < 4; ++i) asc[i] = (k_ >= 512) ? rsqrtf(gssrow[(srow + 32 * i) * 2 + ((k_ - 512) >> 8)] * (1.f / 256.f) + EPS) : 1.f; \
    } else { \
        _Pragma("unroll") for (int i = 0; i < 4; ++i) __builtin_amdgcn_global_load_lds((const unsigned*)(ap + (size_t)(i * 32) * lda + (kt) * 64), (LAS unsigned*)(lds + (buf) * 16384 + i * 4096 + gl), 16, 0, 0); \
    } \
    _Pragma("unroll") for (int i = 0; i < NI; ++i) __builtin_amdgcn_global_load_lds((const unsigned*)(bp + (size_t)(i * 32) * ldb + (kt) * 64), (LAS unsigned*)(lds + 32768 + (buf) * 16384 + i * 4096 + gl), 16, 0, 0); \
  } while (0)
#define MS_STORE(buf) do { if (AMODE == 1) { \
    _Pragma("unroll") for (int i = 0; i < 4; ++i) { *(LAS u32x4*)(lds + (buf) * 16384 + woff + i * 4096) = scale8(ra[i], asc[i]); } } \
  } while (0)
    __syncthreads();
    MS_ISSUE(0, 0);
    MS_STORE(0);
    asm volatile("s_waitcnt vmcnt(0)" ::: "memory");
    __syncthreads();
    for (int kt = 0; kt < nk; ++kt) {
        const int cur = kt & 1;
        if (kt + 1 < nk) MS_ISSUE(kt + 1, cur ^ 1);
#pragma unroll
        for (int kk = 0; kk < 2; ++kk) {
            const int co = (((kk * 4 + fq) ^ sw) << 4) + cur * 16384;
            bf16x8 af[4], bfv[NI];
#pragma unroll
            for (int mi = 0; mi < 4; ++mi) af[mi] = *(LAS bf16x8*)(lds + aoff + mi * 2048 + co);
#pragma unroll
            for (int ni = 0; ni < NI; ++ni) bfv[ni] = *(LAS bf16x8*)(lds + boff + ni * 2048 + co);
#pragma unroll
            for (int mi = 0; mi < 4; ++mi)
#pragma unroll
                for (int ni = 0; ni < NI; ++ni) acc[mi][ni] = __builtin_amdgcn_mfma_f32_16x16x32_bf16(bfv[ni], af[mi], acc[mi][ni], 0, 0, 0);
        }
        if (kt + 1 < nk) MS_STORE(cur ^ 1);
        asm volatile("s_waitcnt vmcnt(0)" ::: "memory");
        __syncthreads();
    }
#undef MS_ISSUE
#undef MS_STORE
}
template <int NI> __device__ __forceinline__ void zero_acc(f32x4 (&acc)[4][NI]) {
#pragma unroll
    for (int mi = 0; mi < 4; ++mi)
#pragma unroll
        for (int ni = 0; ni < NI; ++ni) acc[mi][ni] = (f32x4){0.f, 0.f, 0.f, 0.f};
}
__device__ __forceinline__ void mma256(f32x4 (&acc0)[4][4], f32x4 (&acc1)[4][4], const bf16_t* __restrict__ A, const int lda,
                                       const bf16_t* __restrict__ Bt, const int ldb, const int K, LAS char* lds) {
    const int tid = RTID, lane = tid & 63, w8 = __builtin_amdgcn_readfirstlane(tid >> 6), wm2 = w8 >> 2, wn4 = w8 & 3, fr = lane & 15, fq = lane >> 4;
    const int srow = tid >> 3, sc = tid & 7;
    const int csw = (sc ^ ((srow >> 1) & 7)) * 8;
    const bf16_t* ap = A + (size_t)srow * lda + csw;
    const bf16_t* bp = Bt + (size_t)srow * ldb + csw;
    const int gl = w8 * 1024;
    const int sw = (fr >> 1) & 7;
    const int aoff = (wm2 * 128 + fr) * 128, boff = 32768 + (wn4 * 64 + fr) * 128;
    const int nk = K >> 6;
#define M8_ISSUE(kt, buf) do { const int base_ = (buf) * 65536 + gl; \
    _Pragma("unroll") for (int i = 0; i < 4; ++i) __builtin_amdgcn_global_load_lds((const unsigned*)(ap + (size_t)(i * 64) * lda + (kt) * 64), (LAS unsigned*)(lds + base_ + i * 8192), 16, 0, 0); \
    _Pragma("unroll") for (int i = 0; i < 4; ++i) __builtin_amdgcn_global_load_lds((const unsigned*)(bp + (size_t)(i * 64) * ldb + (kt) * 64), (LAS unsigned*)(lds + base_ + 32768 + i * 8192), 16, 0, 0); \
  } while (0)
    __syncthreads();
    M8_ISSUE(0, 0);
    asm volatile("s_waitcnt vmcnt(0)" ::: "memory");
    __syncthreads();
    for (int kt = 0; kt < nk; ++kt) {
        const int cur = kt & 1;
        if (kt + 1 < nk) M8_ISSUE(kt + 1, cur ^ 1);
#pragma unroll 1
        for (int kk = 0; kk < 2; ++kk) {
            const int co = (((kk * 4 + fq) ^ sw) << 4) + cur * 65536;
            bf16x8 a0[4], a1[4], bfv[4];
#pragma unroll
            for (int ni = 0; ni < 4; ++ni) bfv[ni] = *(LAS bf16x8*)(lds + boff + ni * 2048 + co);
#pragma unroll
            for (int mi = 0; mi < 4; ++mi) a0[mi] = *(LAS bf16x8*)(lds + aoff + mi * 2048 + co);
#pragma unroll
            for (int mi = 0; mi < 4; ++mi) a1[mi] = *(LAS bf16x8*)(lds + aoff + 8192 + mi * 2048 + co);
            __builtin_amdgcn_s_setprio(1);
#pragma unroll
            for (int mi = 0; mi < 4; ++mi)
#pragma unroll
                for (int ni = 0; ni < 4; ++ni) acc0[mi][ni] = __builtin_amdgcn_mfma_f32_16x16x32_bf16(bfv[ni], a0[mi], acc0[mi][ni], 0, 0, 0);
#pragma unroll
            for (int mi = 0; mi < 4; ++mi)
#pragma unroll
                for (int ni = 0; ni < 4; ++ni) acc1[mi][ni] = __builtin_amdgcn_mfma_f32_16x16x32_bf16(bfv[ni], a1[mi], acc1[mi][ni], 0, 0, 0);
            __builtin_amdgcn_s_setprio(0);
        }
        asm volatile("s_waitcnt vmcnt(0)" ::: "memory");
        __syncthreads();
    }
#undef M8_ISSUE
}
namespace pg8 {
#define PG8_LAS __attribute__((address_space(3)))
constexpr int BM = 256, BK = 64, HALF = 128, HTB = HALF * BK * 2  , STAGE_BYTES = 8 * HTB, NXCD = 8, WGM = 8;
__device__ __forceinline__ int lds_byte(int r, int c) { const int st = (r >> 4) * 2 + (c >> 5), rr = r & 15, cc = c & 31, ob = rr * 64 + cc * 2; return st * 1024 + (ob ^ (((ob >> 9) & 1) << 5)); }
__device__ __forceinline__ void stage_rc(int b, int& R, int& C) { const int st = b / 1024, sb = b % 1024, swz = sb ^ (((sb >> 9) & 1) << 5); R = (st >> 1) * 16 + swz / 64; C = (st & 1) * 32 + (swz % 64) / 2; }
__device__ __forceinline__ int perm32(int rho) { const int n = rho >> 4, i = rho & 15; return 8 * (i >> 2) + 4 * n + (i & 3); }
struct Unit { int pm, pn; };
struct Gemm { const bf16_t* A; const bf16_t* Bt; int M, N, K; };
template <class Epi, class Sched, bool STAMP = false>
__device__ __forceinline__ void gemm_phase(PG8_LAS unsigned char* lds, const Gemm g, const Sched& S, const Epi& E, unsigned long long* stamps) {
    const int tid = threadIdx.x, wid = __builtin_amdgcn_readfirstlane(tid >> 6), lane = tid & 63, wr = wid >> 2, wc = wid & 3, fr = lane & 15, fq = lane >> 4;
    const int K = g.K, nt = K / BK;
    int ts_lo = 0, ts_hi = 0, nts = 0; const unsigned long long rt_entry = STAMP ? (unsigned long long)wall_clock64() : 0ull;
#define PG8_STAMP() do { if (STAMP && wid == 0 && nts < 64) { const unsigned long long _c = (unsigned long long)clock64(); \
        ts_lo = (lane == nts) ? (int)(unsigned)_c : ts_lo; ts_hi = (lane == nts) ? (int)(unsigned)(_c >> 32) : ts_hi; ++nts; } } while (0)
    PG8_STAMP();
    unsigned voffA[2], voffB[2];
#pragma unroll
    for (int i = 0; i < 2; ++i) { int R, C; stage_rc(tid * 16 + i * 8192, R, C); const int Rb = Epi::PERM ? ((R & ~31) + perm32(R & 31)) : R;
        voffA[i] = (unsigned)(R * K + C) * 2u; voffB[i] = (unsigned)(Rb * K + C) * 2u; }
    const size_t kstep = (size_t)(BK * 2);
    const size_t hstep = (size_t)HALF * K * 2;
    const size_t tstep = 2 * hstep;
    const unsigned ldsw = (unsigned)wid * 1024u;
    const int aoff = lds_byte(wr * 64 + fr, fq * 8), boff = lds_byte(wc * 32 + fr, fq * 8);
#define PG8_SA(b, h) (((b) * 2 + (h)) * HTB)
#define PG8_SB(b, h) ((4 + (b) * 2 + (h)) * HTB)
#define PG8_STAGE(bufoff, gbase, voff) do { _Pragma("unroll") for (int _i = 0; _i < 2; ++_i) \
        __builtin_amdgcn_global_load_lds((const unsigned*)((const char*)(gbase) + (voff)[_i]), (PG8_LAS unsigned*)(lds + (bufoff) + ldsw + _i * 8192), 16, 0, 0); } while (0)
#define PG8_LDA(dst, b, h) do { _Pragma("unroll") for (int m = 0; m < 4; ++m) _Pragma("unroll") for (int k = 0; k < 2; ++k) dst[m][k] = *(const PG8_LAS bf16x8*)(lds + PG8_SA(b, h) + aoff + m * 2048 + k * 1024); } while (0)
#define PG8_LDB(dst, b, h) do { _Pragma("unroll") for (int n = 0; n < 2; ++n) _Pragma("unroll") for (int k = 0; k < 2; ++k) dst[n][k] = *(const PG8_LAS bf16x8*)(lds + PG8_SB(b, h) + boff + n * 2048 + k * 1024); } while (0)
#define PG8_MMA(ai, bj, At, Bt) do { __builtin_amdgcn_s_setprio(1); _Pragma("unroll") for (int m = 0; m < 4; ++m) _Pragma("unroll") for (int n = 0; n < 2; ++n) _Pragma("unroll") for (int k = 0; k < 2; ++k) \
        acc[ai][bj][m][n] = __builtin_amdgcn_mfma_f32_16x16x32_bf16(Bt[n][k], At[m][k], acc[ai][bj][m][n], 0, 0, 0); __builtin_amdgcn_s_setprio(0); } while (0)
#define PG8_WAIT_V(n) asm volatile("s_waitcnt vmcnt(" #n ")" ::: "memory")
#define PG8_WAIT_L(n) asm volatile("s_waitcnt lgkmcnt(" #n ")" ::: "memory")
#define PG8_BAR __builtin_amdgcn_s_barrier()
#define PG8_SCHED __builtin_amdgcn_sched_barrier(0)
    Unit cur, nxt; int ui = 0;
    if (!S.next(0, cur)) return;
    f32x4 acc[2][2][4][2];
#pragma unroll
    for (int a = 0; a < 2; ++a)
#pragma unroll
        for (int b = 0; b < 2; ++b)
#pragma unroll
            for (int m = 0; m < 4; ++m)
#pragma unroll
                for (int n = 0; n < 2; ++n) acc[a][b][m][n] = (f32x4){0.f, 0.f, 0.f, 0.f};
    bf16x8 At[4][2], B0[2][2], B1[2][2];
    const char* cA = (const char*)g.A + (size_t)cur.pm * tstep; const char* cB = (const char*)g.Bt + (size_t)cur.pn * tstep;
    S.a_ready(cur);
    PG8_STAGE(PG8_SB(0, 0), cB, voffB); PG8_STAGE(PG8_SA(0, 0), cA, voffA); PG8_STAGE(PG8_SB(0, 1), cB + hstep, voffB); PG8_STAGE(PG8_SA(0, 1), cA + hstep, voffA);
    if (wr == 1) PG8_BAR;
    PG8_WAIT_V(4); PG8_BAR;
    PG8_STAGE(PG8_SB(1, 0), cB + kstep, voffB); PG8_STAGE(PG8_SA(1, 0), cA + kstep, voffA); PG8_STAGE(PG8_SB(1, 1), cB + hstep + kstep, voffB);
    PG8_WAIT_V(6); PG8_BAR;
    PG8_STAMP();
    for (;;) {
        const bool has_next = S.next(ui + 1, nxt);
        const char* nA = has_next ? (const char*)g.A + (size_t)nxt.pm * tstep : cA; const char* nB = has_next ? (const char*)g.Bt + (size_t)nxt.pn * tstep : cB;
        for (int t = 0; t < nt; t += 2) {
            const bool last = (t == nt - 2);
            const char* a1 = cA + (size_t)(t + 1) * kstep;
            const char* a2 = last ? nA : cA + (size_t)(t + 2) * kstep; const char* b2 = last ? nB : cB + (size_t)(t + 2) * kstep;
            const char* a3 = a2 + kstep; const char* b3 = b2 + kstep;
            if (last && has_next) S.a_ready(nxt);
            PG8_LDB(B0, 0, 0); PG8_SCHED; PG8_LDA(At, 0, 0); PG8_STAGE(PG8_SA(1, 1), a1 + hstep, voffA);
            PG8_WAIT_L(8); PG8_BAR; PG8_WAIT_L(0); PG8_MMA(0, 0, At, B0); PG8_BAR; PG8_SCHED;
            PG8_LDB(B1, 0, 1); PG8_STAGE(PG8_SB(0, 0), b2, voffB);
            PG8_BAR; PG8_WAIT_L(0); PG8_MMA(0, 1, At, B1); PG8_BAR;
            PG8_LDA(At, 0, 1); PG8_STAGE(PG8_SA(0, 0), a2, voffA);
            PG8_BAR; PG8_WAIT_L(0); PG8_MMA(1, 0, At, B0); PG8_BAR; PG8_SCHED;
            PG8_STAGE(PG8_SB(0, 1), b2 + hstep, voffB);
            PG8_WAIT_V(6); PG8_BAR; PG8_MMA(1, 1, At, B1); PG8_BAR;
            PG8_LDB(B0, 1, 0); PG8_SCHED; PG8_LDA(At, 1, 0); PG8_STAGE(PG8_SA(0, 1), a2 + hstep, voffA);
            PG8_WAIT_L(8); PG8_BAR; PG8_WAIT_L(0); PG8_MMA(0, 0, At, B0); PG8_BAR; PG8_SCHED;
            PG8_LDB(B1, 1, 1); PG8_STAGE(PG8_SB(1, 0), b3, voffB);
            PG8_BAR; PG8_WAIT_L(0); PG8_MMA(0, 1, At, B1); PG8_BAR;
            PG8_LDA(At, 1, 1); PG8_STAGE(PG8_SA(1, 0), a3, voffA);
            PG8_BAR; PG8_WAIT_L(0); PG8_MMA(1, 0, At, B0); PG8_BAR; PG8_SCHED;
            PG8_STAGE(PG8_SB(1, 1), b3 + hstep, voffB);
            PG8_WAIT_V(6); PG8_BAR; PG8_MMA(1, 1, At, B1); PG8_BAR;
        }
        PG8_STAMP();
        if constexpr (!Epi::AFTER_DRAIN) { E(acc, cur, wr, wc, fr, fq); S.done(cur); }
        PG8_STAMP();
        if (!has_next) break;
#pragma unroll
        for (int a = 0; a < 2; ++a)
#pragma unroll
            for (int b = 0; b < 2; ++b)
#pragma unroll
                for (int m = 0; m < 4; ++m)
#pragma unroll
                    for (int n = 0; n < 2; ++n) acc[a][b][m][n] = (f32x4){0.f, 0.f, 0.f, 0.f};
        cur = nxt; cA = nA; cB = nB; ++ui;
    }
    PG8_WAIT_V(0);
    if (wr == 0) PG8_BAR;
    PG8_BAR;
    if constexpr (Epi::AFTER_DRAIN) { E.fused(acc, cur, wr, wc, fr, fq, lds, wid, lane); S.done(cur); }
    PG8_STAMP();
    if (STAMP && wid == 0) { stamps[lane] = lane < nts ? (((unsigned long long)(unsigned)ts_hi << 32) | (unsigned)ts_lo) : 0ull;
        if (lane == 62) stamps[62] = rt_entry; if (lane == 63) stamps[63] = (unsigned long long)wall_clock64(); }
#undef PG8_STAMP
#undef PG8_SA
#undef PG8_SB
#undef PG8_STAGE
#undef PG8_LDA
#undef PG8_LDB
#undef PG8_MMA
#undef PG8_WAIT_V
#undef PG8_WAIT_L
#undef PG8_BAR
#undef PG8_SCHED
}
}

__device__ __forceinline__ int sched256(int i, int T) {
    const int x = RBID & 7, lb = RBID >> 3, nlb = RGRID >> 3;
    const int chunk = (T + 7) >> 3, local = lb + i * nlb;
    if (local >= chunk) return -1;
    const int t = x * chunk + local;
    return t < T ? t : -1;
}
#define W8V const int w8_ = __builtin_amdgcn_readfirstlane(RTID >> 6), wm2_ = w8_ >> 2, wn4_ = w8_ & 3; const int half_ = w8_ >> 2; (void)half_
__device__ __forceinline__ float fq_sum(float v) { v += __shfl_xor(v, 16); v += __shfl_xor(v, 32); return v; }
__device__ __forceinline__ float fq_max(float v) { v = fmaxf(v, __shfl_xor(v, 16)); v = fmaxf(v, __shfl_xor(v, 32)); return v; }

#define WSP(T, off) ((T*)(p.ws + (off)))
#define TIDV const int tid = VTID, lane = tid & 63, wid = __builtin_amdgcn_readfirstlane(tid >> 6), wm = wid >> 1, wn = wid & 1, fr = lane & 15, fq = lane >> 4; (void)wm; (void)wn; (void)fr; (void)fq; (void)lane; (void)wid

__device__ __forceinline__ void p0_transpose(const Params& p, int item, LAS char* lds) {
    TIDV;
    LAS float* tile = (LAS float*)lds;
    int r = item; const float* s0; const float* s1 = nullptr; const float* ksc = nullptr; bf16_t* dst; int K = 1024, NT, ld, mode = 0, kso = 0, nvalid; float mul = 1.f;
    if (r < 704) { s0 = p.in[8]; dst = WSP(bf16_t, W_WIN); NT = 44; ld = 2568; nvalid = 2568; }
    else if ((r -= 704) < 512) { s0 = p.in[23]; s1 = p.in[24]; dst = WSP(bf16_t, W_WKV); mode = 1; NT = 32; ld = 1024; nvalid = 2048; }
    else if ((r -= 512) < 256) { s0 = p.in[19]; dst = WSP(bf16_t, W_WOUT); ksc = p.in[18]; kso = 512; NT = 16; ld = 1024; nvalid = 1024; }
    else if ((r -= 256) < 256) { s0 = p.in[22]; dst = WSP(bf16_t, W_WQ); ksc = p.in[20]; mul = 0.0625f; NT = 16; ld = 1024; nvalid = 1024; }
    else if ((r -= 256) < 256) { s0 = p.in[25]; dst = WSP(bf16_t, W_WXO); NT = 16; ld = 1024; nvalid = 1024; }
    else if ((r -= 256) < 1408) { s0 = p.in[27]; s1 = p.in[28]; dst = WSP(bf16_t, W_WGU); mode = 2; ksc = p.in[26]; NT = 88; ld = 2816; nvalid = 5632; }
    else { r -= 1408; s0 = p.in[29]; dst = WSP(bf16_t, W_WD); K = 2816; NT = 16; ld = 1024; nvalid = 1024; }
    const int kt = r / NT, nt = r - kt * NT, k0 = kt * 64, n0 = nt * 64;
    {
        const int tn = (tid & 15) * 4, tk = tid >> 4, n = n0 + tn;
        const float* src = s0; size_t coff = 0; const bool valid = n < nvalid;
        if (mode == 0) coff = n;
        else if (mode == 1) { if (n >= 1024) { src = s1; coff = n - 1024; } else coff = n; }
        else { const int grp = n >> 5, w = n & 31; coff = grp * 16 + (w & 15); if (w >> 4) src = s1; }
        f32x4 v[4];
#pragma unroll
        for (int i = 0; i < 4; ++i) { const int k = k0 + tk + 16 * i; v[i] = valid ? *(const f32x4*)(src + (size_t)k * ld + coff) : (f32x4){0.f, 0.f, 0.f, 0.f}; }
#pragma unroll
        for (int i = 0; i < 4; ++i) {
            const int k = k0 + tk + 16 * i;
            float sc_ = mul; if (ksc && k >= kso) sc_ *= ksc[k - kso];
            LAS float* t_ = tile + (tk + 16 * i) * 65 + tn;
            t_[0] = v[i][0] * sc_; t_[1] = v[i][1] * sc_; t_[2] = v[i][2] * sc_; t_[3] = v[i][3] * sc_;
        }
    }
    __syncthreads();
    {
        const int c = tid & 7, nl = tid >> 3;
#pragma unroll
        for (int j = 0; j < 2; ++j) {
            const int n = nl + 32 * j;
            const LAS float* s = tile + (c * 8) * 65 + n;
            u32x4 o; o.x = pk2(s[0], s[65]); o.y = pk2(s[2 * 65], s[3 * 65]); o.z = pk2(s[4 * 65], s[5 * 65]); o.w = pk2(s[6 * 65], s[7 * 65]);
            *(u32x4*)(dst + (size_t)(n0 + n) * K + k0 + c * 8) = o;
        }
    }
    __syncthreads();
}
__device__ __forceinline__ void p0_rownorm(const Params& p, int ri) {
    TIDV;
    const int row = ri * 4 + wid;
    const float* src; const float* g; bf16_t* dst;
    if (row < MT) { src = row < MP ? p.in[0] + (size_t)row * 1024 : p.in[1] + (size_t)(row - MP) * 1024; g = p.in[7]; dst = WSP(bf16_t, W_XB) + (size_t)row * 1024; }
    else { const int r2 = row - MT; src = p.in[6] + (size_t)r2 * 1024; g = p.in[21]; dst = WSP(bf16_t, W_MEMB) + (size_t)r2 * 1024; }
    float4 v[4]; float ss = 0.f;
#pragma unroll
    for (int j = 0; j < 4; ++j) { v[j] = *(const float4*)(src + (j * 64 + lane) * 4); ss += v[j].x * v[j].x + v[j].y * v[j].y + v[j].z * v[j].z + v[j].w * v[j].w; }
    const float rstd = rsqrtf(wave_sum(ss) * (1.f / 1024.f) + EPS);
#pragma unroll
    for (int j = 0; j < 4; ++j) {
        const float4 gv = *(const float4*)(g + (j * 64 + lane) * 4);
        u32x2 o; o.x = pk2(v[j].x * rstd * gv.x, v[j].y * rstd * gv.y); o.y = pk2(v[j].z * rstd * gv.z, v[j].w * rstd * gv.w);
        *(u32x2*)(dst + (j * 64 + lane) * 4) = o;
    }
}
__device__ __forceinline__ void phase0(const Params& p, LAS char* lds) {
    const int gtid = VBID * 256 + VTID, gn = VGRID * 256;
    float* z = WSP(float, W_ZERO);
    for (int i = gtid; i < (int)ZERO_FLOATS; i += gn) z[i] = 0.f;
    bf16_t* wsb = WSP(bf16_t, W_WSB); const float* ws = p.in[11];
    for (int i = gtid; i < 4 * 128 * 128; i += gn) { const int s = i & 127, t = (i >> 7) & 127; wsb[i] = (s <= t) ? (bf16_t)(pk2(ws[i], 0.f) & 0xffffu) : (bf16_t)0; }
    for (int it = VBID; it < 4096 + 4640; it += VGRID) {
        if (it < 4096) p0_transpose(p, it, lds); else p0_rownorm(p, it - 4096);
    }
}

template <int NI>
__device__ __forceinline__ void p1_inproj_epi(const Params& p, f32x4 (&acc)[4][NI], const int rbw, const int cbw) {
    TIDV;
    const int n0 = cbw & ~127;
    const int rb = rbw + fr, cb = cbw + fq * 4;
    if (n0 < 512) {
        bf16_t* ub = WSP(bf16_t, W_UB);
#pragma unroll
        for (int mi = 0; mi < 4; ++mi)
#pragma unroll
            for (int ni = 0; ni < NI; ++ni) { const f32x4 a = acc[mi][ni]; u32x2 o; o.x = pk2(gelu_t(a[0]), gelu_t(a[1])); o.y = pk2(gelu_t(a[2]), gelu_t(a[3]));
                *(u32x2*)(ub + (size_t)(rb + mi * 16) * 512 + cb + ni * 16) = o; }
    } else if (n0 < 1024) {
        bf16_t* vg = WSP(bf16_t, W_VG); float* vstat = WSP(float, W_ZERO);
#pragma unroll
        for (int mi = 0; mi < 4; ++mi) {
            float s1 = 0.f, s2 = 0.f;
#pragma unroll
            for (int ni = 0; ni < NI; ++ni) { const f32x4 a = acc[mi][ni]; const float g0 = gelu_t(a[0]), g1 = gelu_t(a[1]), g2 = gelu_t(a[2]), g3 = gelu_t(a[3]);
                u32x2 o; o.x = pk2(g0, g1); o.y = pk2(g2, g3);
                const float r0 = bflo(o.x), r1 = bfhi(o.x), r2 = bflo(o.y), r3 = bfhi(o.y);
                s1 += (r0 + r1) + (r2 + r3); s2 += (r0 * r0 + r1 * r1) + (r2 * r2 + r3 * r3);
                *(u32x2*)(vg + (size_t)(rb + mi * 16) * 512 + (cb - 512) + ni * 16) = o; }
            s1 = fq_sum(s1); s2 = fq_sum(s2);
            if (fq == 0) { atomicAdd(vstat + (size_t)(rb + mi * 16) * 2, s1); atomicAdd(vstat + (size_t)(rb + mi * 16) * 2 + 1, s2); }
        }
    } else if (n0 < 1536) {
        bf16_t* zb = WSP(bf16_t, W_ZB);
#pragma unroll
        for (int mi = 0; mi < 4; ++mi)
#pragma unroll
            for (int ni = 0; ni < NI; ++ni) { const f32x4 a = acc[mi][ni]; u32x2 o; o.x = pk2(a[0], a[1]); o.y = pk2(a[2], a[3]);
                *(u32x2*)(zb + (size_t)(rb + mi * 16) * 512 + (cb - 1024) + ni * 16) = o; }
    } else if (n0 < 2560) {
        bf16_t* xb = WSP(bf16_t, W_XBCB);
#pragma unroll
        for (int mi = 0; mi < 4; ++mi) {
            const int row = rb + mi * 16;
            float* fo = nullptr;
            if (row < MP) { const int t = row & 2047; if (t >= 2045) fo = p.out + O_CONVP + ((size_t)(row >> 11) * 3 + (t - 2045)) * 1024; }
            else fo = p.out + O_CONVS + ((size_t)(row - MP) * 3 + 2) * 1024;
#pragma unroll
            for (int ni = 0; ni < NI; ++ni) { const f32x4 a = acc[mi][ni]; const int ch = cb - 1536 + ni * 16; u32x2 o; o.x = pk2(a[0], a[1]); o.y = pk2(a[2], a[3]);
                *(u32x2*)(xb + (size_t)row * 1024 + ch) = o;
                if (fo) *(f32x4*)(fo + ch) = a; }
        }
    } else {
        float* dtr = WSP(float, W_DTRAW);
        if (cbw == 2560 && fq < 2) {
#pragma unroll
            for (int mi = 0; mi < 4; ++mi) *(f32x4*)(dtr + (size_t)(rb + mi * 16) * 8 + fq * 4) = acc[mi][0];
        }
    }
}
template <int NI>
__device__ __forceinline__ void p1_memkv_epi(const Params& p, f32x4 (&acc)[4][NI], const int rbw, const int cbw) {
    TIDV;
    const int n0 = cbw & ~127;
    const int rb = rbw + fr, cb = cbw + fq * 4;
    if (n0 < 1024) {
        bf16_t* kb = WSP(bf16_t, W_KB);
#pragma unroll
        for (int mi = 0; mi < 4; ++mi)
#pragma unroll
            for (int ni = 0; ni < NI; ++ni) { const f32x4 a = acc[mi][ni]; const size_t o_ = (size_t)(rb + mi * 16) * 1024 + cb + ni * 16;
                *(f32x4*)(p.out + O_MK + o_) = a; u32x2 o; o.x = pk2(a[0], a[1]); o.y = pk2(a[2], a[3]); *(u32x2*)(kb + o_) = o; }
    } else {
        bf16_t* vT = WSP(bf16_t, W_VT);
#pragma unroll
        for (int mi = 0; mi < 4; ++mi)
#pragma unroll
            for (int ni = 0; ni < NI; ++ni) { const f32x4 a = acc[mi][ni]; const int row = rb + mi * 16, c = cb - 1024 + ni * 16;
                *(f32x4*)(p.out + O_MV + (size_t)row * 1024 + c) = a;
                const int b = row >> 8, m = row & 255, head = c >> 8, d = c & 255;
                bf16_t* vp = vT + ((size_t)(b * 4 + head) * 256 + d) * 256 + m;
                const unsigned q0 = pk2(a[0], a[1]), q1 = pk2(a[2], a[3]);
                vp[0] = (bf16_t)(q0 & 0xffffu); vp[256] = (bf16_t)(q0 >> 16); vp[512] = (bf16_t)(q1 & 0xffffu); vp[768] = (bf16_t)(q1 >> 16); }
    }
}
__device__ __forceinline__ void phase1(const Params& p, LAS char* lds, LAS char* ldsh) {
    W8V;
    constexpr int T1 = 64 * 11, T2 = 8 * 8;
    int t;
    for (int i = 0; (t = sched256(i, T1 + T2)) >= 0; ++i) {
        f32x4 acc0[4][4], acc1[4][4]; zero_acc<4>(acc0); zero_acc<4>(acc1);
        int mp, nt;
        if (t < T1) {
            tile_mn(t, 64, 11, mp, nt);
            mma256(acc0, acc1, WSP(bf16_t, W_XB) + (size_t)mp * 256 * 1024, 1024, WSP(bf16_t, W_WIN) + (size_t)nt * 256 * 1024, 1024, 1024, lds);
            const int rb0 = mp * 256 + wm2_ * 128, cbw = nt * 256 + wn4_ * 64;
            p1_inproj_epi<4>(p, acc0, rb0, cbw); p1_inproj_epi<4>(p, acc1, rb0 + 64, cbw);
        } else {
            tile_mn(t - T1, 8, 8, mp, nt);
            mma256(acc0, acc1, WSP(bf16_t, W_MEMB) + (size_t)mp * 256 * 1024, 1024, WSP(bf16_t, W_WKV) + (size_t)nt * 256 * 1024, 1024, 1024, lds);
            const int rb0 = mp * 256 + wm2_ * 128, cbw = nt * 256 + wn4_ * 64;
            p1_memkv_epi<4>(p, acc0, rb0, cbw); p1_memkv_epi<4>(p, acc1, rb0 + 64, cbw);
        }
    }
    if (RBID < 11) {
        const int j = RBID * 2 + half_, jj = j < 21 ? j : 20;
        const int wv_ = __builtin_amdgcn_readfirstlane(VTID >> 6), wmv = wv_ >> 1, wnv = wv_ & 1;
        f32x4 acc[4][4]; zero_acc<4>(acc);
        mma_seg<128, 0>(acc, WSP(bf16_t, W_XB) + (size_t)MP * 1024, 1024, WSP(bf16_t, W_WIN) + (size_t)jj * 128 * 1024, 1024, 1024, ldsh, nullptr);
        if (j < 21) p1_inproj_epi<4>(p, acc, MP + wmv * 64, jj * 128 + wnv * 64);
    }
}

__device__ __forceinline__ void p2_conv(const Params& p, int item, LAS char* lds) {
    TIDV;
    const int cc = item >> 4, slab = item & 15, c = cc & 15, tok0 = cc * 128, ch0 = slab * 64;
    const int cgp = tid & 7, r0 = tid >> 3;
    LAS float* s_acum = (LAS float*)(lds + 40960); LAS float* s_dt = s_acum + 128; LAS float* s_tot = s_acum + 256;
    if (slab < 8) {
        const int h = slab;
        float v = 0.f, dtv = 0.f;
        if (tid < 128) {
            dtv = softplus_f(WSP(float, W_DTRAW)[(size_t)(tok0 + tid) * 8 + h] + p.in[15][h]);
            v = dtv * (-expf(p.in[16][h]));
#pragma unroll
            for (int d = 1; d < 64; d <<= 1) { const float t = __shfl_up(v, d); if (lane >= d) v += t; }
            if (lane == 63) s_tot[wid] = v;
        }
        __syncthreads();
        if (tid < 128) {
            if (wid == 1) v += s_tot[0];
            s_acum[tid] = v; s_dt[tid] = dtv;
            WSP(float, W_ACUM)[(size_t)(cc * 8 + h) * 128 + tid] = v;
            WSP(float, W_DTV)[(size_t)(cc * 8 + h) * 128 + tid] = dtv;
        }
        __syncthreads();
    }
    const bf16_t* xin = WSP(bf16_t, W_XBCB);
    const int chb = ch0 + cgp * 8;
    u32x4 rin[7];
#pragma unroll
    for (int i = 0; i < 7; ++i) {
        const int rr = r0 * 4 - 3 + i;
        if (rr < 0 && c == 0) rin[i] = (u32x4){0u, 0u, 0u, 0u};
        else rin[i] = *(const u32x4*)(xin + (size_t)(tok0 + rr) * 1024 + chb);
    }
    const float* cw = p.in[13]; const float* cbp = p.in[14];
    float o[4][8];
#pragma unroll
    for (int e = 0; e < 8; ++e) {
        const float w0 = cw[chb + e], w1 = cw[1024 + chb + e], w2 = cw[2048 + chb + e], w3 = cw[3072 + chb + e], bb = cbp[chb + e];
        float xin_[7];
#pragma unroll
        for (int i = 0; i < 7; ++i) { const unsigned u = (e >> 1) == 0 ? rin[i].x : (e >> 1) == 1 ? rin[i].y : (e >> 1) == 2 ? rin[i].z : rin[i].w; xin_[i] = (e & 1) ? bfhi(u) : bflo(u); }
#pragma unroll
        for (int r = 0; r < 4; ++r) o[r][e] = silu_f(bb + xin_[r] * w0 + xin_[r + 1] * w1 + xin_[r + 2] * w2 + xin_[r + 3] * w3);
    }
    {
        bf16_t* dstn; int ldn, cofs;
        if (slab < 8) { dstn = WSP(bf16_t, W_XN); ldn = 512; cofs = chb; }
        else if (slab < 12) { dstn = WSP(bf16_t, W_BN); ldn = 256; cofs = chb - 512; }
        else { dstn = WSP(bf16_t, W_CN); ldn = 256; cofs = chb - 768; }
#pragma unroll
        for (int r = 0; r < 4; ++r) { u32x4 q; q.x = pk2(o[r][0], o[r][1]); q.y = pk2(o[r][2], o[r][3]); q.z = pk2(o[r][4], o[r][5]); q.w = pk2(o[r][6], o[r][7]);
            *(u32x4*)(dstn + (size_t)(tok0 + r0 * 4 + r) * ldn + cofs) = q; }
    }
    if (slab < 12) {
        float wv[4] = {1.f, 1.f, 1.f, 1.f};
        if (slab < 8) { const float al_ = s_acum[127];
#pragma unroll
            for (int r = 0; r < 4; ++r) wv[r] = __expf(al_ - s_acum[r0 * 4 + r]) * s_dt[r0 * 4 + r]; }
#pragma unroll
        for (int e = 0; e < 8; ++e) {
            u32x2 q; q.x = pk2(o[0][e], o[1][e]); q.y = pk2(o[2][e], o[3][e]);
            *(LAS u32x2*)(lds + (cgp * 8 + e) * 256 + r0 * 8) = q;
            if (slab < 8) { u32x2 q2; q2.x = pk2(o[0][e] * wv[0], o[1][e] * wv[1]); q2.y = pk2(o[2][e] * wv[2], o[3][e] * wv[3]);
                *(LAS u32x2*)(lds + 16384 + (cgp * 8 + e) * 256 + r0 * 8) = q2; }
        }
        __syncthreads();
        bf16_t* d1; bf16_t* d2 = nullptr; size_t rowbase;
        if (slab < 8) { d1 = WSP(bf16_t, W_XT); d2 = WSP(bf16_t, W_XWT); rowbase = (size_t)(cc * 8 + slab) * 64; }
        else { const int g = (slab - 8) >> 1, half = (slab - 8) & 1; d1 = WSP(bf16_t, W_BT); rowbase = (size_t)(cc * 2 + g) * 128 + half * 64; }
#pragma unroll
        for (int i = 0; i < 4; ++i) {
            const int id = tid + 256 * i, pr = id >> 4, scn = id & 15;
            *(u32x4*)(d1 + (rowbase + pr) * 128 + scn * 8) = *(LAS u32x4*)(lds + pr * 256 + scn * 16);
            if (slab < 8) *(u32x4*)(d2 + (rowbase + pr) * 128 + scn * 8) = *(LAS u32x4*)(lds + 16384 + pr * 256 + scn * 16);
        }
    }
    __syncthreads();
}
__device__ __forceinline__ void p2_vln(const Params& p, int item, LAS char* lds) {
    TIDV;
    const int cc = item >> 2, head = item & 3, c = cc & 15, b = cc >> 4, tok0 = cc * 128;
    const int cgp = tid & 15, r0 = tid >> 4;
    const int chb = head * 128 + cgp * 8;
    const bf16_t* vg = WSP(bf16_t, W_VG); const float* vstat = WSP(float, W_ZERO);
    float lg[8], lb[8];
#pragma unroll
    for (int e = 0; e < 8; ++e) { lg[e] = p.in[9][chb + e]; lb[e] = p.in[10][chb + e]; }
    float o[8][8];
#pragma unroll
    for (int r = 0; r < 8; ++r) {
        const int tok = tok0 + r0 * 8 + r;
        const u32x4 q = *(const u32x4*)(vg + (size_t)tok * 512 + chb);
        const float mean = vstat[(size_t)tok * 2] * (1.f / 512.f);
        const float var = vstat[(size_t)tok * 2 + 1] * (1.f / 512.f) - mean * mean;
        const float rstd = rsqrtf(fmaxf(var, 0.f) + EPS);
        const float xv[8] = {bflo(q.x), bfhi(q.x), bflo(q.y), bfhi(q.y), bflo(q.z), bfhi(q.z), bflo(q.w), bfhi(q.w)};
#pragma unroll
        for (int e = 0; e < 8; ++e) o[r][e] = (xv[e] - mean) * rstd * lg[e] + lb[e];
        if (c == 15) {
            float* go = p.out + O_GVP + ((size_t)(b * 128 + r0 * 8 + r)) * 512 + chb;
            *(f32x4*)go = (f32x4){o[r][0], o[r][1], o[r][2], o[r][3]}; *(f32x4*)(go + 4) = (f32x4){o[r][4], o[r][5], o[r][6], o[r][7]};
        }
    }
#pragma unroll
    for (int e = 0; e < 8; ++e) {
        u32x4 q; q.x = pk2(o[0][e], o[1][e]); q.y = pk2(o[2][e], o[3][e]); q.z = pk2(o[4][e], o[5][e]); q.w = pk2(o[6][e], o[7][e]);
        *(LAS u32x4*)(lds + (cgp * 8 + e) * 256 + r0 * 16) = q;
    }
    __syncthreads();
    bf16_t* dst = WSP(bf16_t, W_VLNT) + (size_t)(cc * 4 + head) * 128 * 128;
#pragma unroll
    for (int i = 0; i < 8; ++i) { const int id = tid + 256 * i, pr = id >> 4, scn = id & 15;
        *(u32x4*)(dst + (size_t)pr * 128 + scn * 8) = *(LAS u32x4*)(lds + pr * 256 + scn * 16); }
    __syncthreads();
}
__device__ __forceinline__ void p2_sample_ssd(const Params& p, int item, LAS char* lds) {
    TIDV;
    const int bs = item >> 3, h = item & 7, g = h >> 2;
    LAS float* s_x = (LAS float*)lds; LAS float* s_B = s_x + 64; LAS float* s_C = s_B + 128; LAS float* s_y = s_C + 128;
    const float* scv = p.in[3] + (size_t)bs * 3 * 1024;
    const float* xrow = p.out + O_CONVS + ((size_t)bs * 3 + 2) * 1024;
    const float* cw = p.in[13]; const float* cbp = p.in[14];
    for (int idx = tid; idx < 320; idx += 256) {
        int ch; if (idx < 64) ch = h * 64 + idx; else if (idx < 192) ch = 512 + g * 128 + (idx - 64); else ch = 768 + g * 128 + (idx - 192);
        const float v = cbp[ch] + scv[ch] * cw[ch] + scv[1024 + ch] * cw[1024 + ch] + scv[2048 + ch] * cw[2048 + ch] + xrow[ch] * cw[3072 + ch];
        s_x[idx] = silu_f(v);
    }
    __syncthreads();
    const float dt = softplus_f(WSP(float, W_DTRAW)[(size_t)(MP + bs) * 8 + h] + p.in[15][h]);
    const float dA = expf(dt * (-expf(p.in[16][h])));
    const int l = tid & 31, rg = tid >> 5;
    const f32x4 Bv = *(LAS f32x4*)(s_B + l * 4), Cv = *(LAS f32x4*)(s_C + l * 4);
    const float* h0 = p.in[2] + ((size_t)(bs * 8 + h) * 64) * 128;
    float* ho = p.out + O_SSMS + ((size_t)(bs * 8 + h) * 64) * 128;
    f32x4 hv[8];
#pragma unroll
    for (int i = 0; i < 8; ++i) hv[i] = __builtin_nontemporal_load((const f32x4*)(h0 + (size_t)(rg + 8 * i) * 128 + l * 4));
#pragma unroll
    for (int i = 0; i < 8; ++i) {
        const int pp = rg + 8 * i;
        const float dx = dt * s_x[pp];
        f32x4 hn = hv[i] * dA + Bv * dx;
        __builtin_nontemporal_store(hn, (f32x4*)(ho + (size_t)pp * 128 + l * 4));
        float y = hn[0] * Cv[0] + hn[1] * Cv[1] + hn[2] * Cv[2] + hn[3] * Cv[3];
        y += __shfl_xor(y, 16); y += __shfl_xor(y, 8); y += __shfl_xor(y, 4); y += __shfl_xor(y, 2); y += __shfl_xor(y, 1);
        if (l == 0) s_y[pp] = y;
    }
    __syncthreads();
    if (tid < 64) {
        const float xv = s_x[tid];
        const float y = s_y[tid] + p.in[17][h] * xv;
        const float z = bf2f(WSP(bf16_t, W_ZB)[(size_t)(MP + bs) * 512 + h * 64 + tid]);
        const float yz = y * silu_f(z);
        const unsigned q = pk2(yz, 0.f) & 0xffffu;
        WSP(bf16_t, W_CONCAT)[(size_t)(MP + bs) * 1024 + 512 + h * 64 + tid] = (bf16_t)q;
        const float yr = bflo(q);
        const float ssq = wave_sum(yr * yr);
        if (tid == 0) atomicAdd(WSP(float, W_ZERO) + (size_t)MT * 2 + (size_t)(MP + bs) * 2 + g, ssq);
    }
    __syncthreads();
}
__device__ __forceinline__ void p2_sample_misc(const Params& p, int bs) {
    TIDV;
    const float* vstat = WSP(float, W_ZERO);
    const int tok = MP + bs;
    const float mean = vstat[(size_t)tok * 2] * (1.f / 512.f);
    const float var = vstat[(size_t)tok * 2 + 1] * (1.f / 512.f) - mean * mean;
    const float rstd = rsqrtf(fmaxf(var, 0.f) + EPS);
    for (int ch = tid; ch < 512; ch += 256) {
        const int hd = ch >> 7;
        const float v = bf2f(WSP(bf16_t, W_VG)[(size_t)tok * 512 + ch]);
        const float vl = (v - mean) * rstd * p.in[9][ch] + p.in[10][ch];
        p.out[O_GVS + (size_t)bs * 512 + ch] = vl;
        const float u = bf2f(WSP(bf16_t, W_UB)[(size_t)tok * 512 + ch]);
        const float gout = u * (p.in[11][hd * 128 * 128] * vl + p.in[12][hd * 128]);
        WSP(bf16_t, W_CONCAT)[(size_t)tok * 1024 + ch] = (bf16_t)(pk2(gout, 0.f) & 0xffffu);
    }
    const float* scv = p.in[3] + (size_t)bs * 3 * 1024;
    float* co = p.out + O_CONVS + (size_t)bs * 3 * 1024;
    for (int i = tid; i < 2048; i += 256) co[i] = scv[1024 + i];
}
__device__ __forceinline__ void phase2(const Params& p, LAS char* lds) {
    constexpr int N1 = 1024, N2 = 2048, N3 = 512, N4 = 128;
    for (int it = VBID; it < N1 + N2 + N3 + N4; it += VGRID) {
        if (it < N1) p2_sample_ssd(p, it, lds);
        else if (it < N1 + N2) p2_conv(p, it - N1, lds);
        else if (it < N1 + N2 + N3) p2_vln(p, it - N1 - N2, lds);
        else p2_sample_misc(p, it - N1 - N2 - N3);
    }
}

__device__ __forceinline__ void p3_cb(const Params& p, int item, LAS char* lds) {
    TIDV;
    const int cc = item >> 2, g = (item >> 1) & 1, hpair = item & 1, tok0 = cc * 128;
    f32x4 acc[4][4]; zero_acc<4>(acc);
    mma_seg<128, 0>(acc, WSP(bf16_t, W_CN) + (size_t)tok0 * 256 + g * 128, 256, WSP(bf16_t, W_BN) + (size_t)tok0 * 256 + g * 128, 256, 128, lds, nullptr);
    const int tb = wm * 64 + fr, sb = wn * 64 + fq * 4;
#pragma unroll 1
    for (int jh2 = 0; jh2 < 2; ++jh2) {
        const int h = g * 4 + hpair * 2 + jh2;
        const float* ac = WSP(float, W_ACUM) + (size_t)(cc * 8 + h) * 128;
        const float* dv = WSP(float, W_DTV) + (size_t)(cc * 8 + h) * 128;
        bf16_t* mt_ = WSP(bf16_t, W_MT) + (size_t)(cc * 8 + h) * 128 * 128;
        float at[4];
#pragma unroll
        for (int mi = 0; mi < 4; ++mi) at[mi] = ac[tb + mi * 16];
#pragma unroll
        for (int ni = 0; ni < 4; ++ni) {
            const f32x4 as = *(const f32x4*)(ac + sb + ni * 16), ds = *(const f32x4*)(dv + sb + ni * 16);
#pragma unroll
            for (int mi = 0; mi < 4; ++mi) {
                const int t = tb + mi * 16, s0 = sb + ni * 16;
                float v[4];
#pragma unroll
                for (int j = 0; j < 4; ++j) v[j] = (s0 + j <= t) ? acc[mi][ni][j] * __expf(at[mi] - as[j]) * ds[j] : 0.f;
                u32x2 o; o.x = pk2(v[0], v[1]); o.y = pk2(v[2], v[3]);
                *(u32x2*)(mt_ + (size_t)t * 128 + s0) = o;
            }
        }
    }
}
__device__ __forceinline__ void p3_gmlp(const Params& p, int item, LAS char* lds) {
    TIDV;
    const int cc = item >> 2, head = item & 3, tok0 = cc * 128;
    f32x4 acc[4][4]; zero_acc<4>(acc);
    mma_seg<128, 0>(acc, WSP(bf16_t, W_WSB) + (size_t)head * 128 * 128, 128, WSP(bf16_t, W_VLNT) + (size_t)(cc * 4 + head) * 128 * 128, 128, 128, lds, nullptr);
    const int tb = wm * 64 + fr, db = wn * 64 + fq * 4;
    const bf16_t* ub = WSP(bf16_t, W_UB); bf16_t* cat = WSP(bf16_t, W_CONCAT);
#pragma unroll
    for (int mi = 0; mi < 4; ++mi) {
        const int t = tb + mi * 16;
        const float bias = p.in[12][head * 128 + t];
#pragma unroll
        for (int ni = 0; ni < 4; ++ni) {
            const int d = db + ni * 16;
            const u32x2 uq = *(const u32x2*)(ub + (size_t)(tok0 + t) * 512 + head * 128 + d);
            const f32x4 a = acc[mi][ni];
            u32x2 o; o.x = pk2((a[0] + bias) * bflo(uq.x), (a[1] + bias) * bfhi(uq.x)); o.y = pk2((a[2] + bias) * bflo(uq.y), (a[3] + bias) * bfhi(uq.y));
            *(u32x2*)(cat + (size_t)(tok0 + t) * 1024 + head * 128 + d) = o;
        }
    }
}
__device__ __forceinline__ void p3_states(const Params& p, int item, LAS char* lds) {
    TIDV;
    const int cc = item >> 3, h = item & 7, g = h >> 2;
    f32x4 acc[4][2]; zero_acc<2>(acc);
    mma_seg<64, 0>(acc, WSP(bf16_t, W_BT) + (size_t)(cc * 2 + g) * 128 * 128, 128, WSP(bf16_t, W_XWT) + (size_t)(cc * 8 + h) * 64 * 128, 128, 128, lds, nullptr);
    float* sc = WSP(float, W_SC) + (size_t)(cc * 8 + h) * 64 * 128;
    const int nb = wm * 64 + fr, pb = wn * 32 + fq * 4;
#pragma unroll
    for (int mi = 0; mi < 4; ++mi)
#pragma unroll
        for (int ni = 0; ni < 2; ++ni)
#pragma unroll
            for (int j = 0; j < 4; ++j) sc[(size_t)(pb + ni * 16 + j) * 128 + nb + mi * 16] = acc[mi][ni][j];
}
__device__ __forceinline__ void phase3(const Params& p, LAS char* lds) {
    constexpr int N1 = 512, N2 = 512, N3 = 1024;
    for (int it = VBID; it < N1 + N2 + N3; it += VGRID) {
        if (it < N1) p3_cb(p, it, lds);
        else if (it < N1 + N2) p3_gmlp(p, it - N1, lds);
        else p3_states(p, it - N1 - N2, lds);
    }
}

__device__ __forceinline__ void phase4(const Params& p) {
    for (int it = VBID; it < 512; it += VGRID) {
        const int idx4 = it * 256 + VTID;
        const int bh = idx4 >> 11, rem = (idx4 & 2047) * 4, b = bh >> 3, h = bh & 7;
        const float* sc = WSP(float, W_SC); bf16_t* hp_ = WSP(bf16_t, W_HPREV); const float* ac = WSP(float, W_ACUM);
        f32x4 sv[16]; float dec[16];
#pragma unroll
        for (int c = 0; c < 16; ++c) {
            sv[c] = *(const f32x4*)(sc + ((size_t)((b * 16 + c) * 8 + h)) * 8192 + rem);
            dec[c] = ac[(size_t)((b * 16 + c) * 8 + h) * 128 + 127];
        }
        f32x4 st = {0.f, 0.f, 0.f, 0.f};
#pragma unroll
        for (int c = 0; c < 16; ++c) {
            const size_t base = ((size_t)((b * 16 + c) * 8 + h)) * 8192 + rem;
            u32x2 o; o.x = pk2(st[0], st[1]); o.y = pk2(st[2], st[3]);
            *(u32x2*)(hp_ + base) = o;
            st = st * __expf(dec[c]) + sv[c];
        }
        *(f32x4*)(p.out + O_SSMP + (size_t)idx4 * 4) = st;
    }
}

__device__ __forceinline__ void p5_y(const Params& p, int item, LAS char* lds) {
    TIDV;
    const int cc = item >> 3, h = item & 7, g = h >> 2, tok0 = cc * 128;
    f32x4 acc[4][2]; zero_acc<2>(acc);
    mma_seg<64, 0>(acc, WSP(bf16_t, W_CN) + (size_t)tok0 * 256 + g * 128, 256, WSP(bf16_t, W_HPREV) + (size_t)(cc * 8 + h) * 64 * 128, 128, 128, lds, nullptr);
    const float* ac = WSP(float, W_ACUM) + (size_t)(cc * 8 + h) * 128;
    const int tb = wm * 64 + fr, pb = wn * 32 + fq * 4;
#pragma unroll
    for (int mi = 0; mi < 4; ++mi) { const float e = __expf(ac[tb + mi * 16]);
#pragma unroll
        for (int ni = 0; ni < 2; ++ni) acc[mi][ni] = acc[mi][ni] * e; }
    mma_seg<64, 0>(acc, WSP(bf16_t, W_MT) + (size_t)(cc * 8 + h) * 128 * 128, 128, WSP(bf16_t, W_XT) + (size_t)(cc * 8 + h) * 64 * 128, 128, 128, lds, nullptr);
    const float dsk = p.in[17][h];
    const bf16_t* xn = WSP(bf16_t, W_XN); const bf16_t* zb = WSP(bf16_t, W_ZB); bf16_t* cat = WSP(bf16_t, W_CONCAT);
    float* gss = WSP(float, W_ZERO) + (size_t)MT * 2;
#pragma unroll
    for (int mi = 0; mi < 4; ++mi) {
        const int tok = tok0 + tb + mi * 16;
        float ssq = 0.f;
#pragma unroll
        for (int ni = 0; ni < 2; ++ni) {
            const int pc = h * 64 + pb + ni * 16;
            const u32x2 xq = *(const u32x2*)(xn + (size_t)tok * 512 + pc), zq = *(const u32x2*)(zb + (size_t)tok * 512 + pc);
            const f32x4 a = acc[mi][ni];
            const float y0 = (a[0] + dsk * bflo(xq.x)) * silu_f(bflo(zq.x)), y1 = (a[1] + dsk * bfhi(xq.x)) * silu_f(bfhi(zq.x));
            const float y2 = (a[2] + dsk * bflo(xq.y)) * silu_f(bflo(zq.y)), y3 = (a[3] + dsk * bfhi(xq.y)) * silu_f(bfhi(zq.y));
            u32x2 o; o.x = pk2(y0, y1); o.y = pk2(y2, y3);
            const float r0 = bflo(o.x), r1 = bfhi(o.x), r2 = bflo(o.y), r3 = bfhi(o.y);
            ssq += (r0 * r0 + r1 * r1) + (r2 * r2 + r3 * r3);
            *(u32x2*)(cat + (size_t)tok * 1024 + 512 + pc) = o;
        }
        ssq = fq_sum(ssq);
        if (fq == 0) atomicAdd(gss + (size_t)tok * 2 + g, ssq);
    }
}
__device__ __forceinline__ void phase5(const Params& p, LAS char* lds) {
    for (int it = VBID; it < 1024; it += VGRID) p5_y(p, it, lds);
}

template <int MODE, int NI>
__device__ __forceinline__ void res_epi(const Params& p, f32x4 (&acc)[4][NI], const int rbw, const int cbw) {
    TIDV;
    const int rb = rbw + fr, cb = cbw + fq * 4;
    float* hp = WSP(float, W_HP); bf16_t* hpb = WSP(bf16_t, W_HPB);
    float* ssq_ = WSP(float, W_ZERO) + (size_t)MT * 4 + (size_t)MT * MODE;
#pragma unroll
    for (int mi = 0; mi < 4; ++mi) {
        const int row = rb + mi * 16;
        const float* rsrc;
        if (MODE == 0) rsrc = row < MP ? p.in[0] + (size_t)row * 1024 : p.in[1] + (size_t)(row - MP) * 1024;
        else rsrc = hp + (size_t)row * 1024;
        float ssq = 0.f;
#pragma unroll
        for (int ni = 0; ni < NI; ++ni) {
            const int col = cb + ni * 16;
            const f32x4 r = *(const f32x4*)(rsrc + col);
            const f32x4 v = acc[mi][ni] + r;
            *(f32x4*)(hp + (size_t)row * 1024 + col) = v;
            ssq += (v[0] * v[0] + v[1] * v[1]) + (v[2] * v[2] + v[3] * v[3]);
            if (MODE != 2) { u32x2 o; o.x = pk2(v[0], v[1]); o.y = pk2(v[2], v[3]); *(u32x2*)(hpb + (size_t)row * 1024 + col) = o; }
        }
        if (MODE != 2) { ssq = fq_sum(ssq); if (fq == 0) atomicAdd(ssq_ + row, ssq); }
    }
}
template <int MODE>
__device__ __forceinline__ void phase_res(const Params& p, LAS char* lds, LAS char* ldsh) {
    W8V;
    const int lane_ = RTID & 63, fr_ = lane_ & 15;
    int t;
    for (int i = 0; (t = sched256(i, 64 * 4)) >= 0; ++i) {
        int mp, nt; tile_mn(t, 64, 4, mp, nt);
        f32x4 acc0[4][4], acc1[4][4]; zero_acc<4>(acc0); zero_acc<4>(acc1);
        const int rb0 = mp * 256 + wm2_ * 128, cbw = nt * 256 + wn4_ * 64;
        if (MODE == 0) {
            const bf16_t* Ab = WSP(bf16_t, W_CONCAT) + (size_t)mp * 256 * 1024; const bf16_t* Wb = WSP(bf16_t, W_WOUT) + (size_t)nt * 256 * 1024;
            const float* gss = WSP(float, W_ZERO) + (size_t)MT * 2;
            mma256(acc0, acc1, Ab + 512, 1024, Wb + 512, 1024, 256, lds);
#pragma unroll
            for (int mi = 0; mi < 4; ++mi) { const int ra = rb0 + mi * 16 + fr_, rbb = ra + 64;
                const float fa = rsqrtf(gss[(size_t)ra * 2] * (1.f / 256.f) + EPS) / rsqrtf(gss[(size_t)ra * 2 + 1] * (1.f / 256.f) + EPS);
                const float fb = rsqrtf(gss[(size_t)rbb * 2] * (1.f / 256.f) + EPS) / rsqrtf(gss[(size_t)rbb * 2 + 1] * (1.f / 256.f) + EPS);
#pragma unroll
                for (int ni = 0; ni < 4; ++ni) { acc0[mi][ni] = acc0[mi][ni] * fa; acc1[mi][ni] = acc1[mi][ni] * fb; } }
            mma256(acc0, acc1, Ab + 768, 1024, Wb + 768, 1024, 256, lds);
#pragma unroll
            for (int mi = 0; mi < 4; ++mi) { const int ra = rb0 + mi * 16 + fr_, rbb = ra + 64;
                const float r1a = rsqrtf(gss[(size_t)ra * 2 + 1] * (1.f / 256.f) + EPS), r1b = rsqrtf(gss[(size_t)rbb * 2 + 1] * (1.f / 256.f) + EPS);
#pragma unroll
                for (int ni = 0; ni < 4; ++ni) { acc0[mi][ni] = acc0[mi][ni] * r1a; acc1[mi][ni] = acc1[mi][ni] * r1b; } }
            mma256(acc0, acc1, Ab, 1024, Wb, 1024, 512, lds);
        } else if (MODE == 1) {
            mma256(acc0, acc1, WSP(bf16_t, W_OB) + (size_t)mp * 256 * 1024, 1024, WSP(bf16_t, W_WXO) + (size_t)nt * 256 * 1024, 1024, 1024, lds);
        } else {
            mma256(acc0, acc1, WSP(bf16_t, W_ACT) + (size_t)mp * 256 * 2816, 2816, WSP(bf16_t, W_WD) + (size_t)nt * 256 * 2816, 2816, 2816, lds);
        }
        res_epi<MODE, 4>(p, acc0, rb0, cbw); res_epi<MODE, 4>(p, acc1, rb0 + 64, cbw);
    }
    const int wv_ = __builtin_amdgcn_readfirstlane(VTID >> 6), wmv = wv_ >> 1, wnv = wv_ & 1, lanev = VTID & 63, frv = lanev & 15, fqv = lanev >> 4;
    if (MODE != 2) {
        if (RBID < 4) {
            const int j = RBID * 2 + half_, n0 = j * 128;
            f32x4 acc[4][4]; zero_acc<4>(acc);
            if (MODE == 0) {
                const bf16_t* Ab = WSP(bf16_t, W_CONCAT) + (size_t)MP * 1024; const bf16_t* Wb = WSP(bf16_t, W_WOUT) + (size_t)n0 * 1024;
                const float* gss = WSP(float, W_ZERO) + (size_t)MT * 2;
                float r0[4], r1[4];
#pragma unroll
                for (int mi = 0; mi < 4; ++mi) { const int row = MP + wmv * 64 + mi * 16 + frv;
                    r0[mi] = rsqrtf(gss[(size_t)row * 2] * (1.f / 256.f) + EPS); r1[mi] = rsqrtf(gss[(size_t)row * 2 + 1] * (1.f / 256.f) + EPS); }
                mma_seg<128, 0>(acc, Ab + 512, 1024, Wb + 512, 1024, 256, ldsh, nullptr);
#pragma unroll
                for (int mi = 0; mi < 4; ++mi) { const float f = r0[mi] / r1[mi];
#pragma unroll
                    for (int ni = 0; ni < 4; ++ni) acc[mi][ni] = acc[mi][ni] * f; }
                mma_seg<128, 0>(acc, Ab + 768, 1024, Wb + 768, 1024, 256, ldsh, nullptr);
#pragma unroll
                for (int mi = 0; mi < 4; ++mi)
#pragma unroll
                    for (int ni = 0; ni < 4; ++ni) acc[mi][ni] = acc[mi][ni] * r1[mi];
                mma_seg<128, 0>(acc, Ab, 1024, Wb, 1024, 512, ldsh, nullptr);
            } else {
                mma_seg<128, 0>(acc, WSP(bf16_t, W_OB) + (size_t)MP * 1024, 1024, WSP(bf16_t, W_WXO) + (size_t)n0 * 1024, 1024, 1024, ldsh, nullptr);
            }
            res_epi<MODE, 4>(p, acc, MP + wmv * 64, n0 + wnv * 64);
        }
    } else {
        if (RBID < 16) {
            const int j = RBID * 2 + half_, nt = j & 7, ks = j >> 3, n0 = nt * 128;
            f32x4 acc[4][4]; zero_acc<4>(acc);
            mma_seg<128, 0>(acc, WSP(bf16_t, W_ACT) + (size_t)MP * 2816 + ks * 704, 2816, WSP(bf16_t, W_WD) + (size_t)n0 * 2816 + ks * 704, 2816, 704, ldsh, nullptr);
            float* hp = WSP(float, W_HP);
            const int rb = MP + wmv * 64 + frv, cb = n0 + wnv * 64 + fqv * 4;
#pragma unroll
            for (int mi = 0; mi < 4; ++mi)
#pragma unroll
                for (int ni = 0; ni < 4; ++ni)
#pragma unroll
                    for (int jj = 0; jj < 4; ++jj) atomicAdd(hp + (size_t)(rb + mi * 16) * 1024 + cb + ni * 16 + jj, acc[mi][ni][jj]);
        }
    }
}

template <int NI>
__device__ __forceinline__ void p7_epi(const Params& p, f32x4 (&acc)[4][NI], const int rbw, const int cbw) {
    TIDV;
    const int rb = rbw + fr, cb = cbw + fq * 4;
    const float* ss1 = WSP(float, W_ZERO) + (size_t)MT * 4;
    bf16_t* qb = WSP(bf16_t, W_QB);
#pragma unroll
    for (int mi = 0; mi < 4; ++mi) {
        const int row = rb + mi * 16;
        const float rs = rsqrtf(ss1[row] * (1.f / 1024.f) + EPS);
#pragma unroll
        for (int ni = 0; ni < NI; ++ni) { const f32x4 a = acc[mi][ni] * rs; u32x2 o; o.x = pk2(a[0], a[1]); o.y = pk2(a[2], a[3]);
            *(u32x2*)(qb + (size_t)row * 1024 + cb + ni * 16) = o; }
    }
}
__device__ __forceinline__ void phase7(const Params& p, LAS char* lds, LAS char* ldsh) {
    W8V;
    int t;
    for (int i = 0; (t = sched256(i, 64 * 4)) >= 0; ++i) {
        int mp, nt; tile_mn(t, 64, 4, mp, nt);
        f32x4 acc0[4][4], acc1[4][4]; zero_acc<4>(acc0); zero_acc<4>(acc1);
        mma256(acc0, acc1, WSP(bf16_t, W_HPB) + (size_t)mp * 256 * 1024, 1024, WSP(bf16_t, W_WQ) + (size_t)nt * 256 * 1024, 1024, 1024, lds);
        const int rb0 = mp * 256 + wm2_ * 128, cbw = nt * 256 + wn4_ * 64;
        p7_epi<4>(p, acc0, rb0, cbw); p7_epi<4>(p, acc1, rb0 + 64, cbw);
    }
    if (RBID < 4) {
        const int j = RBID * 2 + half_, n0 = j * 128;
        const int wv_ = __builtin_amdgcn_readfirstlane(VTID >> 6), wmv = wv_ >> 1, wnv = wv_ & 1;
        f32x4 acc[4][4]; zero_acc<4>(acc);
        mma_seg<128, 0>(acc, WSP(bf16_t, W_HPB) + (size_t)MP * 1024, 1024, WSP(bf16_t, W_WQ) + (size_t)n0 * 1024, 1024, 1024, ldsh, nullptr);
        p7_epi<4>(p, acc, MP + wmv * 64, n0 + wnv * 64);
    }
}

__device__ __forceinline__ void p8_prompt(const Params& p, int item, LAS char* lds) {
    TIDV;
    const int qt = item & 15, head = (item >> 4) & 3, b = item >> 6;
    const int tokq = b * 2048 + qt * 128;
    const bf16_t* qa = WSP(bf16_t, W_QB) + (size_t)tokq * 1024 + head * 256;
    const bf16_t* kbp = WSP(bf16_t, W_KB) + (size_t)(b * 256) * 1024 + head * 256;
    f32x4 s0[4][4], s1[4][4]; zero_acc<4>(s0); zero_acc<4>(s1);
    mma_seg<128, 0>(s0, qa, 1024, kbp, 1024, 256, lds, nullptr);
    mma_seg<128, 0>(s1, qa, 1024, kbp + (size_t)128 * 1024, 1024, 256, lds, nullptr);
    LAS float* red = (LAS float*)(lds + (LDS_MISC + 64) - __builtin_amdgcn_readfirstlane(RTID >> 8) * 61440);
    float rinv[4];
    float mx[4];
#pragma unroll
    for (int mi = 0; mi < 4; ++mi) {
        float m = -3.0e38f;
#pragma unroll
        for (int ni = 0; ni < 4; ++ni)
#pragma unroll
            for (int j = 0; j < 4; ++j) m = fmaxf(m, fmaxf(s0[mi][ni][j], s1[mi][ni][j]));
        m = fq_max(m);
        if (fq == 0) red[wn * 128 + wm * 64 + mi * 16 + fr] = m;
        mx[mi] = m;
    }
    __syncthreads();
#pragma unroll
    for (int mi = 0; mi < 4; ++mi) mx[mi] = fmaxf(mx[mi], red[(wn ^ 1) * 128 + wm * 64 + mi * 16 + fr]);
#pragma unroll
    for (int mi = 0; mi < 4; ++mi) {
        float sum = 0.f;
        const int t = wm * 64 + mi * 16 + fr;
#pragma unroll
        for (int ni = 0; ni < 4; ++ni) {
            const int mcol = wn * 64 + ni * 16 + fq * 4;
            u32x2 o0, o1;
            o0.x = pk2(__expf(s0[mi][ni][0] - mx[mi]), __expf(s0[mi][ni][1] - mx[mi])); o0.y = pk2(__expf(s0[mi][ni][2] - mx[mi]), __expf(s0[mi][ni][3] - mx[mi]));
            o1.x = pk2(__expf(s1[mi][ni][0] - mx[mi]), __expf(s1[mi][ni][1] - mx[mi])); o1.y = pk2(__expf(s1[mi][ni][2] - mx[mi]), __expf(s1[mi][ni][3] - mx[mi]));
            sum += (bflo(o0.x) + bfhi(o0.x)) + (bflo(o0.y) + bfhi(o0.y)) + (bflo(o1.x) + bfhi(o1.x)) + (bflo(o1.y) + bfhi(o1.y));
            const int c0 = mcol >> 3, c1 = (mcol + 128) >> 3, sub = (mcol & 7) * 2;
            *(LAS u32x2*)(lds + t * 512 + ((c0 ^ (t & 15)) << 4) + sub) = o0;
            *(LAS u32x2*)(lds + t * 512 + ((c1 ^ (t & 15)) << 4) + sub) = o1;
        }
        sum = fq_sum(sum);
        if (fq == 0) red[256 + wn * 128 + t] = sum;
        rinv[mi] = sum;
        __builtin_amdgcn_sched_barrier(0);
    }
    __syncthreads();
#pragma unroll
    for (int mi = 0; mi < 4; ++mi) rinv[mi] = 1.f / (rinv[mi] + red[256 + (wn ^ 1) * 128 + wm * 64 + mi * 16 + fr]);
    const bf16_t* vtp = WSP(bf16_t, W_VT) + (size_t)(b * 4 + head) * 256 * 256;
    bf16_t* ob = WSP(bf16_t, W_OB);
#pragma unroll 1
    for (int nn = 0; nn < 2; ++nn) {
        f32x4 acc[4][4]; zero_acc<4>(acc);
        const bf16_t* vb = vtp + (size_t)(nn * 128 + wn * 64 + fr) * 256 + fq * 8;
        bf16x8 bcur[4], bnxt[4];
#pragma unroll
        for (int ni = 0; ni < 4; ++ni) bcur[ni] = *(const bf16x8*)(vb + (size_t)(ni * 16) * 256);
#pragma unroll 1
        for (int kk = 0; kk < 8; ++kk) {
            if (kk + 1 < 8) {
#pragma unroll
                for (int ni = 0; ni < 4; ++ni) bnxt[ni] = *(const bf16x8*)(vb + (size_t)(ni * 16) * 256 + (kk + 1) * 32);
            }
            bf16x8 af[4];
#pragma unroll
            for (int mi = 0; mi < 4; ++mi) { const int t = wm * 64 + mi * 16 + fr; af[mi] = *(LAS bf16x8*)(lds + t * 512 + (((kk * 4 + fq) ^ (t & 15)) << 4)); }
#pragma unroll
            for (int mi = 0; mi < 4; ++mi)
#pragma unroll
                for (int ni = 0; ni < 4; ++ni) acc[mi][ni] = __builtin_amdgcn_mfma_f32_16x16x32_bf16(bcur[ni], af[mi], acc[mi][ni], 0, 0, 0);
            if (kk + 1 < 8) {
#pragma unroll
                for (int ni = 0; ni < 4; ++ni) bcur[ni] = bnxt[ni];
            }
        }
#pragma unroll
        for (int mi = 0; mi < 4; ++mi)
#pragma unroll
            for (int ni = 0; ni < 4; ++ni) { const f32x4 a = acc[mi][ni] * rinv[mi]; u32x2 o; o.x = pk2(a[0], a[1]); o.y = pk2(a[2], a[3]);
                *(u32x2*)(ob + (size_t)(tokq + wm * 64 + mi * 16 + fr) * 1024 + head * 256 + nn * 128 + wn * 64 + ni * 16 + fq * 4) = o; }
    }
    __syncthreads();
}
__device__ __forceinline__ void p8_sample(const Params& p, int item, LAS char* lds) {
    TIDV;
    const int bs = item >> 2, head = item & 3;
    LAS float* s_q = (LAS float*)lds; LAS float* s_sc = s_q + 256; LAS float* s_red = s_sc + 256; LAS float* s_part = s_red + 16;
    s_q[tid] = bf2f(WSP(bf16_t, W_QB)[(size_t)(MP + bs) * 1024 + head * 256 + tid]);
    __syncthreads();
    const f32x4 qv = *(LAS f32x4*)(s_q + lane * 4);
    const float* kc = p.in[4] + ((size_t)(bs * 256) * 4 + head) * 256 + lane * 4;
    const float* vc = p.in[5] + ((size_t)(bs * 256) * 4 + head) * 256 + lane * 4;
#pragma unroll 1
    for (int i = 0; i < 64; i += 16) {
        f32x4 kv[16];
#pragma unroll
        for (int u = 0; u < 16; ++u) kv[u] = __builtin_nontemporal_load((const f32x4*)(kc + (size_t)(wid * 64 + i + u) * 1024));
#pragma unroll
        for (int u = 0; u < 16; ++u) { float d = kv[u][0] * qv[0] + kv[u][1] * qv[1] + kv[u][2] * qv[2] + kv[u][3] * qv[3]; d = wave_sum(d); if (lane == 0) s_sc[wid * 64 + i + u] = d; }
    }
    __syncthreads();
    const float sv = s_sc[tid];
    float m = wave_max(sv);
    if (lane == 0) s_red[wid] = m;
    __syncthreads();
    m = fmaxf(fmaxf(s_red[0], s_red[1]), fmaxf(s_red[2], s_red[3]));
    const float e = __expf(sv - m);
    float sm = wave_sum(e);
    if (lane == 0) s_red[4 + wid] = sm;
    s_sc[tid] = e;
    __syncthreads();
    const float inv = 1.f / ((s_red[4] + s_red[5]) + (s_red[6] + s_red[7]));
    f32x4 o = {0.f, 0.f, 0.f, 0.f};
#pragma unroll 1
    for (int i = 0; i < 64; i += 16) {
        f32x4 vv[16];
#pragma unroll
        for (int u = 0; u < 16; ++u) vv[u] = __builtin_nontemporal_load((const f32x4*)(vc + (size_t)(wid * 64 + i + u) * 1024));
#pragma unroll
        for (int u = 0; u < 16; ++u) o = o + vv[u] * s_sc[wid * 64 + i + u];
    }
    *(LAS f32x4*)(s_part + wid * 256 + lane * 4) = o;
    __syncthreads();
    const float r = ((s_part[tid] + s_part[256 + tid]) + (s_part[512 + tid] + s_part[768 + tid])) * inv;
    WSP(bf16_t, W_OB)[(size_t)(MP + bs) * 1024 + head * 256 + tid] = (bf16_t)(pk2(r, 0.f) & 0xffffu);
    __syncthreads();
}
__device__ __forceinline__ void phase8(const Params& p, LAS char* lds) {
    const int flip = (RBID ^ (RBID >> 7)) & 1;
    for (int j = 0; j < 2; ++j) {
        for (int it = VBID + ((j ^ flip) ? 512 : 0); it < ((j ^ flip) ? 1024 : 512); it += VGRID) {
            if (it < 512) p8_sample(p, it, lds); else p8_prompt(p, it - 512, lds);
        }
    }
}

template <int NI>
__device__ __forceinline__ void p10_epi(const Params& p, f32x4 (&acc)[4][NI], const int rbw, const int cbw) {
    TIDV;
    const int rb = rbw + fr, cb = cbw / 2 + fq * 4;
    const float* ss2 = WSP(float, W_ZERO) + (size_t)MT * 5;
    bf16_t* act = WSP(bf16_t, W_ACT);
#pragma unroll
    for (int mi = 0; mi < 4; ++mi) {
        const int row = rb + mi * 16;
        const float rs = rsqrtf(ss2[row] * (1.f / 1024.f) + EPS);
#pragma unroll
        for (int q = 0; q < NI / 2; ++q) {
            const f32x4 g = acc[mi][2 * q] * rs, u = acc[mi][2 * q + 1] * rs;
            u32x2 o; o.x = pk2(silu_f(g[0]) * u[0], silu_f(g[1]) * u[1]); o.y = pk2(silu_f(g[2]) * u[2], silu_f(g[3]) * u[3]);
            *(u32x2*)(act + (size_t)row * 2816 + cb + q * 16) = o;
        }
    }
}
__device__ __forceinline__ void phase10(const Params& p, LAS char* lds, LAS char* ldsh) {
    W8V;
    int t;
    for (int i = 0; (t = sched256(i, 64 * 22)) >= 0; ++i) {
        int mp, nt; tile_mn(t, 64, 22, mp, nt);
        f32x4 acc0[4][4], acc1[4][4]; zero_acc<4>(acc0); zero_acc<4>(acc1);
        mma256(acc0, acc1, WSP(bf16_t, W_HPB) + (size_t)mp * 256 * 1024, 1024, WSP(bf16_t, W_WGU) + (size_t)nt * 256 * 1024, 1024, 1024, lds);
        const int rb0 = mp * 256 + wm2_ * 128, cbw = nt * 256 + wn4_ * 64;
        p10_epi<4>(p, acc0, rb0, cbw); p10_epi<4>(p, acc1, rb0 + 64, cbw);
    }
    if (RBID >= 128 && RBID < 150) {
        const int j = (RBID - 128) * 2 + half_, n0 = j * 128;
        const int wv_ = __builtin_amdgcn_readfirstlane(VTID >> 6), wmv = wv_ >> 1, wnv = wv_ & 1;
        f32x4 acc[4][4]; zero_acc<4>(acc);
        mma_seg<128, 0>(acc, WSP(bf16_t, W_HPB) + (size_t)MP * 1024, 1024, WSP(bf16_t, W_WGU) + (size_t)n0 * 1024, 1024, 1024, ldsh, nullptr);
        p10_epi<4>(p, acc, MP + wmv * 64, n0 + wnv * 64);
    }
}

__device__ __forceinline__ void phase12(const Params& p) {
    const float* hp = WSP(float, W_HP); const float* g = p.in[30];
    const int lane = VTID & 63, wid = VTID >> 6;
    for (int it = VBID; it < MT / 4; it += VGRID) {
        const int row = it * 4 + wid;
        const float* src = hp + (size_t)row * 1024;
        f32x4 v[4]; float ss = 0.f;
#pragma unroll
        for (int j = 0; j < 4; ++j) { v[j] = *(const f32x4*)(src + (j * 64 + lane) * 4); ss += (v[j][0] * v[j][0] + v[j][1] * v[j][1]) + (v[j][2] * v[j][2] + v[j][3] * v[j][3]); }
        const float rs = rsqrtf(wave_sum(ss) * (1.f / 1024.f) + EPS);
#pragma unroll
        for (int j = 0; j < 4; ++j) { const f32x4 gv = *(const f32x4*)(g + (j * 64 + lane) * 4);
            *(f32x4*)(p.out + (size_t)row * 1024 + (j * 64 + lane) * 4) = v[j] * rs * gv; }
    }
}

#ifndef DUMP_SEL
#define DUMP_SEL 0
#endif
__device__ __forceinline__ void phase_dump(const Params& p) {
    const int n = MT * 1024;
    for (int i = VBID * 256 + VTID; i < n; i += VGRID * 256) {
        float v = 0.f;
        if (DUMP_SEL == 1) v = bf2f(WSP(bf16_t, W_CONCAT)[i]);
        else if (DUMP_SEL == 2) v = WSP(float, W_HP)[i];
        else if (DUMP_SEL == 3) v = bf2f(WSP(bf16_t, W_QB)[i]);
        else if (DUMP_SEL == 4) v = bf2f(WSP(bf16_t, W_OB)[i]);
        else if (DUMP_SEL == 5) v = bf2f(WSP(bf16_t, W_HPB)[i]);
        else if (DUMP_SEL == 6) v = bf2f(WSP(bf16_t, W_ACT)[(size_t)(i >> 10) * 2816 + (i & 1023)]);
        p.out[i] = v;
    }
}
__device__ __forceinline__ bool single64_splitk(f32x4 (&acc)[4][2], const bf16_t* A, const int lda, const bf16_t* Bt, const int ldb, const int K, LAS char* lds, LAS char* ldsh, const int half) {
    zero_acc<2>(acc);
    const int kh = K >> 1;
    mma_seg<64, 0>(acc, A + half * kh, lda, Bt + half * kh, ldb, kh, ldsh, nullptr);
    LAS f32x4* xch = (LAS f32x4*)(lds + 65536);
    if (half == 1) {
#pragma unroll
        for (int mi = 0; mi < 4; ++mi)
#pragma unroll
            for (int ni = 0; ni < 2; ++ni) xch[(mi * 2 + ni) * 256 + VTID] = acc[mi][ni];
    }
    __syncthreads();
    if (half == 0) {
#pragma unroll
        for (int mi = 0; mi < 4; ++mi)
#pragma unroll
            for (int ni = 0; ni < 2; ++ni) acc[mi][ni] = acc[mi][ni] + xch[(mi * 2 + ni) * 256 + VTID];
    }
    return half == 0;
}
struct Sched256 {
    int T, NMt, NNt;
    __device__ __forceinline__ bool next(int i, pg8::Unit& u) const { const int t = sched256(i, T); if (t < 0) return false; int mp, nt; tile_mn(t, NMt, NNt, mp, nt); u.pm = mp; u.pn = nt; return true; }
    __device__ __forceinline__ void a_ready(const pg8::Unit&) const {}
    __device__ __forceinline__ void done(const pg8::Unit&) const {}
};
struct SchedMemkv {
    __device__ __forceinline__ bool next(int i, pg8::Unit& u) const { const int idx = RBID - (RGRID - 64); if (i != 0 || idx < 0) return false; u.pm = idx & 7; u.pn = idx >> 3; return true; }
    __device__ __forceinline__ void a_ready(const pg8::Unit&) const {}
    __device__ __forceinline__ void done(const pg8::Unit&) const {}
};
#define PG8_EPI_LOOP(CALL) _Pragma("unroll") for (int ai = 0; ai < 2; ++ai) _Pragma("unroll") for (int bj = 0; bj < 2; ++bj) { const int rbw = u.pm * 256 + ai * 128 + wr * 64, cbw = u.pn * 256 + bj * 128 + wc * 32; CALL; }
struct EpiInproj { static constexpr bool PERM = false, AFTER_DRAIN = false; const Params* pp;
    __device__ __forceinline__ void operator()(f32x4 (&acc)[2][2][4][2], const pg8::Unit& u, int wr, int wc, int, int) const { const Params& p = *pp; PG8_EPI_LOOP(p1_inproj_epi<2>(p, acc[ai][bj], rbw, cbw)) } };
struct EpiMemkv { static constexpr bool PERM = false, AFTER_DRAIN = false; const Params* pp;
    __device__ __forceinline__ void operator()(f32x4 (&acc)[2][2][4][2], const pg8::Unit& u, int wr, int wc, int, int) const { const Params& p = *pp; PG8_EPI_LOOP(p1_memkv_epi<2>(p, acc[ai][bj], rbw, cbw)) } };
struct EpiQ { static constexpr bool PERM = false, AFTER_DRAIN = false; const Params* pp;
    __device__ __forceinline__ void operator()(f32x4 (&acc)[2][2][4][2], const pg8::Unit& u, int wr, int wc, int, int) const { const Params& p = *pp; PG8_EPI_LOOP(p7_epi<2>(p, acc[ai][bj], rbw, cbw)) } };
struct EpiGU { static constexpr bool PERM = false, AFTER_DRAIN = false; const Params* pp;
    __device__ __forceinline__ void operator()(f32x4 (&acc)[2][2][4][2], const pg8::Unit& u, int wr, int wc, int, int) const { const Params& p = *pp; PG8_EPI_LOOP(p10_epi<2>(p, acc[ai][bj], rbw, cbw)) } };
template <int MODE> struct EpiRes { static constexpr bool PERM = false, AFTER_DRAIN = false; const Params* pp;
    __device__ __forceinline__ void operator()(f32x4 (&acc)[2][2][4][2], const pg8::Unit& u, int wr, int wc, int, int) const { const Params& p = *pp; PG8_EPI_LOOP((res_epi<MODE, 2>(p, acc[ai][bj], rbw, cbw))) } };

__device__ __forceinline__ void phase1_g8(const Params& p, LAS char* lds, LAS char* ldsh) {
    W8V;
    pg8::Gemm g1{WSP(bf16_t, W_XB), WSP(bf16_t, W_WIN), MP, 2816, 1024};
    pg8::gemm_phase<EpiInproj, Sched256, false>((PG8_LAS unsigned char*)lds, g1, Sched256{64 * 11, 64, 11}, EpiInproj{&p}, nullptr);
    pg8::Gemm g2{WSP(bf16_t, W_MEMB), WSP(bf16_t, W_WKV), 2048, 2048, 1024};
    pg8::gemm_phase<EpiMemkv, SchedMemkv, false>((PG8_LAS unsigned char*)lds, g2, SchedMemkv{}, EpiMemkv{&p}, nullptr);
    if (RBID < 42) {
        const int n0 = RBID * 64;
        const int wv_ = __builtin_amdgcn_readfirstlane(VTID >> 6), wmv = wv_ >> 1, wnv = wv_ & 1;
        f32x4 acc[4][2];
        if (single64_splitk(acc, WSP(bf16_t, W_XB) + (size_t)MP * 1024, 1024, WSP(bf16_t, W_WIN) + (size_t)n0 * 1024, 1024, 1024, lds, ldsh, half_)) p1_inproj_epi<2>(p, acc, MP + wmv * 64, n0 + wnv * 32);
    }
}
__device__ __forceinline__ void phase5b(const Params& p) {
    const int lane = VTID & 63, wid = __builtin_amdgcn_readfirstlane(VTID >> 6);
    const float* gss = WSP(float, W_ZERO) + (size_t)MT * 2;
    bf16_t* cat = WSP(bf16_t, W_CONCAT);
    for (int it = VBID; it < MT / 4; it += VGRID) {
        const int row = it * 4 + wid;
        const float rs = rsqrtf(gss[(size_t)row * 2 + (lane >> 5)] * (1.f / 256.f) + EPS);
        u32x4* ptr = (u32x4*)(cat + (size_t)row * 1024 + 512 + lane * 8);
        *ptr = scale8(*ptr, rs);
    }
}
__device__ __forceinline__ void phase6_g8(const Params& p, LAS char* lds, LAS char* ldsh) {
    W8V;
    pg8::Gemm g{WSP(bf16_t, W_CONCAT), WSP(bf16_t, W_WOUT), MP, 1024, 1024};
    pg8::gemm_phase<EpiRes<0>, Sched256, false>((PG8_LAS unsigned char*)lds, g, Sched256{64 * 4, 64, 4}, EpiRes<0>{&p}, nullptr);
    if (RBID < 16) {
        const int n0 = RBID * 64;
        const int wv_ = __builtin_amdgcn_readfirstlane(VTID >> 6), wmv = wv_ >> 1, wnv = wv_ & 1;
        f32x4 acc[4][2];
        if (single64_splitk(acc, WSP(bf16_t, W_CONCAT) + (size_t)MP * 1024, 1024, WSP(bf16_t, W_WOUT) + (size_t)n0 * 1024, 1024, 1024, lds, ldsh, half_)) res_epi<0, 2>(p, acc, MP + wmv * 64, n0 + wnv * 32);
    }
}
__device__ __forceinline__ void phase7_g8(const Params& p, LAS char* lds, LAS char* ldsh) {
    W8V;
    pg8::Gemm g{WSP(bf16_t, W_HPB), WSP(bf16_t, W_WQ), MP, 1024, 1024};
    pg8::gemm_phase<EpiQ, Sched256, false>((PG8_LAS unsigned char*)lds, g, Sched256{64 * 4, 64, 4}, EpiQ{&p}, nullptr);
    if (RBID < 16) {
        const int n0 = RBID * 64;
        const int wv_ = __builtin_amdgcn_readfirstlane(VTID >> 6), wmv = wv_ >> 1, wnv = wv_ & 1;
        f32x4 acc[4][2];
        if (single64_splitk(acc, WSP(bf16_t, W_HPB) + (size_t)MP * 1024, 1024, WSP(bf16_t, W_WQ) + (size_t)n0 * 1024, 1024, 1024, lds, ldsh, half_)) p7_epi<2>(p, acc, MP + wmv * 64, n0 + wnv * 32);
    }
}
__device__ __forceinline__ void phase9_g8(const Params& p, LAS char* lds, LAS char* ldsh) {
    W8V;
    pg8::Gemm g{WSP(bf16_t, W_OB), WSP(bf16_t, W_WXO), MP, 1024, 1024};
    pg8::gemm_phase<EpiRes<1>, Sched256, false>((PG8_LAS unsigned char*)lds, g, Sched256{64 * 4, 64, 4}, EpiRes<1>{&p}, nullptr);
    if (RBID < 16) {
        const int n0 = RBID * 64;
        const int wv_ = __builtin_amdgcn_readfirstlane(VTID >> 6), wmv = wv_ >> 1, wnv = wv_ & 1;
        f32x4 acc[4][2];
        if (single64_splitk(acc, WSP(bf16_t, W_OB) + (size_t)MP * 1024, 1024, WSP(bf16_t, W_WXO) + (size_t)n0 * 1024, 1024, 1024, lds, ldsh, half_)) res_epi<1, 2>(p, acc, MP + wmv * 64, n0 + wnv * 32);
    }
}
__device__ __forceinline__ void phase10_g8(const Params& p, LAS char* lds, LAS char* ldsh) {
    W8V;
    pg8::Gemm g{WSP(bf16_t, W_HPB), WSP(bf16_t, W_WGU), MP, 5632, 1024};
    pg8::gemm_phase<EpiGU, Sched256, false>((PG8_LAS unsigned char*)lds, g, Sched256{1280, 64, 22}, EpiGU{&p}, nullptr);
    const int wv_ = __builtin_amdgcn_readfirstlane(VTID >> 6), wmv = wv_ >> 1, wnv = wv_ & 1;
    for (int q = RBID * 2 + half_; q < 512; q += RGRID * 2) {
        const int m0 = 56 * 256 + (q & 15) * 128, n0 = 6 * 256 + (q >> 4) * 128;
        f32x4 acc[4][4]; zero_acc<4>(acc);
        mma_seg<128, 0>(acc, WSP(bf16_t, W_HPB) + (size_t)m0 * 1024, 1024, WSP(bf16_t, W_WGU) + (size_t)n0 * 1024, 1024, 1024, ldsh, nullptr);
        p10_epi<4>(p, acc, m0 + wmv * 64, n0 + wnv * 64);
    }
    if (RBID < 88) {
        const int n0 = RBID * 64;
        f32x4 acc[4][2];
        if (single64_splitk(acc, WSP(bf16_t, W_HPB) + (size_t)MP * 1024, 1024, WSP(bf16_t, W_WGU) + (size_t)n0 * 1024, 1024, 1024, lds, ldsh, half_)) p10_epi<2>(p, acc, MP + wmv * 64, n0 + wnv * 32);
    }
}
__device__ __forceinline__ void phase11_g8(const Params& p, LAS char* lds, LAS char* ldsh) {
    W8V;
    pg8::Gemm g{WSP(bf16_t, W_ACT), WSP(bf16_t, W_WD), MP, 1024, 2816};
    pg8::gemm_phase<EpiRes<2>, Sched256, false>((PG8_LAS unsigned char*)lds, g, Sched256{64 * 4, 64, 4}, EpiRes<2>{&p}, nullptr);
    if (RBID < 88) {
        const int j = RBID * 2 + half_, nt = j & 15, ks = j >> 4, n0 = nt * 64;
        const int wv_ = __builtin_amdgcn_readfirstlane(VTID >> 6), wmv = wv_ >> 1, wnv = wv_ & 1, lanev = VTID & 63, frv = lanev & 15, fqv = lanev >> 4;
        f32x4 acc[4][2]; zero_acc<2>(acc);
        mma_seg<64, 0>(acc, WSP(bf16_t, W_ACT) + (size_t)MP * 2816 + ks * 256, 2816, WSP(bf16_t, W_WD) + (size_t)n0 * 2816 + ks * 256, 2816, 256, ldsh, nullptr);
        float* hp = WSP(float, W_HP);
        const int rb = MP + wmv * 64 + frv, cb = n0 + wnv * 32 + fqv * 4;
#pragma unroll
        for (int mi = 0; mi < 4; ++mi)
#pragma unroll
            for (int ni = 0; ni < 2; ++ni)
#pragma unroll
                for (int jj = 0; jj < 4; ++jj) atomicAdd(hp + (size_t)(rb + mi * 16) * 1024 + cb + ni * 16 + jj, acc[mi][ni][jj]);
    }
}

#ifndef SKIP_PH
#define SKIP_PH 99
#endif
#define PH_ON(n) ((!defined(ONLY_PH) || ONLY_PH == n) && (SKIP_PH != n))
__global__ void __launch_bounds__(512) hymba_fwd(Params p) {
    extern __shared__ __attribute__((aligned(16))) char smem_dyn[];
    LAS char* lds = (LAS char*)smem_dyn;
    LAS char* ldsh = lds + __builtin_amdgcn_readfirstlane(RTID >> 8) * 65536;
    if (p.never) cg::this_grid().sync();
    volatile LAS unsigned* st = (volatile LAS unsigned*)(lds + LDS_MISC);
    if (RTID < 4) st[RTID] = 0u;
    __syncthreads();
    XcdBarrier xb = xcd_barrier_post(WSP(unsigned, W_BAR), st);
#if PH_ON(0)
    if (p.ph_lo <= 0 && 0 < p.ph_hi) { phase0(p, ldsh); }
#if (DUPM >> 0) & 1
    xcd_barrier(xb); { phase0(p, ldsh); }
#endif
#endif
                    xcd_barrier(xb);
#if PH_ON(1)
    if (p.ph_lo <= 1 && 1 < p.ph_hi) { phase1_g8(p, lds, ldsh); }
#if (DUPM >> 1) & 1
    xcd_barrier(xb); { phase1_g8(p, lds, ldsh); }
#endif
#endif
               xcd_barrier(xb);
#if PH_ON(2)
    if (p.ph_lo <= 2 && 2 < p.ph_hi) { phase2(p, ldsh); }
#if (DUPM >> 2) & 1
    xcd_barrier(xb); { phase2(p, ldsh); }
#endif
#endif
                    xcd_barrier(xb);
#if PH_ON(3)
    if (p.ph_lo <= 3 && 3 < p.ph_hi) { phase3(p, ldsh); }
#if (DUPM >> 3) & 1
    xcd_barrier(xb); { phase3(p, ldsh); }
#endif
#endif
                    xcd_barrier(xb);
#if PH_ON(4)
    if (p.ph_lo <= 4 && 4 < p.ph_hi) { phase4(p); }
#if (DUPM >> 4) & 1
    xcd_barrier(xb); { phase4(p); }
#endif
#endif
                          xcd_barrier(xb);
#if PH_ON(5)
    if (p.ph_lo <= 5 && 5 < p.ph_hi) { phase5(p, ldsh); }
#if (DUPM >> 5) & 1
    xcd_barrier(xb); { phase5(p, ldsh); }
#endif
#endif
                    xcd_barrier(xb);
#if PH_ON(6)
    if (p.ph_lo <= 6 && 6 < p.ph_hi) { phase5b(p); xcd_barrier(xb); phase6_g8(p, lds, ldsh); }
#if (DUPM >> 6) & 1
    xcd_barrier(xb); { phase5b(p); xcd_barrier(xb); phase6_g8(p, lds, ldsh); }
#endif
#endif
         xcd_barrier(xb);
#if PH_ON(7)
    if (p.ph_lo <= 7 && 7 < p.ph_hi) { phase7_g8(p, lds, ldsh); }
#if (DUPM >> 7) & 1
    xcd_barrier(xb); { phase7_g8(p, lds, ldsh); }
#endif
#endif
               xcd_barrier(xb);
#if PH_ON(8)
    if (p.ph_lo <= 8 && 8 < p.ph_hi) { phase8(p, ldsh); }
#if (DUPM >> 8) & 1
    xcd_barrier(xb); { phase8(p, ldsh); }
#endif
#endif
                    xcd_barrier(xb);
#if PH_ON(9)
    if (p.ph_lo <= 9 && 9 < p.ph_hi) { phase9_g8(p, lds, ldsh); }
#if (DUPM >> 9) & 1
    xcd_barrier(xb); { phase9_g8(p, lds, ldsh); }
#endif
#endif
         xcd_barrier(xb);
#if PH_ON(10)
    if (p.ph_lo <= 10 && 10 < p.ph_hi) { phase10_g8(p, lds, ldsh); }
#if (DUPM >> 10) & 1
    xcd_barrier(xb); { phase10_g8(p, lds, ldsh); }
#endif
#endif
              xcd_barrier(xb);
#if PH_ON(11)
    if (p.ph_lo <= 11 && 11 < p.ph_hi) { phase11_g8(p, lds, ldsh); }
#if (DUPM >> 11) & 1
    xcd_barrier(xb); { phase11_g8(p, lds, ldsh); }
#endif
#endif
         xcd_barrier(xb);
#if PH_ON(12)
    if (p.ph_lo <= 12 && 12 < p.ph_hi) { phase12(p); }
#if (DUPM >> 12) & 1
    xcd_barrier(xb); { phase12(p); }
#endif
#endif
}

extern "C" void kernel_launch(void* const* d_in, const int* in_sizes, int n_in, void* d_out, int out_size, void* d_ws, size_t ws_size, hipStream_t stream) {
    static int grid = 0;
    if (grid == 0) {
        int dev = 0, cus = 0, per_cu = 0;
        (void)hipGetDevice(&dev);
        (void)hipDeviceGetAttribute(&cus, hipDeviceAttributeMultiprocessorCount, dev);
        (void)hipFuncSetAttribute((const void*)hymba_fwd, hipFuncAttributeMaxDynamicSharedMemorySize, LDS_BYTES);
        (void)hipOccupancyMaxActiveBlocksPerMultiprocessor(&per_cu, (const void*)hymba_fwd, 512, LDS_BYTES);
        grid = cus; grid = (grid / 8) * 8;
        if (per_cu < 1) fprintf(stderr, "kernel_launch: occupancy query reports %d blocks per CU\n", per_cu);
        if (ws_size < W_END) fprintf(stderr, "kernel_launch: workspace too small: %zu < %zu\n", ws_size, (size_t)W_END);
    }
    Params p{};
    for (int i = 0; i < 31; ++i) p.in[i] = (const float*)d_in[i];
    p.out = (float*)d_out; p.ws = (char*)d_ws; p.never = 0;
    (void)hipMemsetAsync((char*)d_ws + W_BAR, 0, XCD_BAR_WORDS * 4, stream);
    p.ph_lo = 0; p.ph_hi = NPH; p.fused = 1;
    void* args[] = {&p};
    hipError_t e = hipLaunchCooperativeKernel((const void*)hymba_fwd, dim3(grid), dim3(512), args, LDS_BYTES, stream);
    if (e != hipSuccess) fprintf(stderr, "cooperative launch failed: %s (grid %d)\n", hipGetErrorString(e), grid);
}
```

```cpp
#include <hip/hip_runtime.h>
#include <hip/hip_cooperative_groups.h>
#include <stdint.h>
#include <cstdio>
namespace cg = cooperative_groups;

#ifndef FUSED
#define FUSED 1
#ifndef DUPM
#define DUPM 0
#endif
#endif
#define DUP_MASK 0
#define PRE_MASK 0
#ifndef RUN_PHASES
#define RUN_PHASES 13
#define DUMP_SEL 0
#endif

#define LAS __attribute__((address_space(3)))
typedef unsigned short bf16_t;
typedef short bf16x8 __attribute__((ext_vector_type(8)));
typedef float f32x4 __attribute__((ext_vector_type(4)));
typedef unsigned u32x4 __attribute__((ext_vector_type(4)));
typedef unsigned u32x2 __attribute__((ext_vector_type(2)));

constexpr int MP = 16384, MS = 128, MT = MP + MS;
constexpr int NCH = 128;
constexpr float EPS = 1e-6f;
constexpr int NPH = 13;

constexpr size_t O_YP = 0, O_YS = 16777216, O_SSMP = 16908288, O_CONVP = 17432576, O_GVP = 17457152,
                 O_MK = 17981440, O_MV = 20078592, O_SSMS = 22175744, O_CONVS = 30564352, O_GVS = 30957568;

constexpr size_t al(size_t x) { return (x + 255) & ~(size_t)255; }
constexpr size_t W_BAR = 0;
constexpr size_t W_ZERO = al(W_BAR + 3456 * 4);
constexpr size_t ZERO_FLOATS = (size_t)MT * 7;
constexpr size_t W_WIN = al(W_ZERO + ZERO_FLOATS * 4);
constexpr size_t W_WKV = al(W_WIN + (size_t)2816 * 1024 * 2);
constexpr size_t W_WOUT = al(W_WKV + (size_t)2048 * 1024 * 2);
constexpr size_t W_WQ = al(W_WOUT + (size_t)1024 * 1024 * 2);
constexpr size_t W_WXO = al(W_WQ + (size_t)1024 * 1024 * 2);
constexpr size_t W_WGU = al(W_WXO + (size_t)1024 * 1024 * 2);
constexpr size_t W_WD = al(W_WGU + (size_t)5632 * 1024 * 2);
constexpr size_t W_WSB = al(W_WD + (size_t)1024 * 2816 * 2);
constexpr size_t W_MEMB = al(W_WSB + (size_t)4 * 128 * 128 * 2);
constexpr size_t W_DTRAW = al(W_MEMB + (size_t)2048 * 1024 * 2);
constexpr size_t W_KB = al(W_DTRAW + (size_t)MT * 8 * 4);
constexpr size_t W_VT = al(W_KB + (size_t)2048 * 1024 * 2);
constexpr size_t W_VLNT = al(W_VT + (size_t)2048 * 1024 * 2);
constexpr size_t W_ACUM = al(W_VLNT + (size_t)MP * 512 * 2);
constexpr size_t W_DTV = al(W_ACUM + (size_t)NCH * 8 * 128 * 4);
constexpr size_t W_CONCAT = al(W_DTV + (size_t)NCH * 8 * 128 * 4);
constexpr size_t W_HP = al(W_CONCAT + (size_t)MT * 1024 * 2);
constexpr size_t W_HPB = al(W_HP + (size_t)MT * 1024 * 4);
constexpr size_t W_XB = al(W_HPB + (size_t)MT * 1024 * 2);
constexpr size_t W_UB = al(W_XB + (size_t)MT * 1024 * 2);
constexpr size_t W_VG = al(W_UB + (size_t)MT * 512 * 2);
constexpr size_t W_ZB = al(W_VG + (size_t)MT * 512 * 2);
constexpr size_t W_XBCB = al(W_ZB + (size_t)MT * 512 * 2);
constexpr size_t W_R1END = al(W_XBCB + (size_t)MT * 1024 * 2);
constexpr size_t W_ACT = W_XB;
static_assert((size_t)MT * 2816 * 2 <= W_R1END - W_XB, "act alias");
constexpr size_t W_XN = W_R1END;
constexpr size_t W_XWT = al(W_XN + (size_t)MP * 512 * 2);
constexpr size_t W_XT = al(W_XWT + (size_t)MP * 512 * 2);
constexpr size_t W_BN = al(W_XT + (size_t)MP * 512 * 2);
constexpr size_t W_BT = al(W_BN + (size_t)MP * 256 * 2);
constexpr size_t W_CN = al(W_BT + (size_t)MP * 256 * 2);
constexpr size_t W_R2END = al(W_CN + (size_t)MP * 256 * 2);
constexpr size_t W_QB = W_XN;
static_assert((size_t)MT * 1024 * 2 <= W_BN - W_XN, "qb alias");
constexpr size_t W_SC = W_R2END;
constexpr size_t W_HPREV = al(W_SC + (size_t)NCH * 8 * 64 * 128 * 4);
constexpr size_t W_MT = al(W_HPREV + (size_t)NCH * 8 * 64 * 128 * 2);
constexpr size_t W_END = al(W_MT + (size_t)NCH * 8 * 128 * 128 * 2);
constexpr size_t W_PBUF = W_SC;
constexpr size_t W_OB = W_HPREV;
static_assert((size_t)MT * 1024 * 2 <= W_END - W_HPREV, "ob alias");
static_assert(W_END < (size_t)530 * 1000 * 1000, "workspace too large");

constexpr int LDS_MISC = 131072;
constexpr int LDS_BYTES = 131072 + 8192;
#define RTID ((int)threadIdx.x)
#define RBID ((int)blockIdx.x)
#define RGRID ((int)gridDim.x)
#define VTID ((int)(threadIdx.x & 255u))
#define VBID ((int)(blockIdx.x * 2u + (unsigned)__builtin_amdgcn_readfirstlane((int)(threadIdx.x >> 8))))
#define VGRID ((int)(gridDim.x * 2u))

struct Params {
    const float* in[31];
    float* out;
    char* ws;
    int ph_lo, ph_hi, fused, never;
};

__device__ __forceinline__ float bf2f(unsigned h) { return __uint_as_float(h << 16); }
__device__ __forceinline__ unsigned pk2(float lo, float hi) { unsigned r; asm("v_cvt_pk_bf16_f32 %0, %1, %2" : "=v"(r) : "v"(lo), "v"(hi)); return r; }
__device__ __forceinline__ float bflo(unsigned u) { return __uint_as_float(u << 16); }
__device__ __forceinline__ float bfhi(unsigned u) { return __uint_as_float(u & 0xffff0000u); }
__device__ __forceinline__ float rbf(float x) { return bflo(pk2(x, 0.f) & 0xffffu); }
__device__ __forceinline__ float gelu_t(float x) { const float u = 1.5957691216f * (x + 0.044715f * x * x * x); return x * __builtin_amdgcn_rcpf(1.f + __expf(-u)); }
__device__ __forceinline__ float silu_f(float x) { return x * __builtin_amdgcn_rcpf(1.f + __expf(-x)); }
__device__ __forceinline__ float softplus_f(float x) { return x > 20.f ? x : log1pf(expf(x)); }
__device__ __forceinline__ float wave_sum(float v) {
#pragma unroll
    for (int o = 1; o < 64; o <<= 1) v += __shfl_xor(v, o);
    return v;
}
__device__ __forceinline__ float wave_max(float v) {
#pragma unroll
    for (int o = 1; o < 64; o <<= 1) v = fmaxf(v, __shfl_xor(v, o));
    return v;
}
__device__ __forceinline__ u32x4 scale8(u32x4 v, float s) {
    u32x4 o;
    o.x = pk2(bflo(v.x) * s, bfhi(v.x) * s); o.y = pk2(bflo(v.y) * s, bfhi(v.y) * s);
    o.z = pk2(bflo(v.z) * s, bfhi(v.z) * s); o.w = pk2(bflo(v.w) * s, bfhi(v.w) * s);
    return o;
}

#define XB_TMO      128
#define XB_XCNT(j)  (256  + 64 * (j))
#define XB_XSUB(j)  (1280 + 64 * (j))
#define XB_XGEN(j)  (2304 + 64 * (j))
#define XB_TOP      3328
#define XB_TOPGEN   3392
#define XCD_BAR_WORDS 3456
#define XB_SPIN_CAP (1u << 22)
__device__ __forceinline__ unsigned xb_ld(unsigned* p)              { return __hip_atomic_load(p, __ATOMIC_RELAXED, __HIP_MEMORY_SCOPE_AGENT); }
__device__ __forceinline__ unsigned xb_add(unsigned* p, unsigned v) { return __hip_atomic_fetch_add(p, v, __ATOMIC_RELAXED, __HIP_MEMORY_SCOPE_AGENT); }
__device__ __forceinline__ unsigned xb_xcc_id() { return (unsigned)__builtin_amdgcn_s_getreg((3 << 11) | 20) & 0xFu; }
#define XB_SPIN(cond, bar) do { unsigned _sp = 0; while (cond) { __builtin_amdgcn_s_sleep(1); \
    if ((++_sp & 255u) == 0u) { if (xb_ld(&(bar)[XB_TMO])) break; if (_sp > XB_SPIN_CAP) { atomicAdd(&(bar)[XB_TMO], 1u); break; } } } } while (0)
struct XcdBarrier { unsigned* bar; unsigned x; volatile LAS unsigned* st; };
__device__ __forceinline__ XcdBarrier xcd_barrier_post(unsigned* bar, volatile LAS unsigned* st) {
    XcdBarrier b; b.bar = bar; b.x = xb_xcc_id(); b.st = st;
    if (threadIdx.x == 0) (void)xb_add(&bar[XB_XCNT(b.x)], 1u);
    return b;
}
__device__ __forceinline__ void xcd_barrier_complete(unsigned* bar, unsigned x, unsigned& nloc, unsigned& nx) {
    const unsigned G = gridDim.x * gridDim.y * gridDim.z;
    unsigned sum, cnt, mine, sp = 0u;
    for (;;) {
        sum = 0u; cnt = 0u; mine = 0u;
#pragma unroll
        for (unsigned j = 0; j < 16; ++j) { const unsigned c = xb_ld(&bar[XB_XCNT(j)]); sum += c; cnt += (c > 0u) ? 1u : 0u; mine = (j == x) ? c : mine; }
        if (sum == G) break;
        __builtin_amdgcn_s_sleep(1);
        if ((++sp & 255u) == 0u) { if (xb_ld(&bar[XB_TMO])) break; if (sp > XB_SPIN_CAP) { atomicAdd(&bar[XB_TMO], 1u); break; } }
    }
    nloc = mine > 0u ? mine : 1u; nx = cnt > 0u ? cnt : 1u;
}
__device__ __forceinline__ void xcd_barrier(const XcdBarrier& b) {
    asm volatile("s_waitcnt vmcnt(0)" ::: "memory");
    __syncthreads();
    if (threadIdx.x == 0) {
        unsigned* bar = b.bar;
        __builtin_amdgcn_s_waitcnt(0);
        unsigned nloc = b.st[0], nx = b.st[1];
        if (nloc == 0u) { xcd_barrier_complete(bar, b.x, nloc, nx); b.st[0] = nloc; b.st[1] = nx; }
        const unsigned old = xb_add(&bar[XB_XSUB(b.x)], 1u);
        const unsigned gen = old / nloc;
        if (old + 1u == (gen + 1u) * nloc) {
            __builtin_amdgcn_fence(__ATOMIC_RELEASE, "agent");
            asm volatile("s_waitcnt vmcnt(0)" ::: "memory");
            const unsigned og = xb_add(&bar[XB_TOP], 1u);
            const unsigned tg = og / nx;
            if (og + 1u == (tg + 1u) * nx) xb_add(&bar[XB_TOPGEN], 1u);
            else XB_SPIN(xb_ld(&bar[XB_TOPGEN]) == tg, bar);
            __builtin_amdgcn_fence(__ATOMIC_ACQUIRE, "agent");
            xb_add(&bar[XB_XGEN(b.x)], 1u);
            asm volatile("s_waitcnt vmcnt(0)" ::: "memory");
        } else {
            XB_SPIN(xb_ld(&bar[XB_XGEN(b.x)]) == gen, bar);
            __builtin_amdgcn_fence(__ATOMIC_ACQUIRE, "agent");
            asm volatile("s_waitcnt vmcnt(0)" ::: "memory");
        }
    }
    __syncthreads();
}

__device__ __forceinline__ int sched(int i, int T) {
    const int x = VBID & 7, lb = VBID >> 3, nlb = VGRID >> 3;
    const int chunk = (T + 7) >> 3, local = lb + i * nlb;
    if (local >= chunk) return -1;
    const int t = x * chunk + local;
    return t < T ? t : -1;
}
__device__ __forceinline__ void tile_mn(int t, int NMt, int NNt, int& mt, int& nt) {
    const int per = 8 * NNt, gi = t / per, r = t - gi * per, fm = gi * 8;
    const int gsz = (NMt - fm) < 8 ? (NMt - fm) : 8;
    mt = fm + r % gsz; nt = r / gsz;
}

template <int BN, int AMODE>
__device__ __forceinline__ void mma_seg(f32x4 (&acc)[4][BN / 32], const bf16_t* __restrict__ A, const int lda,
                                        const bf16_t* __restrict__ Bt, const int ldb, const int K, LAS char* lds,
                                        const float* __restrict__ gssrow) {
    constexpr int NI = BN / 32;
    const int tid = VTID, lane = tid & 63, wid = __builtin_amdgcn_readfirstlane(tid >> 6), wm = wid >> 1, wn = wid & 1, fr = lane & 15, fq = lane >> 4;
    const int srow = tid >> 3, sc = tid & 7;
    const int csw = (sc ^ ((srow >> 1) & 7)) * 8;
    const bf16_t* ap = A + (size_t)srow * lda + (AMODE == 1 ? sc * 8 : csw);
    const bf16_t* bp = Bt + (size_t)srow * ldb + csw;
    const int woff = srow * 128 + ((sc ^ ((srow >> 1) & 7)) << 4);
    const int gl = wid * 1024;
    const int sw = (fr >> 1) & 7;
    const int aoff = (wm * 64 + fr) * 128, boff = 32768 + (wn * (BN / 2) + fr) * 128;
    u32x4 ra[4];
    float asc[4];
    const int nk = K >> 6;
#define MS_ISSUE(kt, buf) do { \
    if (AMODE == 1) { \
        _Pragma("unroll") for (int i = 0; i < 4; ++i) ra[i] = *(const u32x4*)(ap + (size_t)(i * 32) * lda + (kt) * 64); \
        const int k_ = (kt) * 64 + sc * 8; \
        _Pragma("unroll") for (int i = 0; i < 4; ++i) asc[i] = (k_ >= 512) ? rsqrtf(gssrow[(srow + 32 * i) * 2 + ((k_ - 512) >> 8)] * (1.f / 256.f) + EPS) : 1.f; \
    } else { \
        _Pragma("unroll") for (int i = 0; i < 4; ++i) __builtin_amdgcn_global_load_lds((const unsigned*)(ap + (size_t)(i * 32) * lda + (kt) * 64), (LAS unsigned*)(lds + (buf) * 16384 + i * 4096 + gl), 16, 0, 0); \
    } \
    _Pragma("unroll") for (int i = 0; i < NI; ++i) __builtin_amdgcn_global_load_lds((const unsigned*)(bp + (size_t)(i * 32) * ldb + (kt) * 64), (LAS unsigned*)(lds + 32768 + (buf) * 16384 + i * 4096 + gl), 16, 0, 0); \
  } while (0)
#define MS_STORE(buf) do { if (AMODE == 1) { \
    _Pragma("unroll") for (int i = 0; i < 4; ++i) { *(LAS u32x4*)(lds + (buf) * 16384 + woff + i * 4096) = scale8(ra[i], asc[i]); } } \
  } while (0)
    __syncthreads();
    MS_ISSUE(0, 0);
    MS_STORE(0);
    asm volatile("s_waitcnt vmcnt(0)" ::: "memory");
    __syncthreads();
    for (int kt = 0; kt < nk; ++kt) {
        const int cur = kt & 1;
        if (kt + 1 < nk) MS_ISSUE(kt + 1, cur ^ 1);
#pragma unroll
        for (int kk = 0; kk < 2; ++kk) {
            const int co = (((kk * 4 + fq) ^ sw) << 4) + cur * 16384;
            bf16x8 af[4], bfv[NI];
#pragma unroll
            for (int mi = 0; mi < 4; ++mi) af[mi] = *(LAS bf16x8*)(lds + aoff + mi * 2048 + co);
#pragma unroll
            for (int ni = 0; ni < NI; ++ni) bfv[ni] = *(LAS bf16x8*)(lds + boff + ni * 2048 + co);
            __builtin_amdgcn_s_setprio(1);
#pragma unroll
            for (int mi = 0; mi < 4; ++mi)
#pragma unroll
                for (int ni = 0; ni < NI; ++ni) acc[mi][ni] = __builtin_amdgcn_mfma_f32_16x16x32_bf16(bfv[ni], af[mi], acc[mi][ni], 0, 0, 0);
            __builtin_amdgcn_s_setprio(0);
        }
        if (kt + 1 < nk) MS_STORE(cur ^ 1);
        asm volatile("s_waitcnt vmcnt(0)" ::: "memory");
        __syncthreads();
    }
#undef MS_ISSUE
#undef MS_STORE
}
template <int NI> __device__ __forceinline__ void zero_acc(f32x4 (&acc)[4][NI]) {
#pragma unroll
    for (int mi = 0; mi < 4; ++mi)
#pragma unroll
        for (int ni = 0; ni < NI; ++ni) acc[mi][ni] = (f32x4){0.f, 0.f, 0.f, 0.f};
}
__device__ __forceinline__ void mma256(f32x4 (&acc0)[4][4], f32x4 (&acc1)[4][4], const bf16_t* __restrict__ A, const int lda,
                                       const bf16_t* __restrict__ Bt, const int ldb, const int K, LAS char* lds) {
    const int tid = RTID, lane = tid & 63, w8 = __builtin_amdgcn_readfirstlane(tid >> 6), wm2 = w8 >> 2, wn4 = w8 & 3, fr = lane & 15, fq = lane >> 4;
    const int srow = tid >> 3, sc = tid & 7;
    const int csw = (sc ^ ((srow >> 1) & 7)) * 8;
    const bf16_t* ap = A + (size_t)srow * lda + csw;
    const bf16_t* bp = Bt + (size_t)srow * ldb + csw;
    const int gl = w8 * 1024;
    const int sw = (fr >> 1) & 7;
    const int aoff = (wm2 * 128 + fr) * 128, boff = 32768 + (wn4 * 64 + fr) * 128;
    const int nk = K >> 6;
#define M8_ISSUE(kt, buf) do { const int base_ = (buf) * 65536 + gl; \
    _Pragma("unroll") for (int i = 0; i < 4; ++i) __builtin_amdgcn_global_load_lds((const unsigned*)(ap + (size_t)(i * 64) * lda + (kt) * 64), (LAS unsigned*)(lds + base_ + i * 8192), 16, 0, 0); \
    _Pragma("unroll") for (int i = 0; i < 4; ++i) __builtin_amdgcn_global_load_lds((const unsigned*)(bp + (size_t)(i * 64) * ldb + (kt) * 64), (LAS unsigned*)(lds + base_ + 32768 + i * 8192), 16, 0, 0); \
  } while (0)
    __syncthreads();
    M8_ISSUE(0, 0);
    asm volatile("s_waitcnt vmcnt(0)" ::: "memory");
    __syncthreads();
    for (int kt = 0; kt < nk; ++kt) {
        const int cur = kt & 1;
        if (kt + 1 < nk) M8_ISSUE(kt + 1, cur ^ 1);
#pragma unroll 1
        for (int kk = 0; kk < 2; ++kk) {
            const int co = (((kk * 4 + fq) ^ sw) << 4) + cur * 65536;
            bf16x8 a0[4], a1[4], bfv[4];
#pragma unroll
            for (int ni = 0; ni < 4; ++ni) bfv[ni] = *(LAS bf16x8*)(lds + boff + ni * 2048 + co);
#pragma unroll
            for (int mi = 0; mi < 4; ++mi) a0[mi] = *(LAS bf16x8*)(lds + aoff + mi * 2048 + co);
#pragma unroll
            for (int mi = 0; mi < 4; ++mi) a1[mi] = *(LAS bf16x8*)(lds + aoff + 8192 + mi * 2048 + co);
            __builtin_amdgcn_s_setprio(1);
#pragma unroll
            for (int mi = 0; mi < 4; ++mi)
#pragma unroll
                for (int ni = 0; ni < 4; ++ni) acc0[mi][ni] = __builtin_amdgcn_mfma_f32_16x16x32_bf16(bfv[ni], a0[mi], acc0[mi][ni], 0, 0, 0);
#pragma unroll
            for (int mi = 0; mi < 4; ++mi)
#pragma unroll
                for (int ni = 0; ni < 4; ++ni) acc1[mi][ni] = __builtin_amdgcn_mfma_f32_16x16x32_bf16(bfv[ni], a1[mi], acc1[mi][ni], 0, 0, 0);
            __builtin_amdgcn_s_setprio(0);
        }
        asm volatile("s_waitcnt vmcnt(0)" ::: "memory");
        __syncthreads();
    }
#undef M8_ISSUE
}
namespace pg8 {
#define PG8_LAS __attribute__((address_space(3)))
constexpr int BM = 256, BK = 64, HALF = 128, HTB = HALF * BK * 2  , STAGE_BYTES = 8 * HTB, NXCD = 8, WGM = 8;
__device__ __forceinline__ int lds_byte(int r, int c) { const int st = (r >> 4) * 2 + (c >> 5), rr = r & 15, cc = c & 31, ob = rr * 64 + cc * 2; return st * 1024 + (ob ^ (((ob >> 9) & 1) << 5)); }
__device__ __forceinline__ void stage_rc(int b, int& R, int& C) { const int st = b / 1024, sb = b % 1024, swz = sb ^ (((sb >> 9) & 1) << 5); R = (st >> 1) * 16 + swz / 64; C = (st & 1) * 32 + (swz % 64) / 2; }
__device__ __forceinline__ int perm32(int rho) { const int n = rho >> 4, i = rho & 15; return 8 * (i >> 2) + 4 * n + (i & 3); }
struct Unit { int pm, pn; };
struct Gemm { const bf16_t* A; const bf16_t* Bt; int M, N, K; };
template <class Epi, class Sched, bool STAMP = false>
__device__ __forceinline__ void gemm_phase(PG8_LAS unsigned char* lds, const Gemm g, const Sched& S, const Epi& E, unsigned long long* stamps) {
    const int tid = threadIdx.x, wid = __builtin_amdgcn_readfirstlane(tid >> 6), lane = tid & 63, wr = wid >> 2, wc = wid & 3, fr = lane & 15, fq = lane >> 4;
    const int K = g.K, nt = K / BK;
    int ts_lo = 0, ts_hi = 0, nts = 0; const unsigned long long rt_entry = STAMP ? (unsigned long long)wall_clock64() : 0ull;
#define PG8_STAMP() do { if (STAMP && wid == 0 && nts < 64) { const unsigned long long _c = (unsigned long long)clock64(); \
        ts_lo = (lane == nts) ? (int)(unsigned)_c : ts_lo; ts_hi = (lane == nts) ? (int)(unsigned)(_c >> 32) : ts_hi; ++nts; } } while (0)
    PG8_STAMP();
    unsigned voffA[2], voffB[2];
#pragma unroll
    for (int i = 0; i < 2; ++i) { int R, C; stage_rc(tid * 16 + i * 8192, R, C); const int Rb = Epi::PERM ? ((R & ~31) + perm32(R & 31)) : R;
        voffA[i] = (unsigned)(R * K + C) * 2u; voffB[i] = (unsigned)(Rb * K + C) * 2u; }
    const size_t kstep = (size_t)(BK * 2);
    const size_t hstep = (size_t)HALF * K * 2;
    const size_t tstep = 2 * hstep;
    const unsigned ldsw = (unsigned)wid * 1024u;
    const int aoff = lds_byte(wr * 64 + fr, fq * 8), boff = lds_byte(wc * 32 + fr, fq * 8);
#define PG8_SA(b, h) (((b) * 2 + (h)) * HTB)
#define PG8_SB(b, h) ((4 + (b) * 2 + (h)) * HTB)
#define PG8_STAGE(bufoff, gbase, voff) do { _Pragma("unroll") for (int _i = 0; _i < 2; ++_i) \
        __builtin_amdgcn_global_load_lds((const unsigned*)((const char*)(gbase) + (voff)[_i]), (PG8_LAS unsigned*)(lds + (bufoff) + ldsw + _i * 8192), 16, 0, 0); } while (0)
#define PG8_LDA(dst, b, h) do { _Pragma("unroll") for (int m = 0; m < 4; ++m) _Pragma("unroll") for (int k = 0; k < 2; ++k) dst[m][k] = *(const PG8_LAS bf16x8*)(lds + PG8_SA(b, h) + aoff + m * 2048 + k * 1024); } while (0)
#define PG8_LDB(dst, b, h) do { _Pragma("unroll") for (int n = 0; n < 2; ++n) _Pragma("unroll") for (int k = 0; k < 2; ++k) dst[n][k] = *(const PG8_LAS bf16x8*)(lds + PG8_SB(b, h) + boff + n * 2048 + k * 1024); } while (0)
#define PG8_MMA(ai, bj, At, Bt) do { __builtin_amdgcn_s_setprio(1); _Pragma("unroll") for (int m = 0; m < 4; ++m) _Pragma("unroll") for (int n = 0; n < 2; ++n) _Pragma("unroll") for (int k = 0; k < 2; ++k) \
        acc[ai][bj][m][n] = __builtin_amdgcn_mfma_f32_16x16x32_bf16(Bt[n][k], At[m][k], acc[ai][bj][m][n], 0, 0, 0); __builtin_amdgcn_s_setprio(0); } while (0)
#define PG8_WAIT_V(n) asm volatile("s_waitcnt vmcnt(" #n ")" ::: "memory")
#define PG8_WAIT_L(n) asm volatile("s_waitcnt lgkmcnt(" #n ")" ::: "memory")
#define PG8_BAR __builtin_amdgcn_s_barrier()
#define PG8_SCHED __builtin_amdgcn_sched_barrier(0)
    Unit cur, nxt; int ui = 0;
    if (!S.next(0, cur)) return;
    f32x4 acc[2][2][4][2];
#pragma unroll
    for (int a = 0; a < 2; ++a)
#pragma unroll
        for (int b = 0; b < 2; ++b)
#pragma unroll
            for (int m = 0; m < 4; ++m)
#pragma unroll
                for (int n = 0; n < 2; ++n) acc[a][b][m][n] = (f32x4){0.f, 0.f, 0.f, 0.f};
    bf16x8 At[4][2], B0[2][2], B1[2][2];
    const char* cA = (const char*)g.A + (size_t)cur.pm * tstep; const char* cB = (const char*)g.Bt + (size_t)cur.pn * tstep;
    S.a_ready(cur);
    PG8_STAGE(PG8_SB(0, 0), cB, voffB); PG8_STAGE(PG8_SA(0, 0), cA, voffA); PG8_STAGE(PG8_SB(0, 1), cB + hstep, voffB); PG8_STAGE(PG8_SA(0, 1), cA + hstep, voffA);
    if (wr == 1) PG8_BAR;
    PG8_WAIT_V(4); PG8_BAR;
    PG8_STAGE(PG8_SB(1, 0), cB + kstep, voffB); PG8_STAGE(PG8_SA(1, 0), cA + kstep, voffA); PG8_STAGE(PG8_SB(1, 1), cB + hstep + kstep, voffB);
    PG8_WAIT_V(6); PG8_BAR;
    PG8_STAMP();
    for (;;) {
        const bool has_next = S.next(ui + 1, nxt);
        const char* nA = has_next ? (const char*)g.A + (size_t)nxt.pm * tstep : cA; const char* nB = has_next ? (const char*)g.Bt + (size_t)nxt.pn * tstep : cB;
        for (int t = 0; t < nt; t += 2) {
            const bool last = (t == nt - 2);
            const char* a1 = cA + (size_t)(t + 1) * kstep;
            const char* a2 = last ? nA : cA + (size_t)(t + 2) * kstep; const char* b2 = last ? nB : cB + (size_t)(t + 2) * kstep;
            const char* a3 = a2 + kstep; const char* b3 = b2 + kstep;
            if (last && has_next) S.a_ready(nxt);
            PG8_LDB(B0, 0, 0); PG8_SCHED; PG8_LDA(At, 0, 0); PG8_STAGE(PG8_SA(1, 1), a1 + hstep, voffA);
            PG8_WAIT_L(8); PG8_BAR; PG8_WAIT_L(0); PG8_MMA(0, 0, At, B0); PG8_BAR; PG8_SCHED;
            PG8_LDB(B1, 0, 1); PG8_STAGE(PG8_SB(0, 0), b2, voffB);
            PG8_BAR; PG8_WAIT_L(0); PG8_MMA(0, 1, At, B1); PG8_BAR;
            PG8_LDA(At, 0, 1); PG8_STAGE(PG8_SA(0, 0), a2, voffA);
            PG8_BAR; PG8_WAIT_L(0); PG8_MMA(1, 0, At, B0); PG8_BAR; PG8_SCHED;
            PG8_STAGE(PG8_SB(0, 1), b2 + hstep, voffB);
            PG8_WAIT_V(6); PG8_BAR; PG8_MMA(1, 1, At, B1); PG8_BAR;
            PG8_LDB(B0, 1, 0); PG8_SCHED; PG8_LDA(At, 1, 0); PG8_STAGE(PG8_SA(0, 1), a2 + hstep, voffA);
            PG8_WAIT_L(8); PG8_BAR; PG8_WAIT_L(0); PG8_MMA(0, 0, At, B0); PG8_BAR; PG8_SCHED;
            PG8_LDB(B1, 1, 1); PG8_STAGE(PG8_SB(1, 0), b3, voffB);
            PG8_BAR; PG8_WAIT_L(0); PG8_MMA(0, 1, At, B1); PG8_BAR;
            PG8_LDA(At, 1, 1); PG8_STAGE(PG8_SA(1, 0), a3, voffA);
            PG8_BAR; PG8_WAIT_L(0); PG8_MMA(1, 0, At, B0); PG8_BAR; PG8_SCHED;
            PG8_STAGE(PG8_SB(1, 1), b3 + hstep, voffB);
            PG8_WAIT_V(6); PG8_BAR; PG8_MMA(1, 1, At, B1); PG8_BAR;
        }
        PG8_STAMP();
        if constexpr (!Epi::AFTER_DRAIN) { E(acc, cur, wr, wc, fr, fq); S.done(cur); }
        PG8_STAMP();
        if (!has_next) break;
#pragma unroll
        for (int a = 0; a < 2; ++a)
#pragma unroll
            for (int b = 0; b < 2; ++b)
#pragma unroll
                for (int m = 0; m < 4; ++m)
#pragma unroll
                    for (int n = 0; n < 2; ++n) acc[a][b][m][n] = (f32x4){0.f, 0.f, 0.f, 0.f};
        cur = nxt; cA = nA; cB = nB; ++ui;
    }
    PG8_WAIT_V(0);
    if (wr == 0) PG8_BAR;
    PG8_BAR;
    if constexpr (Epi::AFTER_DRAIN) { E.fused(acc, cur, wr, wc, fr, fq, lds, wid, lane); S.done(cur); }
    PG8_STAMP();
    if (STAMP && wid == 0) { stamps[lane] = lane < nts ? (((unsigned long long)(unsigned)ts_hi << 32) | (unsigned)ts_lo) : 0ull;
        if (lane == 62) stamps[62] = rt_entry; if (lane == 63) stamps[63] = (unsigned long long)wall_clock64(); }
#undef PG8_STAMP
#undef PG8_SA
#undef PG8_SB
#undef PG8_STAGE
#undef PG8_LDA
#undef PG8_LDB
#undef PG8_MMA
#undef PG8_WAIT_V
#undef PG8_WAIT_L
#undef PG8_BAR
#undef PG8_SCHED
}
}

__device__ __forceinline__ int sched256(int i, int T) {
    const int x = RBID & 7, lb = RBID >> 3, nlb = RGRID >> 3;
    const int chunk = (T + 7) >> 3, local = lb + i * nlb;
    if (local >= chunk) return -1;
    const int t = x * chunk + local;
    return t < T ? t : -1;
}
#define W8V const int w8_ = __builtin_amdgcn_readfirstlane(RTID >> 6), wm2_ = w8_ >> 2, wn4_ = w8_ & 3; const int half_ = w8_ >> 2; (void)half_
__device__ __forceinline__ float fq_sum(float v) { v += __shfl_xor(v, 16); v += __shfl_xor(v, 32); return v; }
__device__ __forceinline__ float fq_max(float v) { v = fmaxf(v, __shfl_xor(v, 16)); v = fmaxf(v, __shfl_xor(v, 32)); return v; }

#define WSP(T, off) ((T*)(p.ws + (off)))
#define TIDV const int tid = VTID, lane = tid & 63, wid = __builtin_amdgcn_readfirstlane(tid >> 6), wm = wid >> 1, wn = wid & 1, fr = lane & 15, fq = lane >> 4; (void)wm; (void)wn; (void)fr; (void)fq; (void)lane; (void)wid

__device__ __forceinline__ void p0_transpose(const Params& p, int item, LAS char* lds) {
    TIDV;
    LAS float* tile = (LAS float*)lds;
    int r = item; const float* s0; const float* s1 = nullptr; const float* ksc = nullptr; bf16_t* dst; int K = 1024, NT, ld, mode = 0, kso = 0, nvalid; float mul = 1.f;
    if (r < 704) { s0 = p.in[8]; dst = WSP(bf16_t, W_WIN); NT = 44; ld = 2568; nvalid = 2568; }
    else if ((r -= 704) < 512) { s0 = p.in[23]; s1 = p.in[24]; dst = WSP(bf16_t, W_WKV); mode = 1; NT = 32; ld = 1024; nvalid = 2048; }
    else if ((r -= 512) < 256) { s0 = p.in[19]; dst = WSP(bf16_t, W_WOUT); ksc = p.in[18]; kso = 512; NT = 16; ld = 1024; nvalid = 1024; }
    else if ((r -= 256) < 256) { s0 = p.in[22]; dst = WSP(bf16_t, W_WQ); ksc = p.in[20]; mul = 0.0625f; NT = 16; ld = 1024; nvalid = 1024; }
    else if ((r -= 256) < 256) { s0 = p.in[25]; dst = WSP(bf16_t, W_WXO); NT = 16; ld = 1024; nvalid = 1024; }
    else if ((r -= 256) < 1408) { s0 = p.in[27]; s1 = p.in[28]; dst = WSP(bf16_t, W_WGU); mode = 2; ksc = p.in[26]; NT = 88; ld = 2816; nvalid = 5632; }
    else { r -= 1408; s0 = p.in[29]; dst = WSP(bf16_t, W_WD); K = 2816; NT = 16; ld = 1024; nvalid = 1024; }
    const int kt = r / NT, nt = r - kt * NT, k0 = kt * 64, n0 = nt * 64;
    {
        const int tn = (tid & 15) * 4, tk = tid >> 4, n = n0 + tn;
        const float* src = s0; size_t coff = 0; const bool valid = n < nvalid;
        if (mode == 0) coff = n;
        else if (mode == 1) { if (n >= 1024) { src = s1; coff = n - 1024; } else coff = n; }
        else { const int grp = n >> 5, w = n & 31; coff = grp * 16 + (w & 15); if (w >> 4) src = s1; }
        f32x4 v[4];
#pragma unroll
        for (int i = 0; i < 4; ++i) { const int k = k0 + tk + 16 * i; v[i] = valid ? *(const f32x4*)(src + (size_t)k * ld + coff) : (f32x4){0.f, 0.f, 0.f, 0.f}; }
#pragma unroll
        for (int i = 0; i < 4; ++i) {
            const int k = k0 + tk + 16 * i;
            float sc_ = mul; if (ksc && k >= kso) sc_ *= ksc[k - kso];
            LAS float* t_ = tile + (tk + 16 * i) * 65 + tn;
            t_[0] = v[i][0] * sc_; t_[1] = v[i][1] * sc_; t_[2] = v[i][2] * sc_; t_[3] = v[i][3] * sc_;
        }
    }
    __syncthreads();
    {
        const int c = tid & 7, nl = tid >> 3;
#pragma unroll
        for (int j = 0; j < 2; ++j) {
            const int n = nl + 32 * j;
            const LAS float* s = tile + (c * 8) * 65 + n;
            u32x4 o; o.x = pk2(s[0], s[65]); o.y = pk2(s[2 * 65], s[3 * 65]); o.z = pk2(s[4 * 65], s[5 * 65]); o.w = pk2(s[6 * 65], s[7 * 65]);
            *(u32x4*)(dst + (size_t)(n0 + n) * K + k0 + c * 8) = o;
        }
    }
    __syncthreads();
}
__device__ __forceinline__ void p0_rownorm(const Params& p, int ri) {
    TIDV;
    const int row = ri * 4 + wid;
    const float* src; const float* g; bf16_t* dst;
    if (row < MT) { src = row < MP ? p.in[0] + (size_t)row * 1024 : p.in[1] + (size_t)(row - MP) * 1024; g = p.in[7]; dst = WSP(bf16_t, W_XB) + (size_t)row * 1024; }
    else { const int r2 = row - MT; src = p.in[6] + (size_t)r2 * 1024; g = p.in[21]; dst = WSP(bf16_t, W_MEMB) + (size_t)r2 * 1024; }
    float4 v[4]; float ss = 0.f;
#pragma unroll
    for (int j = 0; j < 4; ++j) { v[j] = *(const float4*)(src + (j * 64 + lane) * 4); ss += v[j].x * v[j].x + v[j].y * v[j].y + v[j].z * v[j].z + v[j].w * v[j].w; }
    const float rstd = rsqrtf(wave_sum(ss) * (1.f / 1024.f) + EPS);
#pragma unroll
    for (int j = 0; j < 4; ++j) {
        const float4 gv = *(const float4*)(g + (j * 64 + lane) * 4);
        u32x2 o; o.x = pk2(v[j].x * rstd * gv.x, v[j].y * rstd * gv.y); o.y = pk2(v[j].z * rstd * gv.z, v[j].w * rstd * gv.w);
        *(u32x2*)(dst + (j * 64 + lane) * 4) = o;
    }
}
__device__ __forceinline__ void phase0(const Params& p, LAS char* lds) {
    const int gtid = VBID * 256 + VTID, gn = VGRID * 256;
    float* z = WSP(float, W_ZERO);
    for (int i = gtid; i < (int)ZERO_FLOATS; i += gn) z[i] = 0.f;
    bf16_t* wsb = WSP(bf16_t, W_WSB); const float* ws = p.in[11];
    for (int i = gtid; i < 4 * 128 * 128; i += gn) { const int s = i & 127, t = (i >> 7) & 127; wsb[i] = (s <= t) ? (bf16_t)(pk2(ws[i], 0.f) & 0xffffu) : (bf16_t)0; }
    for (int it = VBID; it < 4096 + 4640; it += VGRID) {
        if (it < 4096) p0_transpose(p, it, lds); else p0_rownorm(p, it - 4096);
    }
}

template <int NI>
__device__ __forceinline__ void p1_inproj_epi(const Params& p, f32x4 (&acc)[4][NI], const int rbw, const int cbw) {
    TIDV;
    const int n0 = cbw & ~127;
    const int rb = rbw + fr, cb = cbw + fq * 4;
    if (n0 < 512) {
        bf16_t* ub = WSP(bf16_t, W_UB);
#pragma unroll
        for (int mi = 0; mi < 4; ++mi)
#pragma unroll
            for (int ni = 0; ni < NI; ++ni) { const f32x4 a = acc[mi][ni]; u32x2 o; o.x = pk2(gelu_t(a[0]), gelu_t(a[1])); o.y = pk2(gelu_t(a[2]), gelu_t(a[3]));
                *(u32x2*)(ub + (size_t)(rb + mi * 16) * 512 + cb + ni * 16) = o; }
    } else if (n0 < 1024) {
        bf16_t* vg = WSP(bf16_t, W_VG); float* vstat = WSP(float, W_ZERO);
#pragma unroll
        for (int mi = 0; mi < 4; ++mi) {
            float s1 = 0.f, s2 = 0.f;
#pragma unroll
            for (int ni = 0; ni < NI; ++ni) { const f32x4 a = acc[mi][ni]; const float g0 = gelu_t(a[0]), g1 = gelu_t(a[1]), g2 = gelu_t(a[2]), g3 = gelu_t(a[3]);
                u32x2 o; o.x = pk2(g0, g1); o.y = pk2(g2, g3);
                const float r0 = bflo(o.x), r1 = bfhi(o.x), r2 = bflo(o.y), r3 = bfhi(o.y);
                s1 += (r0 + r1) + (r2 + r3); s2 += (r0 * r0 + r1 * r1) + (r2 * r2 + r3 * r3);
                *(u32x2*)(vg + (size_t)(rb + mi * 16) * 512 + (cb - 512) + ni * 16) = o; }
            s1 = fq_sum(s1); s2 = fq_sum(s2);
            if (fq == 0) { atomicAdd(vstat + (size_t)(rb + mi * 16) * 2, s1); atomicAdd(vstat + (size_t)(rb + mi * 16) * 2 + 1, s2); }
        }
    } else if (n0 < 1536) {
        bf16_t* zb = WSP(bf16_t, W_ZB);
#pragma unroll
        for (int mi = 0; mi < 4; ++mi)
#pragma unroll
            for (int ni = 0; ni < NI; ++ni) { const f32x4 a = acc[mi][ni]; u32x2 o; o.x = pk2(a[0], a[1]); o.y = pk2(a[2], a[3]);
                *(u32x2*)(zb + (size_t)(rb + mi * 16) * 512 + (cb - 1024) + ni * 16) = o; }
    } else if (n0 < 2560) {
        bf16_t* xb = WSP(bf16_t, W_XBCB);
#pragma unroll
        for (int mi = 0; mi < 4; ++mi) {
            const int row = rb + mi * 16;
            float* fo = nullptr;
            if (row < MP) { const int t = row & 2047; if (t >= 2045) fo = p.out + O_CONVP + ((size_t)(row >> 11) * 3 + (t - 2045)) * 1024; }
            else fo = p.out + O_CONVS + ((size_t)(row - MP) * 3 + 2) * 1024;
#pragma unroll
            for (int ni = 0; ni < NI; ++ni) { const f32x4 a = acc[mi][ni]; const int ch = cb - 1536 + ni * 16; u32x2 o; o.x = pk2(a[0], a[1]); o.y = pk2(a[2], a[3]);
                *(u32x2*)(xb + (size_t)row * 1024 + ch) = o;
                if (fo) *(f32x4*)(fo + ch) = a; }
        }
    } else {
        float* dtr = WSP(float, W_DTRAW);
        if (cbw == 2560 && fq < 2) {
#pragma unroll
            for (int mi = 0; mi < 4; ++mi) *(f32x4*)(dtr + (size_t)(rb + mi * 16) * 8 + fq * 4) = acc[mi][0];
        }
    }
}
template <int NI>
__device__ __forceinline__ void p1_memkv_epi(const Params& p, f32x4 (&acc)[4][NI], const int rbw, const int cbw) {
    TIDV;
    const int n0 = cbw & ~127;
    const int rb = rbw + fr, cb = cbw + fq * 4;
    if (n0 < 1024) {
        bf16_t* kb = WSP(bf16_t, W_KB);
#pragma unroll
        for (int mi = 0; mi < 4; ++mi)
#pragma unroll
            for (int ni = 0; ni < NI; ++ni) { const f32x4 a = acc[mi][ni]; const size_t o_ = (size_t)(rb + mi * 16) * 1024 + cb + ni * 16;
                *(f32x4*)(p.out + O_MK + o_) = a; u32x2 o; o.x = pk2(a[0], a[1]); o.y = pk2(a[2], a[3]); *(u32x2*)(kb + o_) = o; }
    } else {
        bf16_t* vT = WSP(bf16_t, W_VT);
#pragma unroll
        for (int mi = 0; mi < 4; ++mi)
#pragma unroll
            for (int ni = 0; ni < NI; ++ni) { const f32x4 a = acc[mi][ni]; const int row = rb + mi * 16, c = cb - 1024 + ni * 16;
                *(f32x4*)(p.out + O_MV + (size_t)row * 1024 + c) = a;
                const int b = row >> 8, m = row & 255, head = c >> 8, d = c & 255;
                bf16_t* vp = vT + ((size_t)(b * 4 + head) * 256 + d) * 256 + m;
                const unsigned q0 = pk2(a[0], a[1]), q1 = pk2(a[2], a[3]);
                vp[0] = (bf16_t)(q0 & 0xffffu); vp[256] = (bf16_t)(q0 >> 16); vp[512] = (bf16_t)(q1 & 0xffffu); vp[768] = (bf16_t)(q1 >> 16); }
    }
}
__device__ __forceinline__ void phase1(const Params& p, LAS char* lds, LAS char* ldsh) {
    W8V;
    constexpr int T1 = 64 * 11, T2 = 8 * 8;
    int t;
    for (int i = 0; (t = sched256(i, T1 + T2)) >= 0; ++i) {
        f32x4 acc0[4][4], acc1[4][4]; zero_acc<4>(acc0); zero_acc<4>(acc1);
        int mp, nt;
        if (t < T1) {
            tile_mn(t, 64, 11, mp, nt);
            mma256(acc0, acc1, WSP(bf16_t, W_XB) + (size_t)mp * 256 * 1024, 1024, WSP(bf16_t, W_WIN) + (size_t)nt * 256 * 1024, 1024, 1024, lds);
            const int rb0 = mp * 256 + wm2_ * 128, cbw = nt * 256 + wn4_ * 64;
            p1_inproj_epi<4>(p, acc0, rb0, cbw); p1_inproj_epi<4>(p, acc1, rb0 + 64, cbw);
        } else {
            tile_mn(t - T1, 8, 8, mp, nt);
            mma256(acc0, acc1, WSP(bf16_t, W_MEMB) + (size_t)mp * 256 * 1024, 1024, WSP(bf16_t, W_WKV) + (size_t)nt * 256 * 1024, 1024, 1024, lds);
            const int rb0 = mp * 256 + wm2_ * 128, cbw = nt * 256 + wn4_ * 64;
            p1_memkv_epi<4>(p, acc0, rb0, cbw); p1_memkv_epi<4>(p, acc1, rb0 + 64, cbw);
        }
    }
    if (RBID < 11) {
        const int j = RBID * 2 + half_, jj = j < 21 ? j : 20;
        const int wv_ = __builtin_amdgcn_readfirstlane(VTID >> 6), wmv = wv_ >> 1, wnv = wv_ & 1;
        f32x4 acc[4][4]; zero_acc<4>(acc);
        mma_seg<128, 0>(acc, WSP(bf16_t, W_XB) + (size_t)MP * 1024, 1024, WSP(bf16_t, W_WIN) + (size_t)jj * 128 * 1024, 1024, 1024, ldsh, nullptr);
        if (j < 21) p1_inproj_epi<4>(p, acc, MP + wmv * 64, jj * 128 + wnv * 64);
    }
}

__device__ __forceinline__ void p2_conv(const Params& p, int item, LAS char* lds) {
    TIDV;
    const int cc = item >> 4, slab = item & 15, c = cc & 15, tok0 = cc * 128, ch0 = slab * 64;
    const int cgp = tid & 7, r0 = tid >> 3;
    LAS float* s_acum = (LAS float*)(lds + 40960); LAS float* s_dt = s_acum + 128; LAS float* s_tot = s_acum + 256;
    if (slab < 8) {
        const int h = slab;
        float v = 0.f, dtv = 0.f;
        if (tid < 128) {
            dtv = softplus_f(WSP(float, W_DTRAW)[(size_t)(tok0 + tid) * 8 + h] + p.in[15][h]);
            v = dtv * (-expf(p.in[16][h]));
#pragma unroll
            for (int d = 1; d < 64; d <<= 1) { const float t = __shfl_up(v, d); if (lane >= d) v += t; }
            if (lane == 63) s_tot[wid] = v;
        }
        __syncthreads();
        if (tid < 128) {
            if (wid == 1) v += s_tot[0];
            s_acum[tid] = v; s_dt[tid] = dtv;
            WSP(float, W_ACUM)[(size_t)(cc * 8 + h) * 128 + tid] = v;
            WSP(float, W_DTV)[(size_t)(cc * 8 + h) * 128 + tid] = dtv;
        }
        __syncthreads();
    }
    const bf16_t* xin = WSP(bf16_t, W_XBCB);
    const int chb = ch0 + cgp * 8;
    u32x4 rin[7];
#pragma unroll
    for (int i = 0; i < 7; ++i) {
        const int rr = r0 * 4 - 3 + i;
        if (rr < 0 && c == 0) rin[i] = (u32x4){0u, 0u, 0u, 0u};
        else rin[i] = *(const u32x4*)(xin + (size_t)(tok0 + rr) * 1024 + chb);
    }
    const float* cw = p.in[13]; const float* cbp = p.in[14];
    float o[4][8];
#pragma unroll
    for (int e = 0; e < 8; ++e) {
        const float w0 = cw[chb + e], w1 = cw[1024 + chb + e], w2 = cw[2048 + chb + e], w3 = cw[3072 + chb + e], bb = cbp[chb + e];
        float xin_[7];
#pragma unroll
        for (int i = 0; i < 7; ++i) { const unsigned u = (e >> 1) == 0 ? rin[i].x : (e >> 1) == 1 ? rin[i].y : (e >> 1) == 2 ? rin[i].z : rin[i].w; xin_[i] = (e & 1) ? bfhi(u) : bflo(u); }
#pragma unroll
        for (int r = 0; r < 4; ++r) o[r][e] = silu_f(bb + xin_[r] * w0 + xin_[r + 1] * w1 + xin_[r + 2] * w2 + xin_[r + 3] * w3);
    }
    {
        bf16_t* dstn; int ldn, cofs;
        if (slab < 8) { dstn = WSP(bf16_t, W_XN); ldn = 512; cofs = chb; }
        else if (slab < 12) { dstn = WSP(bf16_t, W_BN); ldn = 256; cofs = chb - 512; }
        else { dstn = WSP(bf16_t, W_CN); ldn = 256; cofs = chb - 768; }
#pragma unroll
        for (int r = 0; r < 4; ++r) { u32x4 q; q.x = pk2(o[r][0], o[r][1]); q.y = pk2(o[r][2], o[r][3]); q.z = pk2(o[r][4], o[r][5]); q.w = pk2(o[r][6], o[r][7]);
            *(u32x4*)(dstn + (size_t)(tok0 + r0 * 4 + r) * ldn + cofs) = q; }
    }
    if (slab < 12) {
        float wv[4] = {1.f, 1.f, 1.f, 1.f};
        if (slab < 8) { const float al_ = s_acum[127];
#pragma unroll
            for (int r = 0; r < 4; ++r) wv[r] = __expf(al_ - s_acum[r0 * 4 + r]) * s_dt[r0 * 4 + r]; }
#pragma unroll
        for (int e = 0; e < 8; ++e) {
            u32x2 q; q.x = pk2(o[0][e], o[1][e]); q.y = pk2(o[2][e], o[3][e]);
            *(LAS u32x2*)(lds + (cgp * 8 + e) * 256 + r0 * 8) = q;
            if (slab < 8) { u32x2 q2; q2.x = pk2(o[0][e] * wv[0], o[1][e] * wv[1]); q2.y = pk2(o[2][e] * wv[2], o[3][e] * wv[3]);
                *(LAS u32x2*)(lds + 16384 + (cgp * 8 + e) * 256 + r0 * 8) = q2; }
        }
        __syncthreads();
        bf16_t* d1; bf16_t* d2 = nullptr; size_t rowbase;
        if (slab < 8) { d1 = WSP(bf16_t, W_XT); d2 = WSP(bf16_t, W_XWT); rowbase = (size_t)(cc * 8 + slab) * 64; }
        else { const int g = (slab - 8) >> 1, half = (slab - 8) & 1; d1 = WSP(bf16_t, W_BT); rowbase = (size_t)(cc * 2 + g) * 128 + half * 64; }
#pragma unroll
        for (int i = 0; i < 4; ++i) {
            const int id = tid + 256 * i, pr = id >> 4, scn = id & 15;
            *(u32x4*)(d1 + (rowbase + pr) * 128 + scn * 8) = *(LAS u32x4*)(lds + pr * 256 + scn * 16);
            if (slab < 8) *(u32x4*)(d2 + (rowbase + pr) * 128 + scn * 8) = *(LAS u32x4*)(lds + 16384 + pr * 256 + scn * 16);
        }
    }
    __syncthreads();
}
__device__ __forceinline__ void p2_vln(const Params& p, int item, LAS char* lds) {
    TIDV;
    const int cc = item >> 2, head = item & 3, c = cc & 15, b = cc >> 4, tok0 = cc * 128;
    const int cgp = tid & 15, r0 = tid >> 4;
    const int chb = head * 128 + cgp * 8;
    const bf16_t* vg = WSP(bf16_t, W_VG); const float* vstat = WSP(float, W_ZERO);
    float lg[8], lb[8];
#pragma unroll
    for (int e = 0; e < 8; ++e) { lg[e] = p.in[9][chb + e]; lb[e] = p.in[10][chb + e]; }
    float o[8][8];
#pragma unroll
    for (int r = 0; r < 8; ++r) {
        const int tok = tok0 + r0 * 8 + r;
        const u32x4 q = *(const u32x4*)(vg + (size_t)tok * 512 + chb);
        const float mean = vstat[(size_t)tok * 2] * (1.f / 512.f);
        const float var = vstat[(size_t)tok * 2 + 1] * (1.f / 512.f) - mean * mean;
        const float rstd = rsqrtf(fmaxf(var, 0.f) + EPS);
        const float xv[8] = {bflo(q.x), bfhi(q.x), bflo(q.y), bfhi(q.y), bflo(q.z), bfhi(q.z), bflo(q.w), bfhi(q.w)};
#pragma unroll
        for (int e = 0; e < 8; ++e) o[r][e] = (xv[e] - mean) * rstd * lg[e] + lb[e];
        if (c == 15) {
            float* go = p.out + O_GVP + ((size_t)(b * 128 + r0 * 8 + r)) * 512 + chb;
            *(f32x4*)go = (f32x4){o[r][0], o[r][1], o[r][2], o[r][3]}; *(f32x4*)(go + 4) = (f32x4){o[r][4], o[r][5], o[r][6], o[r][7]};
        }
    }
#pragma unroll
    for (int e = 0; e < 8; ++e) {
        u32x4 q; q.x = pk2(o[0][e], o[1][e]); q.y = pk2(o[2][e], o[3][e]); q.z = pk2(o[4][e], o[5][e]); q.w = pk2(o[6][e], o[7][e]);
        *(LAS u32x4*)(lds + (cgp * 8 + e) * 256 + r0 * 16) = q;
    }
    __syncthreads();
    bf16_t* dst = WSP(bf16_t, W_VLNT) + (size_t)(cc * 4 + head) * 128 * 128;
#pragma unroll
    for (int i = 0; i < 8; ++i) { const int id = tid + 256 * i, pr = id >> 4, scn = id & 15;
        *(u32x4*)(dst + (size_t)pr * 128 + scn * 8) = *(LAS u32x4*)(lds + pr * 256 + scn * 16); }
    __syncthreads();
}
__device__ __forceinline__ void p2_sample_ssd(const Params& p, int item, LAS char* lds) {
    TIDV;
    const int bs = item >> 3, h = item & 7, g = h >> 2;
    LAS float* s_x = (LAS float*)lds; LAS float* s_B = s_x + 64; LAS float* s_C = s_B + 128; LAS float* s_y = s_C + 128;
    const float* scv = p.in[3] + (size_t)bs * 3 * 1024;
    const float* xrow = p.out + O_CONVS + ((size_t)bs * 3 + 2) * 1024;
    const float* cw = p.in[13]; const float* cbp = p.in[14];
    for (int idx = tid; idx < 320; idx += 256) {
        int ch; if (idx < 64) ch = h * 64 + idx; else if (idx < 192) ch = 512 + g * 128 + (idx - 64); else ch = 768 + g * 128 + (idx - 192);
        const float v = cbp[ch] + scv[ch] * cw[ch] + scv[1024 + ch] * cw[1024 + ch] + scv[2048 + ch] * cw[2048 + ch] + xrow[ch] * cw[3072 + ch];
        s_x[idx] = silu_f(v);
    }
    __syncthreads();
    const float dt = softplus_f(WSP(float, W_DTRAW)[(size_t)(MP + bs) * 8 + h] + p.in[15][h]);
    const float dA = expf(dt * (-expf(p.in[16][h])));
    const int l = tid & 31, rg = tid >> 5;
    const f32x4 Bv = *(LAS f32x4*)(s_B + l * 4), Cv = *(LAS f32x4*)(s_C + l * 4);
    const float* h0 = p.in[2] + ((size_t)(bs * 8 + h) * 64) * 128;
    float* ho = p.out + O_SSMS + ((size_t)(bs * 8 + h) * 64) * 128;
    f32x4 hv[8];
#pragma unroll
    for (int i = 0; i < 8; ++i) hv[i] = __builtin_nontemporal_load((const f32x4*)(h0 + (size_t)(rg + 8 * i) * 128 + l * 4));
#pragma unroll
    for (int i = 0; i < 8; ++i) {
        const int pp = rg + 8 * i;
        const float dx = dt * s_x[pp];
        f32x4 hn = hv[i] * dA + Bv * dx;
        __builtin_nontemporal_store(hn, (f32x4*)(ho + (size_t)pp * 128 + l * 4));
        float y = hn[0] * Cv[0] + hn[1] * Cv[1] + hn[2] * Cv[2] + hn[3] * Cv[3];
        y += __shfl_xor(y, 16); y += __shfl_xor(y, 8); y += __shfl_xor(y, 4); y += __shfl_xor(y, 2); y += __shfl_xor(y, 1);
        if (l == 0) s_y[pp] = y;
    }
    __syncthreads();
    if (tid < 64) {
        const float xv = s_x[tid];
        const float y = s_y[tid] + p.in[17][h] * xv;
        const float z = bf2f(WSP(bf16_t, W_ZB)[(size_t)(MP + bs) * 512 + h * 64 + tid]);
        const float yz = y * silu_f(z);
        const unsigned q = pk2(yz, 0.f) & 0xffffu;
        WSP(bf16_t, W_CONCAT)[(size_t)(MP + bs) * 1024 + 512 + h * 64 + tid] = (bf16_t)q;
        const float yr = bflo(q);
        const float ssq = wave_sum(yr * yr);
        if (tid == 0) atomicAdd(WSP(float, W_ZERO) + (size_t)MT * 2 + (size_t)(MP + bs) * 2 + g, ssq);
    }
    __syncthreads();
}
__device__ __forceinline__ void p2_sample_misc(const Params& p, int bs) {
    TIDV;
    const float* vstat = WSP(float, W_ZERO);
    const int tok = MP + bs;
    const float mean = vstat[(size_t)tok * 2] * (1.f / 512.f);
    const float var = vstat[(size_t)tok * 2 + 1] * (1.f / 512.f) - mean * mean;
    const float rstd = rsqrtf(fmaxf(var, 0.f) + EPS);
    for (int ch = tid; ch < 512; ch += 256) {
        const int hd = ch >> 7;
        const float v = bf2f(WSP(bf16_t, W_VG)[(size_t)tok * 512 + ch]);
        const float vl = (v - mean) * rstd * p.in[9][ch] + p.in[10][ch];
        p.out[O_GVS + (size_t)bs * 512 + ch] = vl;
        const float u = bf2f(WSP(bf16_t, W_UB)[(size_t)tok * 512 + ch]);
        const float gout = u * (p.in[11][hd * 128 * 128] * vl + p.in[12][hd * 128]);
        WSP(bf16_t, W_CONCAT)[(size_t)tok * 1024 + ch] = (bf16_t)(pk2(gout, 0.f) & 0xffffu);
    }
    const float* scv = p.in[3] + (size_t)bs * 3 * 1024;
    float* co = p.out + O_CONVS + (size_t)bs * 3 * 1024;
    for (int i = tid; i < 2048; i += 256) co[i] = scv[1024 + i];
}
__device__ __forceinline__ void phase2(const Params& p, LAS char* lds) {
    constexpr int N1 = 1024, N2 = 2048, N3 = 512, N4 = 128;
    for (int it = VBID; it < N1 + N2 + N3 + N4; it += VGRID) {
        if (it < N1) p2_sample_ssd(p, it, lds);
        else if (it < N1 + N2) p2_conv(p, it - N1, lds);
        else if (it < N1 + N2 + N3) p2_vln(p, it - N1 - N2, lds);
        else p2_sample_misc(p, it - N1 - N2 - N3);
    }
}

__device__ __forceinline__ void p3_cb(const Params& p, int item, LAS char* lds) {
    TIDV;
    const int cc = item >> 2, g = (item >> 1) & 1, hpair = item & 1, tok0 = cc * 128;
    f32x4 acc[4][4]; zero_acc<4>(acc);
    mma_seg<128, 0>(acc, WSP(bf16_t, W_CN) + (size_t)tok0 * 256 + g * 128, 256, WSP(bf16_t, W_BN) + (size_t)tok0 * 256 + g * 128, 256, 128, lds, nullptr);
    const int tb = wm * 64 + fr, sb = wn * 64 + fq * 4;
#pragma unroll 1
    for (int jh2 = 0; jh2 < 2; ++jh2) {
        const int h = g * 4 + hpair * 2 + jh2;
        const float* ac = WSP(float, W_ACUM) + (size_t)(cc * 8 + h) * 128;
        const float* dv = WSP(float, W_DTV) + (size_t)(cc * 8 + h) * 128;
        bf16_t* mt_ = WSP(bf16_t, W_MT) + (size_t)(cc * 8 + h) * 128 * 128;
        float at[4];
#pragma unroll
        for (int mi = 0; mi < 4; ++mi) at[mi] = ac[tb + mi * 16];
#pragma unroll
        for (int ni = 0; ni < 4; ++ni) {
            const f32x4 as = *(const f32x4*)(ac + sb + ni * 16), ds = *(const f32x4*)(dv + sb + ni * 16);
#pragma unroll
            for (int mi = 0; mi < 4; ++mi) {
                const int t = tb + mi * 16, s0 = sb + ni * 16;
                float v[4];
#pragma unroll
                for (int j = 0; j < 4; ++j) v[j] = (s0 + j <= t) ? acc[mi][ni][j] * __expf(at[mi] - as[j]) * ds[j] : 0.f;
                u32x2 o; o.x = pk2(v[0], v[1]); o.y = pk2(v[2], v[3]);
                *(u32x2*)(mt_ + (size_t)t * 128 + s0) = o;
            }
        }
    }
}
__device__ __forceinline__ void p3_gmlp(const Params& p, int item, LAS char* lds) {
    TIDV;
    const int cc = item >> 2, head = item & 3, tok0 = cc * 128;
    f32x4 acc[4][4]; zero_acc<4>(acc);
    mma_seg<128, 0>(acc, WSP(bf16_t, W_WSB) + (size_t)head * 128 * 128, 128, WSP(bf16_t, W_VLNT) + (size_t)(cc * 4 + head) * 128 * 128, 128, 128, lds, nullptr);
    const int tb = wm * 64 + fr, db = wn * 64 + fq * 4;
    const bf16_t* ub = WSP(bf16_t, W_UB); bf16_t* cat = WSP(bf16_t, W_CONCAT);
#pragma unroll
    for (int mi = 0; mi < 4; ++mi) {
        const int t = tb + mi * 16;
        const float bias = p.in[12][head * 128 + t];
#pragma unroll
        for (int ni = 0; ni < 4; ++ni) {
            const int d = db + ni * 16;
            const u32x2 uq = *(const u32x2*)(ub + (size_t)(tok0 + t) * 512 + head * 128 + d);
            const f32x4 a = acc[mi][ni];
            u32x2 o; o.x = pk2((a[0] + bias) * bflo(uq.x), (a[1] + bias) * bfhi(uq.x)); o.y = pk2((a[2] + bias) * bflo(uq.y), (a[3] + bias) * bfhi(uq.y));
            *(u32x2*)(cat + (size_t)(tok0 + t) * 1024 + head * 128 + d) = o;
        }
    }
}
__device__ __forceinline__ void p3_states(const Params& p, int item, LAS char* lds) {
    TIDV;
    const int cc = item >> 3, h = item & 7, g = h >> 2;
    f32x4 acc[4][2]; zero_acc<2>(acc);
    mma_seg<64, 0>(acc, WSP(bf16_t, W_BT) + (size_t)(cc * 2 + g) * 128 * 128, 128, WSP(bf16_t, W_XWT) + (size_t)(cc * 8 + h) * 64 * 128, 128, 128, lds, nullptr);
    float* sc = WSP(float, W_SC) + (size_t)(cc * 8 + h) * 64 * 128;
    const int nb = wm * 64 + fr, pb = wn * 32 + fq * 4;
#pragma unroll
    for (int mi = 0; mi < 4; ++mi)
#pragma unroll
        for (int ni = 0; ni < 2; ++ni)
#pragma unroll
            for (int j = 0; j < 4; ++j) sc[(size_t)(pb + ni * 16 + j) * 128 + nb + mi * 16] = acc[mi][ni][j];
}
__device__ __forceinline__ void phase3(const Params& p, LAS char* lds) {
    constexpr int N1 = 512, N2 = 512, N3 = 1024;
    for (int it = VBID; it < N1 + N2 + N3; it += VGRID) {
        if (it < N1) p3_cb(p, it, lds);
        else if (it < N1 + N2) p3_gmlp(p, it - N1, lds);
        else p3_states(p, it - N1 - N2, lds);
    }
}

__device__ __forceinline__ void phase4(const Params& p) {
    for (int it = VBID; it < 512; it += VGRID) {
        const int idx4 = it * 256 + VTID;
        const int bh = idx4 >> 11, rem = (idx4 & 2047) * 4, b = bh >> 3, h = bh & 7;
        const float* sc = WSP(float, W_SC); bf16_t* hp_ = WSP(bf16_t, W_HPREV); const float* ac = WSP(float, W_ACUM);
        f32x4 sv[16]; float dec[16];
#pragma unroll
        for (int c = 0; c < 16; ++c) {
            sv[c] = *(const f32x4*)(sc + ((size_t)((b * 16 + c) * 8 + h)) * 8192 + rem);
            dec[c] = ac[(size_t)((b * 16 + c) * 8 + h) * 128 + 127];
        }
        f32x4 st = {0.f, 0.f, 0.f, 0.f};
#pragma unroll
        for (int c = 0; c < 16; ++c) {
            const size_t base = ((size_t)((b * 16 + c) * 8 + h)) * 8192 + rem;
            u32x2 o; o.x = pk2(st[0], st[1]); o.y = pk2(st[2], st[3]);
            *(u32x2*)(hp_ + base) = o;
            st = st * __expf(dec[c]) + sv[c];
        }
        *(f32x4*)(p.out + O_SSMP + (size_t)idx4 * 4) = st;
    }
}

__device__ __forceinline__ void p5_y(const Params& p, int item, LAS char* lds) {
    TIDV;
    const int cc = item >> 3, h = item & 7, g = h >> 2, tok0 = cc * 128;
    f32x4 acc[4][2]; zero_acc<2>(acc);
    mma_seg<64, 0>(acc, WSP(bf16_t, W_CN) + (size_t)tok0 * 256 + g * 128, 256, WSP(bf16_t, W_HPREV) + (size_t)(cc * 8 + h) * 64 * 128, 128, 128, lds, nullptr);
    const float* ac = WSP(float, W_ACUM) + (size_t)(cc * 8 + h) * 128;
    const int tb = wm * 64 + fr, pb = wn * 32 + fq * 4;
#pragma unroll
    for (int mi = 0; mi < 4; ++mi) { const float e = __expf(ac[tb + mi * 16]);
#pragma unroll
        for (int ni = 0; ni < 2; ++ni) acc[mi][ni] = acc[mi][ni] * e; }
    mma_seg<64, 0>(acc, WSP(bf16_t, W_MT) + (size_t)(cc * 8 + h) * 128 * 128, 128, WSP(bf16_t, W_XT) + (size_t)(cc * 8 + h) * 64 * 128, 128, 128, lds, nullptr);
    const float dsk = p.in[17][h];
    const bf16_t* xn = WSP(bf16_t, W_XN); const bf16_t* zb = WSP(bf16_t, W_ZB); bf16_t* cat = WSP(bf16_t, W_CONCAT);
    float* gss = WSP(float, W_ZERO) + (size_t)MT * 2;
#pragma unroll
    for (int mi = 0; mi < 4; ++mi) {
        const int tok = tok0 + tb + mi * 16;
        float ssq = 0.f;
#pragma unroll
        for (int ni = 0; ni < 2; ++ni) {
            const int pc = h * 64 + pb + ni * 16;
            const u32x2 xq = *(const u32x2*)(xn + (size_t)tok * 512 + pc), zq = *(const u32x2*)(zb + (size_t)tok * 512 + pc);
            const f32x4 a = acc[mi][ni];
            const float y0 = (a[0] + dsk * bflo(xq.x)) * silu_f(bflo(zq.x)), y1 = (a[1] + dsk * bfhi(xq.x)) * silu_f(bfhi(zq.x));
            const float y2 = (a[2] + dsk * bflo(xq.y)) * silu_f(bflo(zq.y)), y3 = (a[3] + dsk * bfhi(xq.y)) * silu_f(bfhi(zq.y));
            u32x2 o; o.x = pk2(y0, y1); o.y = pk2(y2, y3);
            const float r0 = bflo(o.x), r1 = bfhi(o.x), r2 = bflo(o.y), r3 = bfhi(o.y);
            ssq += (r0 * r0 + r1 * r1) + (r2 * r2 + r3 * r3);
            *(u32x2*)(cat + (size_t)tok * 1024 + 512 + pc) = o;
        }
        ssq = fq_sum(ssq);
        if (fq == 0) atomicAdd(gss + (size_t)tok * 2 + g, ssq);
    }
}
__device__ __forceinline__ void phase5(const Params& p, LAS char* lds) {
    for (int it = VBID; it < 1024; it += VGRID) p5_y(p, it, lds);
}

template <int MODE, int NI>
__device__ __forceinline__ void res_epi(const Params& p, f32x4 (&acc)[4][NI], const int rbw, const int cbw) {
    TIDV;
    const int rb = rbw + fr, cb = cbw + fq * 4;
    float* hp = WSP(float, W_HP); bf16_t* hpb = WSP(bf16_t, W_HPB);
    float* ssq_ = WSP(float, W_ZERO) + (size_t)MT * 4 + (size_t)MT * MODE;
#pragma unroll
    for (int mi = 0; mi < 4; ++mi) {
        const int row = rb + mi * 16;
        const float* rsrc;
        if (MODE == 0) rsrc = row < MP ? p.in[0] + (size_t)row * 1024 : p.in[1] + (size_t)(row - MP) * 1024;
        else rsrc = hp + (size_t)row * 1024;
        float ssq = 0.f;
#pragma unroll
        for (int ni = 0; ni < NI; ++ni) {
            const int col = cb + ni * 16;
            const f32x4 r = *(const f32x4*)(rsrc + col);
            const f32x4 v = acc[mi][ni] + r;
            *(f32x4*)(hp + (size_t)row * 1024 + col) = v;
            ssq += (v[0] * v[0] + v[1] * v[1]) + (v[2] * v[2] + v[3] * v[3]);
            if (MODE != 2) { u32x2 o; o.x = pk2(v[0], v[1]); o.y = pk2(v[2], v[3]); *(u32x2*)(hpb + (size_t)row * 1024 + col) = o; }
        }
        if (MODE != 2) { ssq = fq_sum(ssq); if (fq == 0) atomicAdd(ssq_ + row, ssq); }
    }
}
template <int MODE>
__device__ __forceinline__ void phase_res(const Params& p, LAS char* lds, LAS char* ldsh) {
    W8V;
    const int lane_ = RTID & 63, fr_ = lane_ & 15;
    int t;
    for (int i = 0; (t = sched256(i, 64 * 4)) >= 0; ++i) {
        int mp, nt; tile_mn(t, 64, 4, mp, nt);
        f32x4 acc0[4][4], acc1[4][4]; zero_acc<4>(acc0); zero_acc<4>(acc1);
        const int rb0 = mp * 256 + wm2_ * 128, cbw = nt * 256 + wn4_ * 64;
        if (MODE == 0) {
            const bf16_t* Ab = WSP(bf16_t, W_CONCAT) + (size_t)mp * 256 * 1024; const bf16_t* Wb = WSP(bf16_t, W_WOUT) + (size_t)nt * 256 * 1024;
            const float* gss = WSP(float, W_ZERO) + (size_t)MT * 2;
            mma256(acc0, acc1, Ab + 512, 1024, Wb + 512, 1024, 256, lds);
#pragma unroll
            for (int mi = 0; mi < 4; ++mi) { const int ra = rb0 + mi * 16 + fr_, rbb = ra + 64;
                const float fa = rsqrtf(gss[(size_t)ra * 2] * (1.f / 256.f) + EPS) / rsqrtf(gss[(size_t)ra * 2 + 1] * (1.f / 256.f) + EPS);
                const float fb = rsqrtf(gss[(size_t)rbb * 2] * (1.f / 256.f) + EPS) / rsqrtf(gss[(size_t)rbb * 2 + 1] * (1.f / 256.f) + EPS);
#pragma unroll
                for (int ni = 0; ni < 4; ++ni) { acc0[mi][ni] = acc0[mi][ni] * fa; acc1[mi][ni] = acc1[mi][ni] * fb; } }
            mma256(acc0, acc1, Ab + 768, 1024, Wb + 768, 1024, 256, lds);
#pragma unroll
            for (int mi = 0; mi < 4; ++mi) { const int ra = rb0 + mi * 16 + fr_, rbb = ra + 64;
                const float r1a = rsqrtf(gss[(size_t)ra * 2 + 1] * (1.f / 256.f) + EPS), r1b = rsqrtf(gss[(size_t)rbb * 2 + 1] * (1.f / 256.f) + EPS);
#pragma unroll
                for (int ni = 0; ni < 4; ++ni) { acc0[mi][ni] = acc0[mi][ni] * r1a; acc1[mi][ni] = acc1[mi][ni] * r1b; } }
            mma256(acc0, acc1, Ab, 1024, Wb, 1024, 512, lds);
        } else if (MODE == 1) {
            mma256(acc0, acc1, WSP(bf16_t, W_OB) + (size_t)mp * 256 * 1024, 1024, WSP(bf16_t, W_WXO) + (size_t)nt * 256 * 1024, 1024, 1024, lds);
        } else {
            mma256(acc0, acc1, WSP(bf16_t, W_ACT) + (size_t)mp * 256 * 2816, 2816, WSP(bf16_t, W_WD) + (size_t)nt * 256 * 2816, 2816, 2816, lds);
        }
        res_epi<MODE, 4>(p, acc0, rb0, cbw); res_epi<MODE, 4>(p, acc1, rb0 + 64, cbw);
    }
    const int wv_ = __builtin_amdgcn_readfirstlane(VTID >> 6), wmv = wv_ >> 1, wnv = wv_ & 1, lanev = VTID & 63, frv = lanev & 15, fqv = lanev >> 4;
    if (MODE != 2) {
        if (RBID < 4) {
            const int j = RBID * 2 + half_, n0 = j * 128;
            f32x4 acc[4][4]; zero_acc<4>(acc);
            if (MODE == 0) {
                const bf16_t* Ab = WSP(bf16_t, W_CONCAT) + (size_t)MP * 1024; const bf16_t* Wb = WSP(bf16_t, W_WOUT) + (size_t)n0 * 1024;
                const float* gss = WSP(float, W_ZERO) + (size_t)MT * 2;
                float r0[4], r1[4];
#pragma unroll
                for (int mi = 0; mi < 4; ++mi) { const int row = MP + wmv * 64 + mi * 16 + frv;
                    r0[mi] = rsqrtf(gss[(size_t)row * 2] * (1.f / 256.f) + EPS); r1[mi] = rsqrtf(gss[(size_t)row * 2 + 1] * (1.f / 256.f) + EPS); }
                mma_seg<128, 0>(acc, Ab + 512, 1024, Wb + 512, 1024, 256, ldsh, nullptr);
#pragma unroll
                for (int mi = 0; mi < 4; ++mi) { const float f = r0[mi] / r1[mi];
#pragma unroll
                    for (int ni = 0; ni < 4; ++ni) acc[mi][ni] = acc[mi][ni] * f; }
                mma_seg<128, 0>(acc, Ab + 768, 1024, Wb + 768, 1024, 256, ldsh, nullptr);
#pragma unroll
                for (int mi = 0; mi < 4; ++mi)
#pragma unroll
                    for (int ni = 0; ni < 4; ++ni) acc[mi][ni] = acc[mi][ni] * r1[mi];
                mma_seg<128, 0>(acc, Ab, 1024, Wb, 1024, 512, ldsh, nullptr);
            } else {
                mma_seg<128, 0>(acc, WSP(bf16_t, W_OB) + (size_t)MP * 1024, 1024, WSP(bf16_t, W_WXO) + (size_t)n0 * 1024, 1024, 1024, ldsh, nullptr);
            }
            res_epi<MODE, 4>(p, acc, MP + wmv * 64, n0 + wnv * 64);
        }
    } else {
        if (RBID < 16) {
            const int j = RBID * 2 + half_, nt = j & 7, ks = j >> 3, n0 = nt * 128;
            f32x4 acc[4][4]; zero_acc<4>(acc);
            mma_seg<128, 0>(acc, WSP(bf16_t, W_ACT) + (size_t)MP * 2816 + ks * 704, 2816, WSP(bf16_t, W_WD) + (size_t)n0 * 2816 + ks * 704, 2816, 704, ldsh, nullptr);
            float* hp = WSP(float, W_HP);
            const int rb = MP + wmv * 64 + frv, cb = n0 + wnv * 64 + fqv * 4;
#pragma unroll
            for (int mi = 0; mi < 4; ++mi)
#pragma unroll
                for (int ni = 0; ni < 4; ++ni)
#pragma unroll
                    for (int jj = 0; jj < 4; ++jj) atomicAdd(hp + (size_t)(rb + mi * 16) * 1024 + cb + ni * 16 + jj, acc[mi][ni][jj]);
        }
    }
}

template <int NI>
__device__ __forceinline__ void p7_epi(const Params& p, f32x4 (&acc)[4][NI], const int rbw, const int cbw) {
    TIDV;
    const int rb = rbw + fr, cb = cbw + fq * 4;
    const float* ss1 = WSP(float, W_ZERO) + (size_t)MT * 4;
    bf16_t* qb = WSP(bf16_t, W_QB);
#pragma unroll
    for (int mi = 0; mi < 4; ++mi) {
        const int row = rb + mi * 16;
        const float rs = rsqrtf(ss1[row] * (1.f / 1024.f) + EPS);
#pragma unroll
        for (int ni = 0; ni < NI; ++ni) { const f32x4 a = acc[mi][ni] * rs; u32x2 o; o.x = pk2(a[0], a[1]); o.y = pk2(a[2], a[3]);
            *(u32x2*)(qb + (size_t)row * 1024 + cb + ni * 16) = o; }
    }
}
__device__ __forceinline__ void phase7(const Params& p, LAS char* lds, LAS char* ldsh) {
    W8V;
    int t;
    for (int i = 0; (t = sched256(i, 64 * 4)) >= 0; ++i) {
        int mp, nt; tile_mn(t, 64, 4, mp, nt);
        f32x4 acc0[4][4], acc1[4][4]; zero_acc<4>(acc0); zero_acc<4>(acc1);
        mma256(acc0, acc1, WSP(bf16_t, W_HPB) + (size_t)mp * 256 * 1024, 1024, WSP(bf16_t, W_WQ) + (size_t)nt * 256 * 1024, 1024, 1024, lds);
        const int rb0 = mp * 256 + wm2_ * 128, cbw = nt * 256 + wn4_ * 64;
        p7_epi<4>(p, acc0, rb0, cbw); p7_epi<4>(p, acc1, rb0 + 64, cbw);
    }
    if (RBID < 4) {
        const int j = RBID * 2 + half_, n0 = j * 128;
        const int wv_ = __builtin_amdgcn_readfirstlane(VTID >> 6), wmv = wv_ >> 1, wnv = wv_ & 1;
        f32x4 acc[4][4]; zero_acc<4>(acc);
        mma_seg<128, 0>(acc, WSP(bf16_t, W_HPB) + (size_t)MP * 1024, 1024, WSP(bf16_t, W_WQ) + (size_t)n0 * 1024, 1024, 1024, ldsh, nullptr);
        p7_epi<4>(p, acc, MP + wmv * 64, n0 + wnv * 64);
    }
}

__device__ __forceinline__ void p8_prompt(const Params& p, int item, LAS char* lds) {
    TIDV;
    const int qt = item & 15, head = (item >> 4) & 3, b = item >> 6;
    const int tokq = b * 2048 + qt * 128;
    const bf16_t* qa = WSP(bf16_t, W_QB) + (size_t)tokq * 1024 + head * 256;
    const bf16_t* kbp = WSP(bf16_t, W_KB) + (size_t)(b * 256) * 1024 + head * 256;
    f32x4 s0[4][4], s1[4][4]; zero_acc<4>(s0); zero_acc<4>(s1);
    mma_seg<128, 0>(s0, qa, 1024, kbp, 1024, 256, lds, nullptr);
    mma_seg<128, 0>(s1, qa, 1024, kbp + (size_t)128 * 1024, 1024, 256, lds, nullptr);
    LAS float* red = (LAS float*)(lds + (LDS_MISC + 64) - __builtin_amdgcn_readfirstlane(RTID >> 8) * 61440);
    float rinv[4];
    float mx[4];
#pragma unroll
    for (int mi = 0; mi < 4; ++mi) {
        float m = -3.0e38f;
#pragma unroll
        for (int ni = 0; ni < 4; ++ni)
#pragma unroll
            for (int j = 0; j < 4; ++j) m = fmaxf(m, fmaxf(s0[mi][ni][j], s1[mi][ni][j]));
        m = fq_max(m);
        if (fq == 0) red[wn * 128 + wm * 64 + mi * 16 + fr] = m;
        mx[mi] = m;
    }
    __syncthreads();
#pragma unroll
    for (int mi = 0; mi < 4; ++mi) mx[mi] = fmaxf(mx[mi], red[(wn ^ 1) * 128 + wm * 64 + mi * 16 + fr]);
#pragma unroll
    for (int mi = 0; mi < 4; ++mi) {
        float sum = 0.f;
        const int t = wm * 64 + mi * 16 + fr;
#pragma unroll
        for (int ni = 0; ni < 4; ++ni) {
            const int mcol = wn * 64 + ni * 16 + fq * 4;
            u32x2 o0, o1;
            o0.x = pk2(__expf(s0[mi][ni][0] - mx[mi]), __expf(s0[mi][ni][1] - mx[mi])); o0.y = pk2(__expf(s0[mi][ni][2] - mx[mi]), __expf(s0[mi][ni][3] - mx[mi]));
            o1.x = pk2(__expf(s1[mi][ni][0] - mx[mi]), __expf(s1[mi][ni][1] - mx[mi])); o1.y = pk2(__expf(s1[mi][ni][2] - mx[mi]), __expf(s1[mi][ni][3] - mx[mi]));
            sum += (bflo(o0.x) + bfhi(o0.x)) + (bflo(o0.y) + bfhi(o0.y)) + (bflo(o1.x) + bfhi(o1.x)) + (bflo(o1.y) + bfhi(o1.y));
            const int c0 = mcol >> 3, c1 = (mcol + 128) >> 3, sub = (mcol & 7) * 2;
            *(LAS u32x2*)(lds + t * 512 + ((c0 ^ (t & 15)) << 4) + sub) = o0;
            *(LAS u32x2*)(lds + t * 512 + ((c1 ^ (t & 15)) << 4) + sub) = o1;
        }
        sum = fq_sum(sum);
        if (fq == 0) red[256 + wn * 128 + t] = sum;
        rinv[mi] = sum;
        __builtin_amdgcn_sched_barrier(0);
    }
    __syncthreads();
#pragma unroll
    for (int mi = 0; mi < 4; ++mi) rinv[mi] = 1.f / (rinv[mi] + red[256 + (wn ^ 1) * 128 + wm * 64 + mi * 16 + fr]);
    const bf16_t* vtp = WSP(bf16_t, W_VT) + (size_t)(b * 4 + head) * 256 * 256;
    bf16_t* ob = WSP(bf16_t, W_OB);
#pragma unroll 1
    for (int nn = 0; nn < 2; ++nn) {
        f32x4 acc[4][4]; zero_acc<4>(acc);
        const bf16_t* vb = vtp + (size_t)(nn * 128 + wn * 64 + fr) * 256 + fq * 8;
        bf16x8 bcur[4], bnxt[4];
#pragma unroll
        for (int ni = 0; ni < 4; ++ni) bcur[ni] = *(const bf16x8*)(vb + (size_t)(ni * 16) * 256);
#pragma unroll 1
        for (int kk = 0; kk < 8; ++kk) {
            if (kk + 1 < 8) {
#pragma unroll
                for (int ni = 0; ni < 4; ++ni) bnxt[ni] = *(const bf16x8*)(vb + (size_t)(ni * 16) * 256 + (kk + 1) * 32);
            }
            bf16x8 af[4];
#pragma unroll
            for (int mi = 0; mi < 4; ++mi) { const int t = wm * 64 + mi * 16 + fr; af[mi] = *(LAS bf16x8*)(lds + t * 512 + (((kk * 4 + fq) ^ (t & 15)) << 4)); }
#pragma unroll
            for (int mi = 0; mi < 4; ++mi)
#pragma unroll
                for (int ni = 0; ni < 4; ++ni) acc[mi][ni] = __builtin_amdgcn_mfma_f32_16x16x32_bf16(bcur[ni], af[mi], acc[mi][ni], 0, 0, 0);
            if (kk + 1 < 8) {
#pragma unroll
                for (int ni = 0; ni < 4; ++ni) bcur[ni] = bnxt[ni];
            }
        }
#pragma unroll
        for (int mi = 0; mi < 4; ++mi)
#pragma unroll
            for (int ni = 0; ni < 4; ++ni) { const f32x4 a = acc[mi][ni] * rinv[mi]; u32x2 o; o.x = pk2(a[0], a[1]); o.y = pk2(a[2], a[3]);
                *(u32x2*)(ob + (size_t)(tokq + wm * 64 + mi * 16 + fr) * 1024 + head * 256 + nn * 128 + wn * 64 + ni * 16 + fq * 4) = o; }
    }
    __syncthreads();
}
__device__ __forceinline__ void p8_sample(const Params& p, int item, LAS char* lds) {
    TIDV;
    const int bs = item >> 2, head = item & 3;
    LAS float* s_q = (LAS float*)lds; LAS float* s_sc = s_q + 256; LAS float* s_red = s_sc + 256; LAS float* s_part = s_red + 16;
    s_q[tid] = bf2f(WSP(bf16_t, W_QB)[(size_t)(MP + bs) * 1024 + head * 256 + tid]);
    __syncthreads();
    const f32x4 qv = *(LAS f32x4*)(s_q + lane * 4);
    const float* kc = p.in[4] + ((size_t)(bs * 256) * 4 + head) * 256 + lane * 4;
    const float* vc = p.in[5] + ((size_t)(bs * 256) * 4 + head) * 256 + lane * 4;
#pragma unroll 1
    for (int i = 0; i < 64; i += 16) {
        f32x4 kv[16];
#pragma unroll
        for (int u = 0; u < 16; ++u) kv[u] = __builtin_nontemporal_load((const f32x4*)(kc + (size_t)(wid * 64 + i + u) * 1024));
#pragma unroll
        for (int u = 0; u < 16; ++u) { float d = kv[u][0] * qv[0] + kv[u][1] * qv[1] + kv[u][2] * qv[2] + kv[u][3] * qv[3]; d = wave_sum(d); if (lane == 0) s_sc[wid * 64 + i + u] = d; }
    }
    __syncthreads();
    const float sv = s_sc[tid];
    float m = wave_max(sv);
    if (lane == 0) s_red[wid] = m;
    __syncthreads();
    m = fmaxf(fmaxf(s_red[0], s_red[1]), fmaxf(s_red[2], s_red[3]));
    const float e = __expf(sv - m);
    float sm = wave_sum(e);
    if (lane == 0) s_red[4 + wid] = sm;
    s_sc[tid] = e;
    __syncthreads();
    const float inv = 1.f / ((s_red[4] + s_red[5]) + (s_red[6] + s_red[7]));
    f32x4 o = {0.f, 0.f, 0.f, 0.f};
#pragma unroll 1
    for (int i = 0; i < 64; i += 16) {
        f32x4 vv[16];
#pragma unroll
        for (int u = 0; u < 16; ++u) vv[u] = __builtin_nontemporal_load((const f32x4*)(vc + (size_t)(wid * 64 + i + u) * 1024));
#pragma unroll
        for (int u = 0; u < 16; ++u) o = o + vv[u] * s_sc[wid * 64 + i + u];
    }
    *(LAS f32x4*)(s_part + wid * 256 + lane * 4) = o;
    __syncthreads();
    const float r = ((s_part[tid] + s_part[256 + tid]) + (s_part[512 + tid] + s_part[768 + tid])) * inv;
    WSP(bf16_t, W_OB)[(size_t)(MP + bs) * 1024 + head * 256 + tid] = (bf16_t)(pk2(r, 0.f) & 0xffffu);
    __syncthreads();
}
__device__ __forceinline__ void phase8(const Params& p, LAS char* lds) {
    const int flip = (RBID ^ (RBID >> 7)) & 1;
    for (int j = 0; j < 2; ++j) {
        for (int it = VBID + ((j ^ flip) ? 512 : 0); it < ((j ^ flip) ? 1024 : 512); it += VGRID) {
            if (it < 512) p8_sample(p, it, lds); else p8_prompt(p, it - 512, lds);
        }
    }
}

template <int NI>
__device__ __forceinline__ void p10_epi(const Params& p, f32x4 (&acc)[4][NI], const int rbw, const int cbw) {
    TIDV;
    const int rb = rbw + fr, cb = cbw / 2 + fq * 4;
    const float* ss2 = WSP(float, W_ZERO) + (size_t)MT * 5;
    bf16_t* act = WSP(bf16_t, W_ACT);
#pragma unroll
    for (int mi = 0; mi < 4; ++mi) {
        const int row = rb + mi * 16;
        const float rs = rsqrtf(ss2[row] * (1.f / 1024.f) + EPS);
#pragma unroll
        for (int q = 0; q < NI / 2; ++q) {
            const f32x4 g = acc[mi][2 * q] * rs, u = acc[mi][2 * q + 1] * rs;
            u32x2 o; o.x = pk2(silu_f(g[0]) * u[0], silu_f(g[1]) * u[1]); o.y = pk2(silu_f(g[2]) * u[2], silu_f(g[3]) * u[3]);
            *(u32x2*)(act + (size_t)row * 2816 + cb + q * 16) = o;
        }
    }
}
__device__ __forceinline__ void phase10(const Params& p, LAS char* lds, LAS char* ldsh) {
    W8V;
    int t;
    for (int i = 0; (t = sched256(i, 64 * 22)) >= 0; ++i) {
        int mp, nt; tile_mn(t, 64, 22, mp, nt);
        f32x4 acc0[4][4], acc1[4][4]; zero_acc<4>(acc0); zero_acc<4>(acc1);
        mma256(acc0, acc1, WSP(bf16_t, W_HPB) + (size_t)mp * 256 * 1024, 1024, WSP(bf16_t, W_WGU) + (size_t)nt * 256 * 1024, 1024, 1024, lds);
        const int rb0 = mp * 256 + wm2_ * 128, cbw = nt * 256 + wn4_ * 64;
        p10_epi<4>(p, acc0, rb0, cbw); p10_epi<4>(p, acc1, rb0 + 64, cbw);
    }
    if (RBID >= 128 && RBID < 150) {
        const int j = (RBID - 128) * 2 + half_, n0 = j * 128;
        const int wv_ = __builtin_amdgcn_readfirstlane(VTID >> 6), wmv = wv_ >> 1, wnv = wv_ & 1;
        f32x4 acc[4][4]; zero_acc<4>(acc);
        mma_seg<128, 0>(acc, WSP(bf16_t, W_HPB) + (size_t)MP * 1024, 1024, WSP(bf16_t, W_WGU) + (size_t)n0 * 1024, 1024, 1024, ldsh, nullptr);
        p10_epi<4>(p, acc, MP + wmv * 64, n0 + wnv * 64);
    }
}

__device__ __forceinline__ void phase12(const Params& p) {
    const float* hp = WSP(float, W_HP); const float* g = p.in[30];
    const int lane = VTID & 63, wid = VTID >> 6;
    for (int it = VBID; it < MT / 4; it += VGRID) {
        const int row = it * 4 + wid;
        const float* src = hp + (size_t)row * 1024;
        f32x4 v[4]; float ss = 0.f;
#pragma unroll
        for (int j = 0; j < 4; ++j) { v[j] = *(const f32x4*)(src + (j * 64 + lane) * 4); ss += (v[j][0] * v[j][0] + v[j][1] * v[j][1]) + (v[j][2] * v[j][2] + v[j][3] * v[j][3]); }
        const float rs = rsqrtf(wave_sum(ss) * (1.f / 1024.f) + EPS);
#pragma unroll
        for (int j = 0; j < 4; ++j) { const f32x4 gv = *(const f32x4*)(g + (j * 64 + lane) * 4);
            *(f32x4*)(p.out + (size_t)row * 1024 + (j * 64 + lane) * 4) = v[j] * rs * gv; }
    }
}

#ifndef DUMP_SEL
#define DUMP_SEL 0
#endif
__device__ __forceinline__ void phase_dump(const Params& p) {
    const int n = MT * 1024;
    for (int i = VBID * 256 + VTID; i < n; i += VGRID * 256) {
        float v = 0.f;
        if (DUMP_SEL == 1) v = bf2f(WSP(bf16_t, W_CONCAT)[i]);
        else if (DUMP_SEL == 2) v = WSP(float, W_HP)[i];
        else if (DUMP_SEL == 3) v = bf2f(WSP(bf16_t, W_QB)[i]);
        else if (DUMP_SEL == 4) v = bf2f(WSP(bf16_t, W_OB)[i]);
        else if (DUMP_SEL == 5) v = bf2f(WSP(bf16_t, W_HPB)[i]);
        else if (DUMP_SEL == 6) v = bf2f(WSP(bf16_t, W_ACT)[(size_t)(i >> 10) * 2816 + (i & 1023)]);
        p.out[i] = v;
    }
}
__device__ __forceinline__ bool single64_splitk(f32x4 (&acc)[4][2], const bf16_t* A, const int lda, const bf16_t* Bt, const int ldb, const int K, LAS char* lds, LAS char* ldsh, const int half) {
    zero_acc<2>(acc);
    const int kh = K >> 1;
    mma_seg<64, 0>(acc, A + half * kh, lda, Bt + half * kh, ldb, kh, ldsh, nullptr);
    LAS f32x4* xch = (LAS f32x4*)(lds + 65536);
    if (half == 1) {
#pragma unroll
        for (int mi = 0; mi < 4; ++mi)
#pragma unroll
            for (int ni = 0; ni < 2; ++ni) xch[(mi * 2 + ni) * 256 + VTID] = acc[mi][ni];
    }
    __syncthreads();
    if (half == 0) {
#pragma unroll
        for (int mi = 0; mi < 4; ++mi)
#pragma unroll
            for (int ni = 0; ni < 2; ++ni) acc[mi][ni] = acc[mi][ni] + xch[(mi * 2 + ni) * 256 + VTID];
    }
    return half == 0;
}
struct Sched256 {
    int T, NMt, NNt;
    __device__ __forceinline__ bool next(int i, pg8::Unit& u) const { const int t = sched256(i, T); if (t < 0) return false; int mp, nt; tile_mn(t, NMt, NNt, mp, nt); u.pm = mp; u.pn = nt; return true; }
    __device__ __forceinline__ void a_ready(const pg8::Unit&) const {}
    __device__ __forceinline__ void done(const pg8::Unit&) const {}
};
struct SchedMemkv {
    __device__ __forceinline__ bool next(int i, pg8::Unit& u) const { const int idx = RBID - (RGRID - 64); if (i != 0 || idx < 0) return false; u.pm = idx & 7; u.pn = idx >> 3; return true; }
    __device__ __forceinline__ void a_ready(const pg8::Unit&) const {}
    __device__ __forceinline__ void done(const pg8::Unit&) const {}
};
#define PG8_EPI_LOOP(CALL) _Pragma("unroll") for (int ai = 0; ai < 2; ++ai) _Pragma("unroll") for (int bj = 0; bj < 2; ++bj) { const int rbw = u.pm * 256 + ai * 128 + wr * 64, cbw = u.pn * 256 + bj * 128 + wc * 32; CALL; }
struct EpiInproj { static constexpr bool PERM = false, AFTER_DRAIN = false; const Params* pp;
    __device__ __forceinline__ void operator()(f32x4 (&acc)[2][2][4][2], const pg8::Unit& u, int wr, int wc, int, int) const { const Params& p = *pp; PG8_EPI_LOOP(p1_inproj_epi<2>(p, acc[ai][bj], rbw, cbw)) } };
struct EpiMemkv { static constexpr bool PERM = false, AFTER_DRAIN = false; const Params* pp;
    __device__ __forceinline__ void operator()(f32x4 (&acc)[2][2][4][2], const pg8::Unit& u, int wr, int wc, int, int) const { const Params& p = *pp; PG8_EPI_LOOP(p1_memkv_epi<2>(p, acc[ai][bj], rbw, cbw)) } };
struct EpiQ { static constexpr bool PERM = false, AFTER_DRAIN = false; const Params* pp;
    __device__ __forceinline__ void operator()(f32x4 (&acc)[2][2][4][2], const pg8::Unit& u, int wr, int wc, int, int) const { const Params& p = *pp; PG8_EPI_LOOP(p7_epi<2>(p, acc[ai][bj], rbw, cbw)) } };
struct EpiGU { static constexpr bool PERM = false, AFTER_DRAIN = false; const Params* pp;
    __device__ __forceinline__ void operator()(f32x4 (&acc)[2][2][4][2], const pg8::Unit& u, int wr, int wc, int, int) const { const Params& p = *pp; PG8_EPI_LOOP(p10_epi<2>(p, acc[ai][bj], rbw, cbw)) } };
template <int MODE> struct EpiRes { static constexpr bool PERM = false, AFTER_DRAIN = false; const Params* pp;
    __device__ __forceinline__ void operator()(f32x4 (&acc)[2][2][4][2], const pg8::Unit& u, int wr, int wc, int, int) const { const Params& p = *pp; PG8_EPI_LOOP((res_epi<MODE, 2>(p, acc[ai][bj], rbw, cbw))) } };

__device__ __forceinline__ void phase1_g8(const Params& p, LAS char* lds, LAS char* ldsh) {
    W8V;
    pg8::Gemm g1{WSP(bf16_t, W_XB), WSP(bf16_t, W_WIN), MP, 2816, 1024};
    pg8::gemm_phase<EpiInproj, Sched256, false>((PG8_LAS unsigned char*)lds, g1, Sched256{64 * 11, 64, 11}, EpiInproj{&p}, nullptr);
    pg8::Gemm g2{WSP(bf16_t, W_MEMB), WSP(bf16_t, W_WKV), 2048, 2048, 1024};
    pg8::gemm_phase<EpiMemkv, SchedMemkv, false>((PG8_LAS unsigned char*)lds, g2, SchedMemkv{}, EpiMemkv{&p}, nullptr);
    if (RBID < 42) {
        const int n0 = RBID * 64;
        const int wv_ = __builtin_amdgcn_readfirstlane(VTID >> 6), wmv = wv_ >> 1, wnv = wv_ & 1;
        f32x4 acc[4][2];
        if (single64_splitk(acc, WSP(bf16_t, W_XB) + (size_t)MP * 1024, 1024, WSP(bf16_t, W_WIN) + (size_t)n0 * 1024, 1024, 1024, lds, ldsh, half_)) p1_inproj_epi<2>(p, acc, MP + wmv * 64, n0 + wnv * 32);
    }
}
__device__ __forceinline__ void phase5b(const Params& p) {
    const int lane = VTID & 63, wid = __builtin_amdgcn_readfirstlane(VTID >> 6);
    const float* gss = WSP(float, W_ZERO) + (size_t)MT * 2;
    bf16_t* cat = WSP(bf16_t, W_CONCAT);
    for (int it = VBID; it < MT / 4; it += VGRID) {
        const int row = it * 4 + wid;
        const float rs = rsqrtf(gss[(size_t)row * 2 + (lane >> 5)] * (1.f / 256.f) + EPS);
        u32x4* ptr = (u32x4*)(cat + (size_t)row * 1024 + 512 + lane * 8);
        *ptr = scale8(*ptr, rs);
    }
}
__device__ __forceinline__ void phase6_g8(const Params& p, LAS char* lds, LAS char* ldsh) {
    W8V;
    pg8::Gemm g{WSP(bf16_t, W_CONCAT), WSP(bf16_t, W_WOUT), MP, 1024, 1024};
    pg8::gemm_phase<EpiRes<0>, Sched256, false>((PG8_LAS unsigned char*)lds, g, Sched256{64 * 4, 64, 4}, EpiRes<0>{&p}, nullptr);
    if (RBID < 16) {
        const int n0 = RBID * 64;
        const int wv_ = __builtin_amdgcn_readfirstlane(VTID >> 6), wmv = wv_ >> 1, wnv = wv_ & 1;
        f32x4 acc[4][2];
        if (single64_splitk(acc, WSP(bf16_t, W_CONCAT) + (size_t)MP * 1024, 1024, WSP(bf16_t, W_WOUT) + (size_t)n0 * 1024, 1024, 1024, lds, ldsh, half_)) res_epi<0, 2>(p, acc, MP + wmv * 64, n0 + wnv * 32);
    }
}
__device__ __forceinline__ void phase7_g8(const Params& p, LAS char* lds, LAS char* ldsh) {
    W8V;
    pg8::Gemm g{WSP(bf16_t, W_HPB), WSP(bf16_t, W_WQ), MP, 1024, 1024};
    pg8::gemm_phase<EpiQ, Sched256, false>((PG8_LAS unsigned char*)lds, g, Sched256{64 * 4, 64, 4}, EpiQ{&p}, nullptr);
    if (RBID < 16) {
        const int n0 = RBID * 64;
        const int wv_ = __builtin_amdgcn_readfirstlane(VTID >> 6), wmv = wv_ >> 1, wnv = wv_ & 1;
        f32x4 acc[4][2];
        if (single64_splitk(acc, WSP(bf16_t, W_HPB) + (size_t)MP * 1024, 1024, WSP(bf16_t, W_WQ) + (size_t)n0 * 1024, 1024, 1024, lds, ldsh, half_)) p7_epi<2>(p, acc, MP + wmv * 64, n0 + wnv * 32);
    }
}
__device__ __forceinline__ void phase9_g8(const Params& p, LAS char* lds, LAS char* ldsh) {
    W8V;
    pg8::Gemm g{WSP(bf16_t, W_OB), WSP(bf16_t, W_WXO), MP, 1024, 1024};
    pg8::gemm_phase<EpiRes<1>, Sched256, false>((PG8_LAS unsigned char*)lds, g, Sched256{64 * 4, 64, 4}, EpiRes<1>{&p}, nullptr);
    if (RBID < 16) {
        const int n0 = RBID * 64;
        const int wv_ = __builtin_amdgcn_readfirstlane(VTID >> 6), wmv = wv_ >> 1, wnv = wv_ & 1;
        f32x4 acc[4][2];
        if (single64_splitk(acc, WSP(bf16_t, W_OB) + (size_t)MP * 1024, 1024, WSP(bf16_t, W_WXO) + (size_t)n0 * 1024, 1024, 1024, lds, ldsh, half_)) res_epi<1, 2>(p, acc, MP + wmv * 64, n0 + wnv * 32);
    }
}
__device__ __forceinline__ void phase10_g8(const Params& p, LAS char* lds, LAS char* ldsh) {
    W8V;
    pg8::Gemm g{WSP(bf16_t, W_HPB), WSP(bf16_t, W_WGU), MP, 5632, 1024};
    pg8::gemm_phase<EpiGU, Sched256, false>((PG8_LAS unsigned char*)lds, g, Sched256{1280, 64, 22}, EpiGU{&p}, nullptr);
    const int wv_ = __builtin_amdgcn_readfirstlane(VTID >> 6), wmv = wv_ >> 1, wnv = wv_ & 1;
    for (int q = RBID * 2 + half_; q < 512; q += RGRID * 2) {
        const int m0 = 56 * 256 + (q & 15) * 128, n0 = 6 * 256 + (q >> 4) * 128;
        f32x4 acc[4][4]; zero_acc<4>(acc);
        mma_seg<128, 0>(acc, WSP(bf16_t, W_HPB) + (size_t)m0 * 1024, 1024, WSP(bf16_t, W_WGU) + (size_t)n0 * 1024, 1024, 1024, ldsh, nullptr);
        p10_epi<4>(p, acc, m0 + wmv * 64, n0 + wnv * 64);
    }
    if (RBID < 88) {
        const int n0 = RBID * 64;
        f32x4 acc[4][2];
        if (single64_splitk(acc, WSP(bf16_t, W_HPB) + (size_t)MP * 1024, 1024, WSP(bf16_t, W_WGU) + (size_t)n0 * 1024, 1024, 1024, lds, ldsh, half_)) p10_epi<2>(p, acc, MP + wmv * 64, n0 + wnv * 32);
    }
}
__device__ __forceinline__ void phase11_g8(const Params& p, LAS char* lds, LAS char* ldsh) {
    W8V;
    pg8::Gemm g{WSP(bf16_t, W_ACT), WSP(bf16_t, W_WD), MP, 1024, 2816};
    pg8::gemm_phase<EpiRes<2>, Sched256, false>((PG8_LAS unsigned char*)lds, g, Sched256{64 * 4, 64, 4}, EpiRes<2>{&p}, nullptr);
    if (RBID < 88) {
        const int j = RBID * 2 + half_, nt = j & 15, ks = j >> 4, n0 = nt * 64;
        const int wv_ = __builtin_amdgcn_readfirstlane(VTID >> 6), wmv = wv_ >> 1, wnv = wv_ & 1, lanev = VTID & 63, frv = lanev & 15, fqv = lanev >> 4;
        f32x4 acc[4][2]; zero_acc<2>(acc);
        mma_seg<64, 0>(acc, WSP(bf16_t, W_ACT) + (size_t)MP * 2816 + ks * 256, 2816, WSP(bf16_t, W_WD) + (size_t)n0 * 2816 + ks * 256, 2816, 256, ldsh, nullptr);
        float* hp = WSP(float, W_HP);
        const int rb = MP + wmv * 64 + frv, cb = n0 + wnv * 32 + fqv * 4;
#pragma unroll
        for (int mi = 0; mi < 4; ++mi)
#pragma unroll
            for (int ni = 0; ni < 2; ++ni)
#pragma unroll
                for (int jj = 0; jj < 4; ++jj) atomicAdd(hp + (size_t)(rb + mi * 16) * 1024 + cb + ni * 16 + jj, acc[mi][ni][jj]);
    }
}

#ifndef SKIP_PH
#define SKIP_PH 99
#endif
#define PH_ON(n) ((!defined(ONLY_PH) || ONLY_PH == n) && (SKIP_PH != n))
__global__ void __launch_bounds__(512) hymba_fwd(Params p) {
    extern __shared__ __attribute__((aligned(16))) char smem_dyn[];
    LAS char* lds = (LAS char*)smem_dyn;
    LAS char* ldsh = lds + __builtin_amdgcn_readfirstlane(RTID >> 8) * 65536;
    if (p.never) cg::this_grid().sync();
    volatile LAS unsigned* st = (volatile LAS unsigned*)(lds + LDS_MISC);
    if (RTID < 4) st[RTID] = 0u;
    __syncthreads();
    XcdBarrier xb = xcd_barrier_post(WSP(unsigned, W_BAR), st);
#if PH_ON(0)
    if (p.ph_lo <= 0 && 0 < p.ph_hi) { phase0(p, ldsh); }
#if (DUPM >> 0) & 1
    xcd_barrier(xb); { phase0(p, ldsh); }
#endif
#endif
                    xcd_barrier(xb);
#if PH_ON(1)
    if (p.ph_lo <= 1 && 1 < p.ph_hi) { phase1_g8(p, lds, ldsh); }
#if (DUPM >> 1) & 1
    xcd_barrier(xb); { phase1_g8(p, lds, ldsh); }
#endif
#endif
               xcd_barrier(xb);
#if PH_ON(2)
    if (p.ph_lo <= 2 && 2 < p.ph_hi) { phase2(p, ldsh); }
#if (DUPM >> 2) & 1
    xcd_barrier(xb); { phase2(p, ldsh); }
#endif
#endif
                    xcd_barrier(xb);
#if PH_ON(3)
    if (p.ph_lo <= 3 && 3 < p.ph_hi) { phase3(p, ldsh); }
#if (DUPM >> 3) & 1
    xcd_barrier(xb); { phase3(p, ldsh); }
#endif
#endif
                    xcd_barrier(xb);
#if PH_ON(4)
    if (p.ph_lo <= 4 && 4 < p.ph_hi) { phase4(p); }
#if (DUPM >> 4) & 1
    xcd_barrier(xb); { phase4(p); }
#endif
#endif
                          xcd_barrier(xb);
#if PH_ON(5)
    if (p.ph_lo <= 5 && 5 < p.ph_hi) { phase5(p, ldsh); }
#if (DUPM >> 5) & 1
    xcd_barrier(xb); { phase5(p, ldsh); }
#endif
#endif
                    xcd_barrier(xb);
#if PH_ON(6)
    if (p.ph_lo <= 6 && 6 < p.ph_hi) { phase5b(p); xcd_barrier(xb); phase6_g8(p, lds, ldsh); }
#if (DUPM >> 6) & 1
    xcd_barrier(xb); { phase5b(p); xcd_barrier(xb); phase6_g8(p, lds, ldsh); }
#endif
#endif
         xcd_barrier(xb);
#if PH_ON(7)
    if (p.ph_lo <= 7 && 7 < p.ph_hi) { phase7_g8(p, lds, ldsh); }
#if (DUPM >> 7) & 1
    xcd_barrier(xb); { phase7_g8(p, lds, ldsh); }
#endif
#endif
               xcd_barrier(xb);
#if PH_ON(8)
    if (p.ph_lo <= 8 && 8 < p.ph_hi) { phase8(p, ldsh); }
#if (DUPM >> 8) & 1
    xcd_barrier(xb); { phase8(p, ldsh); }
#endif
#endif
                    xcd_barrier(xb);
#if PH_ON(9)
    if (p.ph_lo <= 9 && 9 < p.ph_hi) { phase9_g8(p, lds, ldsh); }
#if (DUPM >> 9) & 1
    xcd_barrier(xb); { phase9_g8(p, lds, ldsh); }
#endif
#endif
         xcd_barrier(xb);
#if PH_ON(10)
    if (p.ph_lo <= 10 && 10 < p.ph_hi) { phase10_g8(p, lds, ldsh); }
#if (DUPM >> 10) & 1
    xcd_barrier(xb); { phase10_g8(p, lds, ldsh); }
#endif
#endif
              xcd_barrier(xb);
#if PH_ON(11)
    if (p.ph_lo <= 11 && 11 < p.ph_hi) { phase11_g8(p, lds, ldsh); }
#if (DUPM >> 11) & 1
    xcd_barrier(xb); { phase11_g8(p, lds, ldsh); }
#endif
#endif
         xcd_barrier(xb);
#if PH_ON(12)
    if (p.ph_lo <= 12 && 12 < p.ph_hi) { phase12(p); }
#if (DUPM >> 12) & 1
    xcd_barrier(xb); { phase12(p); }
#endif
#endif
}

extern "C" void kernel_launch(void* const* d_in, const int* in_sizes, int n_in, void* d_out, int out_size, void* d_ws, size_t ws_size, hipStream_t stream) {
    static int grid = 0;
    if (grid == 0) {
        int dev = 0, cus = 0, per_cu = 0;
        (void)hipGetDevice(&dev);
        (void)hipDeviceGetAttribute(&cus, hipDeviceAttributeMultiprocessorCount, dev);
        (void)hipFuncSetAttribute((const void*)hymba_fwd, hipFuncAttributeMaxDynamicSharedMemorySize, LDS_BYTES);
        (void)hipOccupancyMaxActiveBlocksPerMultiprocessor(&per_cu, (const void*)hymba_fwd, 512, LDS_BYTES);
        grid = cus; grid = (grid / 8) * 8;
        if (per_cu < 1) fprintf(stderr, "kernel_launch: occupancy query reports %d blocks per CU\n", per_cu);
        if (ws_size < W_END) fprintf(stderr, "kernel_launch: workspace too small: %zu < %zu\n", ws_size, (size_t)W_END);
    }
    Params p{};
    for (int i = 0; i < 31; ++i) p.in[i] = (const float*)d_in[i];
    p.out = (float*)d_out; p.ws = (char*)d_ws; p.never = 0;
    (void)hipMemsetAsync((char*)d_ws + W_BAR, 0, XCD_BAR_WORDS * 4, stream);
    p.ph_lo = 0; p.ph_hi = NPH; p.fused = 1;
    void* args[] = {&p};
    hipError_t e = hipLaunchCooperativeKernel((const void*)hymba_fwd, dim3(grid), dim3(512), args, LDS_BYTES, stream);
    if (e != hipSuccess) fprintf(stderr, "cooperative launch failed: %s (grid %d)\n", hipGetErrorString(e), grid);
}
```
